# Optimizing an MI355X kernel written in HIP

```python
import jax, jax.numpy as jnp
from jax import lax
import numpy as np

D_MODEL = 4096
BATCH = 2
SEQ = 8192
DEPTH = 1

F32 = jnp.float32
RMS_EPS = 1e-6

GLA_HEADS = 8
GLA_VAL_W = D_MODEL // 2
GLA_KEY_W = GLA_VAL_W // 2
GLA_DV = GLA_VAL_W // GLA_HEADS
GLA_DK = GLA_KEY_W // GLA_HEADS
GLA_GATE_RANK = 16
GLA_GATE_TAU = 16.0
GLA_CHUNK = 64

SWA_HEAD_DIM = 64
SWA_Q_HEADS = (D_MODEL // 2) // SWA_HEAD_DIM
SWA_KV_HEADS = SWA_Q_HEADS // 8
SWA_Q_W = SWA_Q_HEADS * SWA_HEAD_DIM
SWA_KV_W = SWA_KV_HEADS * SWA_HEAD_DIM
SWA_WINDOW = 128
SWA_BLOCK = 128
ROPE_THETA = 10000.0

MIX_WIDTH = GLA_VAL_W + SWA_Q_W
IN_SPLITS = (GLA_KEY_W, GLA_KEY_W, GLA_VAL_W, GLA_VAL_W, GLA_GATE_RANK,
             SWA_Q_W, SWA_KV_W, SWA_KV_W)
IN_COLS = GLA_KEY_W * 2 + GLA_VAL_W * 2 + GLA_GATE_RANK + SWA_Q_W + SWA_KV_W * 2

N_GROUPS = 8
EXPERTS_PER_GROUP = 8
N_EXPERTS = N_GROUPS * EXPERTS_PER_GROUP
TOP_K_IN_GROUP = 2
D_FF_EXPERT = D_MODEL // 8

kernel_name = 'hymba_gla_swa_hier_moe'


def rms_norm(x, g):
    xf = x.astype(F32)
    y = xf * lax.rsqrt(jnp.mean(xf * xf, axis=-1, keepdims=True) + RMS_EPS)
    return (y * g.astype(F32)).astype(x.dtype)


def split_points():
    pts, acc = [], 0
    for s in IN_SPLITS[:-1]:
        acc += s
        pts.append(acc)
    return pts


def gla_chunked(q, k, v, g_log):
    B, T, H, dk = q.shape
    dv = v.shape[-1]
    C = GLA_CHUNK
    N = T // C

    def chunked(a):
        return a.reshape(B, N, C, H, a.shape[-1]).transpose(0, 3, 1, 2, 4).astype(F32)

    qc = chunked(q) * (dk ** -0.5)
    kc, vc, gc = chunked(k), chunked(v), chunked(g_log)
    b = jnp.cumsum(gc, axis=3)
    b_last = b[:, :, :, -1:, :]
    q_in = qc * jnp.exp(b)
    k_in = kc * jnp.exp(-b)
    k_dec = kc * jnp.exp(b_last - b)

    causal = jnp.tril(jnp.ones((C, C), dtype=bool))
    a = jnp.einsum('bhnid,bhnjd->bhnij', q_in, k_in)
    a = jnp.where(causal, a, 0.0)
    o_intra = jnp.einsum('bhnij,bhnje->bhnie', a, vc)

    chunk_kv = jnp.einsum('bhncd,bhnce->bhnde', k_dec, vc)
    decay = jnp.exp(b_last[:, :, :, 0, :])

    def step(state, inp):
        kv_n, dec_n = inp
        return dec_n[..., None] * state + kv_n, state

    s0 = jnp.zeros((B, H, dk, dv), F32)
    _, s_start = lax.scan(step, s0, (jnp.moveaxis(chunk_kv, 2, 0), jnp.moveaxis(decay, 2, 0)))
    s_start = jnp.moveaxis(s_start, 0, 2)
    o_inter = jnp.einsum('bhncd,bhnde->bhnce', q_in, s_start)
    o = (o_intra + o_inter).transpose(0, 2, 3, 1, 4).reshape(B, T, H, dv)
    return o.astype(v.dtype)


def rope(x, positions):
    d = x.shape[-1]
    half = d // 2
    inv_freq = ROPE_THETA ** (-jnp.arange(half, dtype=F32) / half)
    ang = positions.astype(F32)[..., None] * inv_freq
    cos = jnp.cos(ang)[:, :, None, :]
    sin = jnp.sin(ang)[:, :, None, :]
    xf = x.astype(F32)
    x1, x2 = xf[..., :half], xf[..., half:]
    out = jnp.concatenate([x1 * cos - x2 * sin, x2 * cos + x1 * sin], axis=-1)
    return out.astype(x.dtype)


def sliding_window_attention(q, k, v, sinks):
    B, T, Hq, d = q.shape
    Hkv = k.shape[2]
    G = Hq // Hkv
    W = SWA_BLOCK
    N = T // W
    qb = q.reshape(B, N, W, Hkv, G, d).astype(F32)

    def band(a):
        ab = a.reshape(B, N, W, Hkv, d).astype(F32)
        prev = jnp.pad(ab, ((0, 0), (1, 0), (0, 0), (0, 0), (0, 0)))[:, :-1]
        return jnp.concatenate([prev, ab], axis=2)

    kb, vb = band(k), band(v)
    s = jnp.einsum('bnqhgd,bnkhd->bnhgqk', qb, kb) * (d ** -0.5)
    qi = jnp.arange(W)[:, None] + W
    kj = jnp.arange(2 * W)[None, :]
    diff = qi - kj
    in_window = (diff >= 0) & (diff < SWA_WINDOW)
    has_prev = (jnp.arange(N)[:, None, None] > 0) | (kj[None] >= W)
    valid = in_window[None] & has_prev
    s = jnp.where(valid[None, :, None, None], s, -jnp.inf)
    sink = jnp.broadcast_to(sinks.astype(F32).reshape(1, 1, Hkv, G, 1, 1), s.shape[:-1] + (1,))
    p = jax.nn.softmax(jnp.concatenate([s, sink], axis=-1), axis=-1)[..., :-1]
    o = jnp.einsum('bnhgqk,bnkhd->bnqhgd', p, vb)
    return o.reshape(B, T, Hq * d).astype(q.dtype)


def hierarchical_moe(h, rg_w, rg_b, re_w, re_b, w_gate, w_up, w_down):
    B, T, D = h.shape
    x = h.reshape(B * T, D)
    g_logits = (x @ rg_w).astype(F32) + rg_b.astype(F32)
    g_prob = jax.nn.softmax(g_logits, axis=-1)
    g_w, g_idx = lax.top_k(g_prob, 1)
    e_logits = jnp.einsum('nd,gde->nge', x, re_w).astype(F32) + re_b.astype(F32)
    e_sel = jnp.take_along_axis(e_logits, g_idx[:, :, None], axis=1)[:, 0]
    e_prob = jax.nn.softmax(e_sel, axis=-1)
    top_w, top_i = lax.top_k(e_prob, TOP_K_IN_GROUP)
    top_w = top_w / jnp.sum(top_w, axis=-1, keepdims=True)
    expert_id = g_idx * EXPERTS_PER_GROUP + top_i
    weights = g_w * top_w
    comb = jnp.sum(jax.nn.one_hot(expert_id, N_EXPERTS, dtype=F32) * weights[..., None], axis=1)

    def step(acc, inp):
        wg, wu, wd, c = inp
        hid = jax.nn.silu(x @ wg) * (x @ wu)
        return acc + c[:, None] * (hid @ wd).astype(F32), None

    acc, _ = lax.scan(step, jnp.zeros((B * T, D), F32), (w_gate, w_up, w_down, comb.T))
    return acc.astype(h.dtype).reshape(B, T, D)


def setup_inputs(seed: int = 0) -> dict:
    key = jax.random.key(seed)
    ks = jax.random.split(key, 20)
    L = DEPTH
    nrm = jax.random.normal
    x = nrm(ks[0], (BATCH, SEQ, D_MODEL), F32)
    offs = jax.random.randint(ks[1], (BATCH, 1), 0, 1024, dtype=jnp.int32)
    positions = (jnp.arange(SEQ, dtype=jnp.int32)[None, :] + offs).astype(jnp.int32)
    return {
        'x': x,
        'positions': positions,
        'norm_mix_g': 1.0 + 0.02 * nrm(ks[2], (L, D_MODEL), F32),
        'w_in': nrm(ks[3], (L, D_MODEL, IN_COLS), F32) * D_MODEL ** -0.5,
        'gla_gate_w2': nrm(ks[4], (L, GLA_GATE_RANK, GLA_KEY_W), F32) * GLA_GATE_RANK ** -0.5,
        'gla_gate_b': 0.1 * nrm(ks[5], (L, GLA_KEY_W), F32),
        'gla_out_norm_g': 1.0 + 0.02 * nrm(ks[6], (L, GLA_DV), F32),
        'swa_sinks': 0.5 * nrm(ks[7], (L, SWA_Q_HEADS), F32),
        'w_out': nrm(ks[8], (L, MIX_WIDTH, D_MODEL), F32) * MIX_WIDTH ** -0.5,
        'norm_ffn_g': 1.0 + 0.02 * nrm(ks[9], (L, D_MODEL), F32),
        'router_group_w': nrm(ks[10], (L, D_MODEL, N_GROUPS), F32) * D_MODEL ** -0.5,
        'router_group_b': 0.01 * nrm(ks[11], (L, N_GROUPS), F32),
        'router_expert_w': nrm(ks[12], (L, N_GROUPS, D_MODEL, EXPERTS_PER_GROUP), F32) * D_MODEL ** -0.5,
        'router_expert_b': 0.01 * nrm(ks[13], (L, N_GROUPS, EXPERTS_PER_GROUP), F32),
        'expert_w_gate': nrm(ks[14], (L, N_EXPERTS, D_MODEL, D_FF_EXPERT), F32) * D_MODEL ** -0.5,
        'expert_w_up': nrm(ks[15], (L, N_EXPERTS, D_MODEL, D_FF_EXPERT), F32) * D_MODEL ** -0.5,
        'expert_w_down': nrm(ks[16], (L, N_EXPERTS, D_FF_EXPERT, D_MODEL), F32) * D_FF_EXPERT ** -0.5,
        'norm_final_g': 1.0 + 0.02 * nrm(ks[17], (D_MODEL,), F32),
    }


def reference(x, positions, norm_mix_g, w_in, gla_gate_w2, gla_gate_b, gla_out_norm_g,
              swa_sinks, w_out, norm_ffn_g, router_group_w, router_group_b,
              router_expert_w, router_expert_b, expert_w_gate, expert_w_up,
              expert_w_down, norm_final_g):
    B, T, _ = x.shape
    h = x
    for l in range(DEPTH):
        u = rms_norm(h, norm_mix_g[l])
        proj = u @ w_in[l]
        gq, gk, gv, gr, ga, sq, sk, sv = jnp.split(proj, split_points(), axis=-1)

        g_log = jax.nn.log_sigmoid((ga @ gla_gate_w2[l]).astype(F32) + gla_gate_b[l].astype(F32)) / GLA_GATE_TAU
        o_gla = gla_chunked(gq.reshape(B, T, GLA_HEADS, GLA_DK),
                            gk.reshape(B, T, GLA_HEADS, GLA_DK),
                            gv.reshape(B, T, GLA_HEADS, GLA_DV),
                            g_log.reshape(B, T, GLA_HEADS, GLA_DK))
        o_gla = rms_norm(o_gla, gla_out_norm_g[l]) * jax.nn.silu(gr.reshape(B, T, GLA_HEADS, GLA_DV))
        o_gla = o_gla.reshape(B, T, GLA_VAL_W)

        q = rope(sq.reshape(B, T, SWA_Q_HEADS, SWA_HEAD_DIM), positions)
        k = rope(sk.reshape(B, T, SWA_KV_HEADS, SWA_HEAD_DIM), positions)
        v = sv.reshape(B, T, SWA_KV_HEADS, SWA_HEAD_DIM)
        o_swa = sliding_window_attention(q, k, v, swa_sinks[l])

        mixed = jnp.concatenate([o_gla.astype(h.dtype), o_swa.astype(h.dtype)], axis=-1)
        h = h + (mixed @ w_out[l]).astype(h.dtype)

        u = rms_norm(h, norm_ffn_g[l])
        h = h + hierarchical_moe(u, router_group_w[l], router_group_b[l],
                                 router_expert_w[l], router_expert_b[l],
                                 expert_w_gate[l], expert_w_up[l], expert_w_down[l])
    return rms_norm(h, norm_final_g)
```

```cpp
#include <hip/hip_runtime.h>
#include <cstdio>
#include <cstdint>

#ifndef MK_N_LAUNCHES
#define MK_N_LAUNCHES 1
#endif

#ifndef PROBE_DUP
#define PROBE_DUP -1
#endif
#define REP(k) for (int rep_ = 0; rep_ < ((PROBE_DUP) == (k) ? 2 : 1); ++rep_)
#define GAS __attribute__((address_space(1)))
#define LAS __attribute__((address_space(3)))
#define PG8_LAS __attribute__((address_space(3)))

typedef unsigned short bf16_t;
typedef short bf16x8 __attribute__((ext_vector_type(8)));
typedef float f32x4 __attribute__((ext_vector_type(4)));
typedef float f32x2 __attribute__((ext_vector_type(2)));
typedef unsigned u32x4 __attribute__((ext_vector_type(4)));
typedef unsigned u32x2 __attribute__((ext_vector_type(2)));

constexpr int D = 4096, BATCH = 2, SEQ = 8192, M = BATCH * SEQ;
constexpr int IN_COLS = 8720, LDP = 8960;
constexpr int C_GQ = 0, C_GK = 1024, C_GV = 2048, C_GR = 4096, C_SQ = 6144, C_SK = 8192, C_SV = 8448, C_GA = 8704;
constexpr int NEXP = 64, DFF = 512;
constexpr int MAXSLOT = 49152;
constexpr float RMS_EPS = 1e-6f;

constexpr size_t MiB = 1u << 20;
constexpr size_t WS_CTL = 0, CTL_ZERO_BYTES = 1 * MiB;
constexpr size_t WS_TAB = 1 * MiB;
constexpr size_t WS_ROPE = 8 * MiB;
constexpr size_t WS_RB = 14 * MiB;
constexpr size_t WS_WIN = 32 * MiB;
constexpr size_t WS_WOUT = 102 * MiB;
constexpr size_t WS_U = 134 * MiB;
constexpr size_t WS_MIX = 262 * MiB;
constexpr size_t WS_PROJ = 390 * MiB;
constexpr size_t WS_Y = 390 * MiB;
constexpr size_t WS_HB = 670 * MiB;
constexpr size_t WS_WGU = 670 * MiB;
constexpr size_t WS_T2 = 1182 * MiB;
constexpr size_t T2_TOK = 0, T2_W = 4 * MiB, T2_DST = 8 * MiB, T2_RS = 12 * MiB; constexpr int CAPS = 16384;
constexpr size_t WS_WD = 1182 * MiB;
constexpr size_t WS_HID = 1438 * MiB;
constexpr size_t WS_QIN = 1486 * MiB;
constexpr size_t WS_KDT = 1518 * MiB;
constexpr size_t WS_AM = 1550 * MiB;
constexpr size_t WS_DEC = 1566 * MiB;
constexpr size_t WS_ORAW = 1568 * MiB;
constexpr size_t WS_END = 1632 * MiB;
constexpr size_t T_TOKE = 0;
constexpr size_t T_TOKW = 256 * 1024;
constexpr size_t T_TOKR = 512 * 1024;
constexpr size_t T_SLOTTOK = 768 * 1024;
constexpr size_t T_SLOTW = 1024 * 1024;
constexpr size_t T_SLOTDST = 1280 * 1024;
constexpr size_t T_TILEE = 1536 * 1024;
constexpr int UL_UP = 2048, UL_DN = 8192;
constexpr size_t T_ULUP = 1800 * 1024;
constexpr size_t T_EOFF = 1900 * 1024;
constexpr size_t T_ULDN = 2048 * 1024;
constexpr size_t T_RSTD = 1540 * 1024;
constexpr size_t T_SLOTRS = 1604 * 1024;
constexpr int CW_CNT = 1024;
constexpr int CW_NT = 1100;
constexpr int CW_NUP = 1200, CW_NDN = 1216;
constexpr int CW_BAR = 4096;

constexpr int RING_BYTES = 141312;
constexpr int LDSCTL_OFF = RING_BYTES, MISC_OFF = LDSCTL_OFF + 320;
constexpr int LDS_BYTES = 142336;

#define LDS_WAIT() asm volatile("s_waitcnt lgkmcnt(0)" ::: "memory")
#define VM_WAIT() asm volatile("s_waitcnt vmcnt(0)" ::: "memory")
__device__ __forceinline__ unsigned f2bf(float f) { unsigned u = __builtin_bit_cast(unsigned, f); return (u + 0x7fffu + ((u >> 16) & 1u)) >> 16; }
__device__ __forceinline__ unsigned pk2(float lo, float hi) { return f2bf(lo) | (f2bf(hi) << 16); }
__device__ __forceinline__ float bf2f(unsigned short b) { return __builtin_bit_cast(float, ((unsigned)b) << 16); }
__device__ __forceinline__ float bflo(unsigned w) { return __builtin_bit_cast(float, w << 16); }
__device__ __forceinline__ float bfhi(unsigned w) { return __builtin_bit_cast(float, w & 0xffff0000u); }
__device__ __forceinline__ unsigned cvt_pk_bf16(float lo, float hi) { unsigned r; asm volatile("v_cvt_pk_bf16_f32 %0, %1, %2" : "=v"(r) : "v"(lo), "v"(hi)); return r; }
typedef float f32x16 __attribute__((ext_vector_type(16)));
typedef short s16x4 __attribute__((ext_vector_type(4)));
typedef __bf16 bf16x2_t __attribute__((ext_vector_type(2)));
__device__ __forceinline__ unsigned cvtpk(float lo, float hi) { f32x2 v = {lo, hi}; bf16x2_t b = __builtin_convertvector(v, bf16x2_t); return __builtin_bit_cast(unsigned, b); }
__device__ __forceinline__ float wave_sum(float v) {
#pragma unroll
    for (int o = 1; o < 64; o <<= 1) v += __shfl_xor(v, o);
    return v;
}

#define XB_TMO      128
#define XB_XCNT(j)  (256  + 64 * (j))
#define XB_XSUB(j)  (1280 + 64 * (j))
#define XB_XGEN(j)  (2304 + 64 * (j))
#define XB_TOP      3328
#define XB_TOPGEN   3392
#define XCD_BAR_WORDS 3456
#define XB_SPIN_CAP (1u << 18)

__device__ __forceinline__ unsigned xb_ld(unsigned* p)              { return __hip_atomic_load(p, __ATOMIC_RELAXED, __HIP_MEMORY_SCOPE_AGENT); }
__device__ __forceinline__ unsigned xb_add(unsigned* p, unsigned v) { return __hip_atomic_fetch_add(p, v, __ATOMIC_RELAXED, __HIP_MEMORY_SCOPE_AGENT); }
__device__ __forceinline__ unsigned xb_xcc_id() { return (unsigned)__builtin_amdgcn_s_getreg((3 << 11) | 20) & 0xFu; }
#define XB_SPIN(cond, bar) do { unsigned _sp = 0; while (cond) { __builtin_amdgcn_s_sleep(1); \
    if ((++_sp & 255u) == 0u) { if (xb_ld(&(bar)[XB_TMO])) break; if (_sp > XB_SPIN_CAP) { atomicAdd(&(bar)[XB_TMO], 1u); break; } } } } while (0)

struct XcdBarrier { unsigned* bar; unsigned x; volatile LAS unsigned* st; };

__device__ __forceinline__ XcdBarrier xcd_barrier_post(unsigned* bar, volatile LAS unsigned* st) {
    XcdBarrier b; b.bar = bar; b.x = xb_xcc_id(); b.st = st;
    if (threadIdx.x == 0) (void)xb_add(&bar[XB_XCNT(b.x)], 1u);
    return b;
}
__device__ __forceinline__ void xcd_barrier_complete(unsigned* bar, unsigned x, unsigned& nloc, unsigned& nx) {
    const unsigned G = gridDim.x * gridDim.y * gridDim.z;
    unsigned sum, cnt, mine, sp = 0u;
    for (;;) {
        sum = 0u; cnt = 0u; mine = 0u;
#pragma unroll
        for (unsigned j = 0; j < 16; ++j) { const unsigned c = xb_ld(&bar[XB_XCNT(j)]); sum += c; cnt += (c > 0u) ? 1u : 0u; mine = (j == x) ? c : mine; }
        if (sum == G) break;
        __builtin_amdgcn_s_sleep(1);
        if ((++sp & 255u) == 0u) { if (xb_ld(&bar[XB_TMO])) break; if (sp > XB_SPIN_CAP) { atomicAdd(&bar[XB_TMO], 1u); break; } }
    }
    nloc = mine > 0u ? mine : 1u; nx = cnt > 0u ? cnt : 1u;
}
__device__ __forceinline__ void xcd_barrier(const XcdBarrier& b) {
    asm volatile("s_waitcnt vmcnt(0)" ::: "memory");
    __syncthreads();
    if (threadIdx.x == 0) {
        unsigned* bar = b.bar;
        __builtin_amdgcn_s_waitcnt(0);
        unsigned nloc = b.st[0], nx = b.st[1];
        if (nloc == 0u) { xcd_barrier_complete(bar, b.x, nloc, nx); b.st[0] = nloc; b.st[1] = nx; }
        const unsigned old = xb_add(&bar[XB_XSUB(b.x)], 1u);
        const unsigned gen = old / nloc;
        if (old + 1u == (gen + 1u) * nloc) {
            __builtin_amdgcn_fence(__ATOMIC_RELEASE, "agent");
            asm volatile("s_waitcnt vmcnt(0)" ::: "memory");
            const unsigned og = xb_add(&bar[XB_TOP], 1u);
            const unsigned tg = og / nx;
            if (og + 1u == (tg + 1u) * nx) xb_add(&bar[XB_TOPGEN], 1u);
            else XB_SPIN(xb_ld(&bar[XB_TOPGEN]) == tg, bar);
            __builtin_amdgcn_fence(__ATOMIC_ACQUIRE, "agent");
            xb_add(&bar[XB_XGEN(b.x)], 1u);
            asm volatile("s_waitcnt vmcnt(0)" ::: "memory");
        } else {
            XB_SPIN(xb_ld(&bar[XB_XGEN(b.x)]) == gen, bar);
            __builtin_amdgcn_fence(__ATOMIC_ACQUIRE, "agent");
            asm volatile("s_waitcnt vmcnt(0)" ::: "memory");
        }
    }
    __syncthreads();
}

namespace pg8 {
constexpr int BM = 256, BK = 64, HALF = 128, HTB = HALF * BK * 2, STAGE_BYTES = 8 * HTB, NXCD = 8, WGM = 8;
__host__ __device__ __forceinline__ int lds_byte(int r, int c) { const int st = (r >> 4) * 2 + (c >> 5), rr = r & 15, cc = c & 31, ob = rr * 64 + cc * 2; return st * 1024 + (ob ^ (((ob >> 9) & 1) << 5)); }
__host__ __device__ __forceinline__ void stage_rc(int b, int& R, int& C) { const int st = b / 1024, sb = b % 1024, swz = sb ^ (((sb >> 9) & 1) << 5); R = (st >> 1) * 16 + swz / 64; C = (st & 1) * 32 + (swz % 64) / 2; }
__host__ __device__ __forceinline__ int perm32(int rho) { const int n = rho >> 4, i = rho & 15; return 8 * (i >> 2) + 4 * n + (i & 3); }

struct Unit { int pm, pn, e; };

struct DenseSched {
    static constexpr bool GATHER = false;
    const bf16_t* A; const bf16_t* Bt; int K;
    int nM, nN, nwg, G, c;
    __device__ void init(const bf16_t* A_, const bf16_t* Bt_, int Mr, int N, int K_, int G_, int c_) { A = A_; Bt = Bt_; K = K_; nM = Mr / BM; nN = N / BM; nwg = nM * nN; G = G_; c = c_; }
    __device__ bool next(int i, Unit& u) const {
        const long L = (long)i * G + c; if (L >= nwg) return false;
        int wgid = (int)L; { const int q = nwg / NXCD, r = nwg % NXCD, xcd = wgid % NXCD, off = wgid / NXCD; wgid = (xcd < r ? xcd * (q + 1) : r * (q + 1) + (xcd - r) * q) + off; }
        const int nig = WGM * nN, gid = wgid / nig, fm = gid * WGM, gsz = (nM - fm) < WGM ? (nM - fm) : WGM;
        u.pm = fm + ((wgid % nig) % gsz); u.pn = (wgid % nig) / gsz; u.e = 0; return true;
    }
    __device__ __forceinline__ const char* a_ptr(const Unit& u) const { return (const char*)A + (size_t)u.pm * BM * K * 2; }
    __device__ __forceinline__ const char* b_ptr(const Unit& u) const { return (const char*)Bt + (size_t)u.pn * BM * K * 2; }
    __device__ __forceinline__ unsigned row(const Unit&, int) const { return 0u; }
};
struct MoeUpSched {
    static constexpr bool GATHER = true;
    const bf16_t* A; const bf16_t* Bt; const int* tile_e; const int* slot_tok; int ntiles, G, c;
    __device__ bool next(int i, Unit& u) const {
        if ((G & 7) == 0) { const int x = c & 7, idx = (c >> 3) + (G >> 3) * i; u.pm = 8 * (idx >> 2) + x; u.pn = idx & 3; if (u.pm >= ntiles) return false; }
        else { const int L = i * G + c; if (L >= ntiles * 4) return false; u.pm = L >> 2; u.pn = L & 3; }
        u.e = tile_e[u.pm]; return true;
    }
    __device__ __forceinline__ const char* a_ptr(const Unit&) const { return (const char*)A; }
    __device__ __forceinline__ const char* b_ptr(const Unit& u) const { return (const char*)Bt + ((size_t)u.e * 1024 + (size_t)u.pn * 256) * 4096 * 2; }
    __device__ __forceinline__ unsigned row(const Unit& u, int r) const { return (unsigned)slot_tok[u.pm * 256 + r]; }
};
struct MoeDownSched {
    static constexpr bool GATHER = false;
    const bf16_t* A; const bf16_t* Bt; const int* tile_e; int ntiles, G, c;
    __device__ bool next(int i, Unit& u) const {
        const int L = i * G + c; if (L >= ntiles * 16) return false;
        u.pm = L >> 4; u.pn = L & 15; u.e = tile_e[u.pm]; return true;
    }
    __device__ __forceinline__ const char* a_ptr(const Unit& u) const { return (const char*)A + (size_t)u.pm * 256 * 512 * 2; }
    __device__ __forceinline__ const char* b_ptr(const Unit& u) const { return (const char*)Bt + ((size_t)u.e * 4096 + (size_t)u.pn * 256) * 512 * 2; }
    __device__ __forceinline__ unsigned row(const Unit&, int) const { return 0u; }
};

struct EpiBf16 {
    static constexpr bool PERM = true;
    bf16_t* O; int ldc;
    __device__ __forceinline__ void operator()(const f32x4 (&acc)[2][2][4][2], const Unit& u, int wr, int wc, int fr, int fq) const {
        const int row0 = u.pm * BM + wr * 64 + fr, col0 = u.pn * BM + wc * 32 + 8 * fq;
#pragma unroll
        for (int ai = 0; ai < 2; ++ai)
#pragma unroll
            for (int m = 0; m < 4; ++m) { bf16_t* rowp = O + (size_t)(row0 + ai * HALF + m * 16) * ldc + col0;
#pragma unroll
                for (int bj = 0; bj < 2; ++bj) { const f32x4 v0 = acc[ai][bj][m][0], v1 = acc[ai][bj][m][1];
                    u32x4 w; w.x = cvt_pk_bf16(v0[0], v0[1]); w.y = cvt_pk_bf16(v0[2], v0[3]); w.z = cvt_pk_bf16(v1[0], v1[1]); w.w = cvt_pk_bf16(v1[2], v1[3]);
                    *(u32x4*)(rowp + bj * HALF) = w; } }
    }
};
struct EpiResF32 {
    static constexpr bool PERM = false;
    const float* res; float* out; int ldc;
    __device__ __forceinline__ void operator()(const f32x4 (&acc)[2][2][4][2], const Unit& u, int wr, int wc, int fr, int fq) const {
        const int row0 = u.pm * BM + wr * 64 + fr, col0 = u.pn * BM + wc * 32 + 4 * fq;
#pragma unroll
        for (int ai = 0; ai < 2; ++ai)
#pragma unroll
            for (int m = 0; m < 4; ++m) { const size_t off = (size_t)(row0 + ai * HALF + m * 16) * ldc + col0;
#pragma unroll
                for (int bj = 0; bj < 2; ++bj)
#pragma unroll
                    for (int n = 0; n < 2; ++n) { const f32x4 r = *(const f32x4*)(res + off + bj * HALF + n * 16); *(f32x4*)(out + off + bj * HALF + n * 16) = r + acc[ai][bj][m][n]; }
                if (m & 1) asm volatile("" ::: "memory"); }
    }
};
struct EpiResBf16 {
    static constexpr bool PERM = true;
    const float* res; bf16_t* out; int ldc;
    __device__ __forceinline__ void operator()(const f32x4 (&acc)[2][2][4][2], const Unit& u, int wr, int wc, int fr, int fq) const {
        const int row0 = u.pm * BM + wr * 64 + fr, col0 = u.pn * BM + wc * 32 + 8 * fq;
#pragma unroll
        for (int ai = 0; ai < 2; ++ai)
#pragma unroll
            for (int m = 0; m < 4; ++m) { const size_t off = (size_t)(row0 + ai * HALF + m * 16) * ldc + col0;
#pragma unroll
                for (int bj = 0; bj < 2; ++bj) { const f32x4 v0 = *(const f32x4*)(res + off + bj * HALF) + acc[ai][bj][m][0], v1 = *(const f32x4*)(res + off + bj * HALF + 4) + acc[ai][bj][m][1];
                    u32x4 w; w.x = cvt_pk_bf16(v0[0], v0[1]); w.y = cvt_pk_bf16(v0[2], v0[3]); w.z = cvt_pk_bf16(v1[0], v1[1]); w.w = cvt_pk_bf16(v1[2], v1[3]);
                    *(u32x4*)(out + off + bj * HALF) = w; }
                if (m & 1) asm volatile("" ::: "memory"); }
    }
};
struct EpiSwiGlu {
    static constexpr bool PERM = true;
    bf16_t* HID; const float* slot_rs;
    __device__ __forceinline__ void operator()(const f32x4 (&acc)[2][2][4][2], const Unit& u, int wr, int wc, int fr, int fq) const {
        const int row0 = u.pm * BM + wr * 64 + fr, col0 = u.pn * 128 + wc * 32 + 8 * fq;
#pragma unroll
        for (int ai = 0; ai < 2; ++ai)
#pragma unroll
            for (int m = 0; m < 4; ++m) { bf16_t* rowp = HID + (size_t)(row0 + ai * HALF + m * 16) * DFF + col0; const float rs = slot_rs[row0 + ai * HALF + m * 16];
                float h[8];
#pragma unroll
                for (int n = 0; n < 2; ++n)
#pragma unroll
                    for (int j = 0; j < 4; ++j) { const float g = acc[ai][0][m][n][j] * rs, up = acc[ai][1][m][n][j] * rs; h[n * 4 + j] = g * __builtin_amdgcn_rcpf(1.0f + __expf(-g)) * up; }
                u32x4 w; w.x = cvt_pk_bf16(h[0], h[1]); w.y = cvt_pk_bf16(h[2], h[3]); w.z = cvt_pk_bf16(h[4], h[5]); w.w = cvt_pk_bf16(h[6], h[7]);
                *(u32x4*)rowp = w; }
    }
};
struct EpiDown {
    static constexpr bool PERM = true;
    bf16_t* Y; const int* slot_dst; const float* slot_w;
    __device__ __forceinline__ void operator()(const f32x4 (&acc)[2][2][4][2], const Unit& u, int wr, int wc, int fr, int fq) const {
        const int slot0 = u.pm * BM + wr * 64 + fr, col0 = u.pn * BM + wc * 32 + 8 * fq;
#pragma unroll
        for (int ai = 0; ai < 2; ++ai)
#pragma unroll
            for (int m = 0; m < 4; ++m) { const int slot = slot0 + ai * HALF + m * 16; const int dst = slot_dst[slot]; const float sw = slot_w[slot];
                if (dst >= 0) { bf16_t* rowp = Y + (size_t)dst * D + col0;
#pragma unroll
                    for (int bj = 0; bj < 2; ++bj) { const f32x4 v0 = acc[ai][bj][m][0] * sw, v1 = acc[ai][bj][m][1] * sw;
                        u32x4 w; w.x = cvt_pk_bf16(v0[0], v0[1]); w.y = cvt_pk_bf16(v0[2], v0[3]); w.z = cvt_pk_bf16(v1[0], v1[1]); w.w = cvt_pk_bf16(v1[2], v1[3]);
                        *(u32x4*)(rowp + bj * HALF) = w; } } }
    }
};

template <class Epi, class Sched, bool ALIGN_EPI>
__device__ __forceinline__ void gemm_phase(PG8_LAS unsigned char* lds, const int K, const Sched& S, const Epi& E) {
    const int tid = threadIdx.x, wid = __builtin_amdgcn_readfirstlane(tid >> 6), lane = tid & 63, wr = wid >> 2, wc = wid & 3, fr = lane & 15, fq = lane >> 4;
    const int nt = K / BK;
    unsigned voffA[2], voffB[2]; int RA[2], CA[2];
#pragma unroll
    for (int i = 0; i < 2; ++i) { int R, C; stage_rc(tid * 16 + i * 8192, R, C); const int Rb = Epi::PERM ? ((R & ~31) + perm32(R & 31)) : R;
        voffA[i] = (unsigned)(R * K + C) * 2u; voffB[i] = (unsigned)(Rb * K + C) * 2u; RA[i] = R; CA[i] = C; }
    const size_t kstep = (size_t)(BK * 2);
    const size_t hstep = (size_t)HALF * K * 2;
    const unsigned ldsw = (unsigned)wid * 1024u;
    const int aoff = lds_byte(wr * 64 + fr, fq * 8), boff = lds_byte(wc * 32 + fr, fq * 8);
#define PG8_SA(b, h) (((b) * 2 + (h)) * HTB)
#define PG8_SB(b, h) ((4 + (b) * 2 + (h)) * HTB)
#define PG8_STAGE(bufoff, gbase, voff) do { _Pragma("unroll") for (int _i = 0; _i < 2; ++_i) \
        __builtin_amdgcn_global_load_lds((const unsigned*)((const char*)(gbase) + (voff)[_i]), (PG8_LAS unsigned*)(lds + (bufoff) + ldsw + _i * 8192), 16, 0, 0); } while (0)
#define PG8_STAGE_A(bufoff, gb, vo, h) do { if constexpr (Sched::GATHER) { PG8_STAGE(bufoff, gb, (vo)[h]); } else { PG8_STAGE(bufoff, (gb) + (h) * hstep, voffA); } } while (0)
#define PG8_LDA(dst, b, h) do { _Pragma("unroll") for (int m = 0; m < 4; ++m) _Pragma("unroll") for (int k = 0; k < 2; ++k) dst[m][k] = *(const PG8_LAS bf16x8*)(lds + PG8_SA(b, h) + aoff + m * 2048 + k * 1024); } while (0)
#define PG8_LDB(dst, b, h) do { _Pragma("unroll") for (int n = 0; n < 2; ++n) _Pragma("unroll") for (int k = 0; k < 2; ++k) dst[n][k] = *(const PG8_LAS bf16x8*)(lds + PG8_SB(b, h) + boff + n * 2048 + k * 1024); } while (0)
#define PG8_MMA(ai, bj, At, Bt) do { __builtin_amdgcn_s_setprio(1); _Pragma("unroll") for (int m = 0; m < 4; ++m) _Pragma("unroll") for (int n = 0; n < 2; ++n) _Pragma("unroll") for (int k = 0; k < 2; ++k) \
        acc[ai][bj][m][n] = __builtin_amdgcn_mfma_f32_16x16x32_bf16(Bt[n][k], At[m][k], acc[ai][bj][m][n], 0, 0, 0); __builtin_amdgcn_s_setprio(0); } while (0)
#define PG8_WAIT_V(n) asm volatile("s_waitcnt vmcnt(" #n ")" ::: "memory")
#define PG8_WAIT_L(n) asm volatile("s_waitcnt lgkmcnt(" #n ")" ::: "memory")
#define PG8_BAR __builtin_amdgcn_s_barrier()
#define PG8_SCHED __builtin_amdgcn_sched_barrier(0)
    Unit cur, nxt; int ui = 0;
    if (!S.next(0, cur)) return;
    f32x4 acc[2][2][4][2];
#pragma unroll
    for (int a = 0; a < 2; ++a)
#pragma unroll
        for (int b = 0; b < 2; ++b)
#pragma unroll
            for (int m = 0; m < 4; ++m)
#pragma unroll
                for (int n = 0; n < 2; ++n) acc[a][b][m][n] = (f32x4){0.f, 0.f, 0.f, 0.f};
    bf16x8 At[4][2], B0[2][2], B1[2][2];
    unsigned cvo[2][2], nvo[2][2];
#pragma unroll
    for (int h = 0; h < 2; ++h)
#pragma unroll
        for (int i = 0; i < 2; ++i) { cvo[h][i] = Sched::GATHER ? (S.row(cur, h * HALF + RA[i]) * (unsigned)K + (unsigned)CA[i]) * 2u : 0u; nvo[h][i] = cvo[h][i]; }
    const char* cA = S.a_ptr(cur); const char* cB = S.b_ptr(cur);
    PG8_STAGE(PG8_SB(0, 0), cB, voffB); PG8_STAGE(PG8_SB(0, 1), cB + hstep, voffB); PG8_STAGE_A(PG8_SA(0, 0), cA, cvo, 0); PG8_STAGE_A(PG8_SA(0, 1), cA, cvo, 1);
    if (wr == 1) PG8_BAR;
    PG8_WAIT_V(2); PG8_BAR;
    PG8_STAGE(PG8_SB(1, 0), cB + kstep, voffB); PG8_STAGE_A(PG8_SA(1, 0), cA + kstep, cvo, 0); PG8_STAGE(PG8_SB(1, 1), cB + hstep + kstep, voffB);
    PG8_WAIT_V(6); PG8_BAR;
    for (;;) {
        const bool has_next = S.next(ui + 1, nxt);
        const char* nA = has_next ? S.a_ptr(nxt) : cA; const char* nB = has_next ? S.b_ptr(nxt) : cB;
        if constexpr (Sched::GATHER) {
#pragma unroll
            for (int h = 0; h < 2; ++h)
#pragma unroll
                for (int i = 0; i < 2; ++i) nvo[h][i] = has_next ? (S.row(nxt, h * HALF + RA[i]) * (unsigned)K + (unsigned)CA[i]) * 2u : cvo[h][i];
        }
        for (int t = 0; t < nt; t += 2) {
            const bool last = (t == nt - 2);
            const char* a1 = cA + (size_t)(t + 1) * kstep;
            const char* a2 = last ? nA : cA + (size_t)(t + 2) * kstep; const char* b2 = last ? nB : cB + (size_t)(t + 2) * kstep;
            const char* a3 = a2 + kstep; const char* b3 = b2 + kstep;
            unsigned vo2[2][2];
#pragma unroll
            for (int h = 0; h < 2; ++h)
#pragma unroll
                for (int i = 0; i < 2; ++i) vo2[h][i] = last ? nvo[h][i] : cvo[h][i];
            PG8_LDB(B0, 0, 0); PG8_LDB(B1, 0, 1); PG8_SCHED; PG8_LDA(At, 0, 0); PG8_STAGE_A(PG8_SA(1, 1), a1, cvo, 1);
            PG8_WAIT_V(8); PG8_WAIT_L(0); PG8_BAR; PG8_MMA(0, 0, At, B0); PG8_MMA(0, 1, At, B1); PG8_BAR; PG8_SCHED;
            PG8_LDA(At, 0, 1); PG8_STAGE(PG8_SB(0, 0), b2, voffB); PG8_STAGE(PG8_SB(0, 1), b2 + hstep, voffB); PG8_STAGE_A(PG8_SA(0, 0), a2, vo2, 0);
            PG8_WAIT_V(8); PG8_WAIT_L(0); PG8_BAR; PG8_MMA(1, 0, At, B0); PG8_MMA(1, 1, At, B1); PG8_BAR; PG8_SCHED;
            PG8_LDB(B0, 1, 0); PG8_LDB(B1, 1, 1); PG8_SCHED; PG8_LDA(At, 1, 0); PG8_STAGE_A(PG8_SA(0, 1), a2, vo2, 1);
            PG8_WAIT_V(8); PG8_WAIT_L(0); PG8_BAR; PG8_MMA(0, 0, At, B0); PG8_MMA(0, 1, At, B1); PG8_BAR; PG8_SCHED;
            PG8_LDA(At, 1, 1); PG8_STAGE(PG8_SB(1, 0), b3, voffB); PG8_STAGE(PG8_SB(1, 1), b3 + hstep, voffB); PG8_STAGE_A(PG8_SA(1, 0), a3, vo2, 0);
            PG8_WAIT_V(8); PG8_WAIT_L(0); PG8_BAR; PG8_MMA(1, 0, At, B0); PG8_MMA(1, 1, At, B1); PG8_BAR; PG8_SCHED;
        }
        if constexpr (ALIGN_EPI) { if (wr == 0) PG8_BAR; }
        E(acc, cur, wr, wc, fr, fq);
        if (!has_next) break;
#pragma unroll
        for (int a = 0; a < 2; ++a)
#pragma unroll
            for (int b = 0; b < 2; ++b)
#pragma unroll
                for (int m = 0; m < 4; ++m)
#pragma unroll
                    for (int n = 0; n < 2; ++n) acc[a][b][m][n] = (f32x4){0.f, 0.f, 0.f, 0.f};
        cur = nxt; cA = nA; cB = nB; ++ui;
#pragma unroll
        for (int h = 0; h < 2; ++h)
#pragma unroll
            for (int i = 0; i < 2; ++i) cvo[h][i] = nvo[h][i];
        if constexpr (ALIGN_EPI) { if (wr == 1) PG8_BAR; }
    }
    PG8_WAIT_V(0);
    if constexpr (!ALIGN_EPI) { if (wr == 0) PG8_BAR; }
    PG8_BAR;
#undef PG8_SA
#undef PG8_SB
#undef PG8_STAGE
#undef PG8_STAGE_A
#undef PG8_LDA
#undef PG8_LDB
#undef PG8_MMA
#undef PG8_WAIT_V
#undef PG8_WAIT_L
#undef PG8_BAR
#undef PG8_SCHED
}
}

namespace mu {
constexpr int MR = 320, RWU = 80, NMU = 5, ABYTES = MR * 64 * 2, BBYTES = 128 * 64 * 2;
constexpr int GAIN_OFF = 2 * ABYTES + 2 * BBYTES;
__device__ __forceinline__ int lds_byte(int r, int c) { const int st = (r >> 4) * 2 + (c >> 5), ob = (r & 15) * 64 + (c & 31) * 2; return st * 1024 + (ob ^ (((ob >> 9) & 1) << 5)); }
__device__ __forceinline__ void stage_rc(int b, int& R, int& C) { const int st = b >> 10, sb = b & 1023, swz = sb ^ (((sb >> 9) & 1) << 5); R = (st >> 1) * 16 + swz / 64; C = (st & 1) * 32 + (swz % 64) / 2; }
template <int MODE>
__device__ __forceinline__ void moe_unit(PG8_LAS unsigned char* lds, int e, int cb, int slot0  , int nv  , const bf16_t* A, const int* slot_tok,
                                         const float* W0, const float* W1, bf16_t* OUT, const float* slot_rs  , const int* slot_dst) {
    constexpr int K = MODE == 0 ? 4096 : 512, nt = K / 64, LDB = MODE == 0 ? 512 : 4096, RB = LDB * 4  ;
    const int tid = threadIdx.x, wid = __builtin_amdgcn_readfirstlane(tid >> 6), lane = tid & 63, wr = wid >> 1, wc = wid & 1, fr = lane & 15, fq = lane >> 4;
    unsigned aoff[NMU];
#pragma unroll
    for (int i = 0; i < NMU; ++i) { int R, C; stage_rc(wid * 1024 + i * 8192 + lane * 16, R, C); const int w4 = R / RWU, r = 4 * (R - RWU * w4) + w4;
        const unsigned row = r < nv ? (MODE == 0 ? (unsigned)slot_tok[slot0 + r] : (unsigned)(slot0 + r)) : (MODE == 0 ? 0u : (unsigned)slot0); aoff[i] = (row * (unsigned)K + (unsigned)C) * 2u; }
    const int jj0 = 2 * (lane & 31), typ = lane >> 5;
    const int R0 = MODE == 0 ? 64 * (jj0 >> 5) + 32 * typ + 16 * ((jj0 >> 4) & 1) + (jj0 & 15) : 2 * lane;
    const char* Bb = MODE == 0 ? (const char*)((typ ? W1 : W0) + (size_t)e * K * LDB + 64 * cb + jj0) + (size_t)(8 * wid) * RB
                               : (const char*)(W0 + (size_t)e * K * LDB + 128 * cb + 2 * lane) + (size_t)(8 * wid) * RB;
    const unsigned bw0 = (unsigned)(R0 * 128 + ((wid ^ ((R0 >> 1) & 7)) * 16)), bw1 = bw0 + 128u;
    const int nvw = (nv - wr + 3) >> 2, mcnt = nvw <= 0 ? 0 : (((nvw + 15) >> 4) > NMU ? NMU : ((nvw + 15) >> 4));
#define MU_SA(b) (lds + (b) * ABYTES)
#define MU_SB(b) (lds + 2 * ABYTES + (b) * BBYTES)
#define MU_GLDS_A(buf, kt) do { _Pragma("unroll") for (int i = 0; i < NMU; ++i) \
        __builtin_amdgcn_global_load_lds((const unsigned*)((const char*)A + aoff[i] + (size_t)(kt) * 128), (PG8_LAS unsigned*)(MU_SA(buf) + wid * 1024 + i * 8192), 16, 0, 0); } while (0)
#define MU_B_ISSUE(sb, kt) do { const char* kb_ = Bb + (size_t)(kt) * (64 * (size_t)RB); _Pragma("unroll") for (int j = 0; j < 8; ++j) { const char* p_ = kb_ + (size_t)j * RB; \
        asm volatile("global_load_dwordx2 %0, %1, off" : "=&v"(sb[j]) : "v"(p_) : "memory"); } } while (0)
#define MU_B_WAIT(sb, N) asm volatile("s_waitcnt vmcnt(%8)" : "+v"(sb[0]), "+v"(sb[1]), "+v"(sb[2]), "+v"(sb[3]), "+v"(sb[4]), "+v"(sb[5]), "+v"(sb[6]), "+v"(sb[7]) : "n"(N) : "memory")
#define MU_G_LOAD(ga, kt) do { const PG8_LAS f32x4* gk_ = (const PG8_LAS f32x4*)(lds + GAIN_OFF) + 16 * (kt) + 2 * wid; const f32x4 ga_ = gk_[0], gb_ = gk_[1]; \
        ga[0] = ga_[0]; ga[1] = ga_[1]; ga[2] = ga_[2]; ga[3] = ga_[3]; ga[4] = gb_[0]; ga[5] = gb_[1]; ga[6] = gb_[2]; ga[7] = gb_[3]; } while (0)
#define MU_B_WRITE(sb, buf, ga) do { u32x4 w0_, w1_; w0_.x = cvtpk(sb[0].x * ga[0], sb[1].x * ga[1]); w0_.y = cvtpk(sb[2].x * ga[2], sb[3].x * ga[3]); w0_.z = cvtpk(sb[4].x * ga[4], sb[5].x * ga[5]); w0_.w = cvtpk(sb[6].x * ga[6], sb[7].x * ga[7]); \
        w1_.x = cvtpk(sb[0].y * ga[0], sb[1].y * ga[1]); w1_.y = cvtpk(sb[2].y * ga[2], sb[3].y * ga[3]); w1_.z = cvtpk(sb[4].y * ga[4], sb[5].y * ga[5]); w1_.w = cvtpk(sb[6].y * ga[6], sb[7].y * ga[7]); \
        *(PG8_LAS u32x4*)(MU_SB(buf) + bw0) = w0_; *(PG8_LAS u32x4*)(MU_SB(buf) + bw1) = w1_; } while (0)
#define MU_COMPUTE(buf) do { _Pragma("unroll") for (int ks = 0; ks < 2; ++ks) { bf16x8 At[NMU], Bf[4]; \
        _Pragma("unroll") for (int n = 0; n < 4; ++n) { const int R_ = 64 * wc + 16 * n + fr; Bf[n] = *(const PG8_LAS bf16x8*)(MU_SB(buf) + R_ * 128 + (((4 * ks + fq) ^ ((R_ >> 1) & 7)) * 16)); } \
        _Pragma("unroll") for (int m = 0; m < NMU; ++m) if (m < mcnt) At[m] = *(const PG8_LAS bf16x8*)(MU_SA(buf) + lds_byte(RWU * wr + 16 * m + fr, 32 * ks + 8 * fq)); \
        _Pragma("unroll") for (int m = 0; m < NMU; ++m) if (m < mcnt) { _Pragma("unroll") for (int n = 0; n < 4; ++n) acc[m][n] = __builtin_amdgcn_mfma_f32_16x16x32_bf16(Bf[n], At[m], acc[m][n], 0, 0, 0); } \
        __builtin_amdgcn_sched_barrier(0); } } while (0)
#define MU_END(last) do { if (last) asm volatile("s_waitcnt vmcnt(0)" ::: "memory"); else asm volatile("s_waitcnt vmcnt(8)" ::: "memory"); \
        asm volatile("s_waitcnt lgkmcnt(0)" ::: "memory"); __builtin_amdgcn_s_barrier(); asm volatile("" ::: "memory"); } while (0)
    f32x4 acc[NMU][4];
#pragma unroll
    for (int m = 0; m < NMU; ++m)
#pragma unroll
        for (int n = 0; n < 4; ++n) acc[m][n] = (f32x4){0.f, 0.f, 0.f, 0.f};
    f32x2 s0[8], s1[8];
    float g0[8], g1[8];
    MU_GLDS_A(0, 0); MU_B_ISSUE(s0, 0); MU_G_LOAD(g0, 0); MU_B_ISSUE(s1, 1); MU_G_LOAD(g1, 1);
    MU_B_WAIT(s0, 8); MU_B_WRITE(s0, 0, g0); __builtin_amdgcn_sched_barrier(0); MU_B_ISSUE(s0, 2); MU_G_LOAD(g0, 2);
    asm volatile("s_waitcnt vmcnt(16)" ::: "memory");
    asm volatile("s_waitcnt lgkmcnt(0)" ::: "memory"); __builtin_amdgcn_s_barrier(); asm volatile("" ::: "memory");
#pragma unroll 1
    for (int t = 0; t < nt; t += 2) {
        if (t + 2 < nt) MU_B_WAIT(s1, 8); else MU_B_WAIT(s1, 0);
        MU_B_WRITE(s1, 1, g1); __builtin_amdgcn_sched_barrier(0); MU_GLDS_A(1, t + 1); __builtin_amdgcn_sched_barrier(0);
        if (t + 3 < nt) { MU_B_ISSUE(s1, t + 3); MU_G_LOAD(g1, t + 3); }
        MU_COMPUTE(0);
        MU_END(t + 3 >= nt);
        if (t + 2 < nt) { MU_B_WAIT(s0, 8); MU_B_WRITE(s0, 0, g0); __builtin_amdgcn_sched_barrier(0); MU_GLDS_A(0, t + 2); __builtin_amdgcn_sched_barrier(0); }
        if (t + 4 < nt) { MU_B_ISSUE(s0, t + 4); MU_G_LOAD(g0, t + 4); }
        MU_COMPUTE(1);
        MU_END(t + 4 >= nt);
    }
#pragma unroll
    for (int m = 0; m < NMU; ++m) if (m < mcnt) { const int r = 4 * (16 * m + fr) + wr;
        if (r < nv) { const int slot = slot0 + r; const float rs = slot_rs[slot];
            if (MODE == 0) {
#pragma unroll
                for (int n = 0; n < 2; ++n) { float h[4];
#pragma unroll
                    for (int i = 0; i < 4; ++i) { const float g = acc[m][n][i] * rs, up = acc[m][n + 2][i] * rs; h[i] = g * __builtin_amdgcn_rcpf(1.0f + __expf(-g)) * up; }
                    u32x2 w; w.x = cvtpk(h[0], h[1]); w.y = cvtpk(h[2], h[3]); *(u32x2*)(OUT + (size_t)slot * DFF + 64 * cb + 32 * wc + 16 * n + 4 * fq) = w; }
            } else { const int dst = slot_dst[slot];
#pragma unroll
                for (int n = 0; n < 4; ++n) { const f32x4 v = acc[m][n] * rs; u32x2 w; w.x = cvtpk(v[0], v[1]); w.y = cvtpk(v[2], v[3]); *(u32x2*)(OUT + (size_t)dst * D + 128 * cb + 64 * wc + 16 * n + 4 * fq) = w; } } } }
#undef MU_SA
#undef MU_SB
#undef MU_GLDS_A
#undef MU_B_ISSUE
#undef MU_B_WAIT
#undef MU_B_WRITE
#undef MU_G_LOAD
#undef MU_COMPUTE
#undef MU_END
}

constexpr int DR = 320, DRW = 80, DNM = 5, DABYTES = DR * 64 * 2;
__device__ __forceinline__ void moe_down_stream(PG8_LAS unsigned char* lds, int e, int cb0, int slot0, int nv, const bf16_t* HIDp, const float* Wd, bf16_t* Y, const float* slot_w, const int* slot_dst) {
    constexpr int K = 512, NT = 64, RB = 4096 * 4;
    const int tid = threadIdx.x, wid = __builtin_amdgcn_readfirstlane(tid >> 6), lane = tid & 63, wr = wid >> 1, wc = wid & 1, fr = lane & 15, fq = lane >> 4;
    unsigned aoff[5];
#pragma unroll
    for (int i = 0; i < 5; ++i) { int R, C; stage_rc(wid * 1024 + i * 8192 + lane * 16, R, C); const int w4 = R / DRW; int r = 4 * (R - DRW * w4) + w4; r = r < nv ? r : r % nv;
        aoff[i] = ((unsigned)(slot0 + r) * (unsigned)K + (unsigned)C) * 2u; }
    const int R0 = 2 * lane;
    const char* Bb = (const char*)(Wd + (size_t)e * K * 4096 + 128 * cb0 + 2 * lane) + (size_t)(8 * wid) * RB;
    const unsigned bw0 = (unsigned)(R0 * 128 + ((wid ^ ((R0 >> 1) & 7)) * 16)), bw1 = bw0 + 128u;
    const int nvw = (nv - wr + 3) >> 2, mcnt = nvw <= 0 ? 0 : (((nvw + 15) >> 4) > DNM ? DNM : ((nvw + 15) >> 4));
    unsigned amask = 0u;
#pragma unroll
    for (int i = 0; i < 5; ++i) { const int grp = 4 * i + (wid >> 1), w4 = grp / DNM, mf = grp % DNM, nv4 = (nv - w4 + 3) >> 2, mc4 = nv4 <= 0 ? 0 : ((nv4 + 15) >> 4); if (mf < mc4) amask |= 1u << i; }
    int dstv[DNM]; float wv[DNM];
#pragma unroll
    for (int m = 0; m < DNM; ++m) { const int r = 4 * (16 * m + fr) + wr; const bool ok = (m < mcnt) && (16 * m + fr < DRW) && (r < nv); dstv[m] = ok ? slot_dst[slot0 + r] : -1; wv[m] = ok ? slot_w[slot0 + r] : 0.f; }
    asm volatile("s_waitcnt vmcnt(0)" : "+v"(dstv[0]), "+v"(dstv[1]), "+v"(dstv[2]), "+v"(dstv[3]), "+v"(dstv[4]), "+v"(wv[0]), "+v"(wv[1]), "+v"(wv[2]), "+v"(wv[3]), "+v"(wv[4]) :: "memory");
#define MD_SA(b) (lds + (b) * DABYTES)
#define MD_SB(b) (lds + 2 * DABYTES + (b) * BBYTES)
#define MD_GLDS_A(buf, tau) do { _Pragma("unroll") for (int i = 0; i < 5; ++i) if (amask & (1u << i)) \
        __builtin_amdgcn_global_load_lds((const unsigned*)((const char*)HIDp + aoff[i] + (size_t)((tau) & 7) * 128), (PG8_LAS unsigned*)(MD_SA(buf) + wid * 1024 + i * 8192), 16, 0, 0); } while (0)
#define MD_B_ISSUE(sb, tau) do { const char* kb_ = Bb + (size_t)((tau) >> 3) * 512 + (size_t)((tau) & 7) * (64 * (size_t)RB); _Pragma("unroll") for (int j = 0; j < 8; ++j) { const char* p_ = kb_ + (size_t)j * RB; \
        asm volatile("global_load_dwordx2 %0, %1, off" : "=&v"(sb[j]) : "v"(p_) : "memory"); } } while (0)
#define MD_B_WAIT(sb, N) asm volatile("s_waitcnt vmcnt(%8)" : "+v"(sb[0]), "+v"(sb[1]), "+v"(sb[2]), "+v"(sb[3]), "+v"(sb[4]), "+v"(sb[5]), "+v"(sb[6]), "+v"(sb[7]) : "n"(N) : "memory")
#define MD_B_WRITE(sb, buf) do { u32x4 w0_, w1_; w0_.x = cvtpk(sb[0].x, sb[1].x); w0_.y = cvtpk(sb[2].x, sb[3].x); w0_.z = cvtpk(sb[4].x, sb[5].x); w0_.w = cvtpk(sb[6].x, sb[7].x); \
        w1_.x = cvtpk(sb[0].y, sb[1].y); w1_.y = cvtpk(sb[2].y, sb[3].y); w1_.z = cvtpk(sb[4].y, sb[5].y); w1_.w = cvtpk(sb[6].y, sb[7].y); \
        *(PG8_LAS u32x4*)(MD_SB(buf) + bw0) = w0_; *(PG8_LAS u32x4*)(MD_SB(buf) + bw1) = w1_; } while (0)
#define MD_COMPUTE(buf) do { _Pragma("unroll") for (int ks = 0; ks < 2; ++ks) { bf16x8 At[DNM], Bf[4]; \
        _Pragma("unroll") for (int n = 0; n < 4; ++n) { const int R_ = 64 * wc + 16 * n + fr; Bf[n] = *(const PG8_LAS bf16x8*)(MD_SB(buf) + R_ * 128 + (((4 * ks + fq) ^ ((R_ >> 1) & 7)) * 16)); } \
        _Pragma("unroll") for (int m = 0; m < DNM; ++m) if (m < mcnt) At[m] = *(const PG8_LAS bf16x8*)(MD_SA(buf) + lds_byte(DRW * wr + 16 * m + fr, 32 * ks + 8 * fq)); \
        _Pragma("unroll") for (int m = 0; m < DNM; ++m) if (m < mcnt) { _Pragma("unroll") for (int n = 0; n < 4; ++n) acc[m][n] = __builtin_amdgcn_mfma_f32_16x16x32_bf16(Bf[n], At[m], acc[m][n], 0, 0, 0); } \
        __builtin_amdgcn_sched_barrier(0); } } while (0)
#define MD_END(last) do { if (last) asm volatile("s_waitcnt vmcnt(0)" ::: "memory"); else asm volatile("s_waitcnt vmcnt(8)" ::: "memory"); \
        asm volatile("s_waitcnt lgkmcnt(0)" ::: "memory"); __builtin_amdgcn_s_barrier(); asm volatile("" ::: "memory"); } while (0)
    f32x4 acc[DNM][4];
#pragma unroll
    for (int m = 0; m < DNM; ++m)
#pragma unroll
        for (int n = 0; n < 4; ++n) acc[m][n] = (f32x4){0.f, 0.f, 0.f, 0.f};
    f32x2 s0[8], s1[8];
    MD_GLDS_A(0, 0); MD_B_ISSUE(s0, 0); MD_B_ISSUE(s1, 1);
    MD_B_WAIT(s0, 8); MD_B_WRITE(s0, 0); __builtin_amdgcn_sched_barrier(0); MD_B_ISSUE(s0, 2);
    asm volatile("s_waitcnt vmcnt(16)" ::: "memory");
    asm volatile("s_waitcnt lgkmcnt(0)" ::: "memory"); __builtin_amdgcn_s_barrier(); asm volatile("" ::: "memory");
#pragma unroll 1
    for (int t = 0; t < NT; t += 2) {
        if (t + 2 < NT) MD_B_WAIT(s1, 8); else MD_B_WAIT(s1, 0);
        MD_B_WRITE(s1, 1); __builtin_amdgcn_sched_barrier(0); MD_GLDS_A(1, t + 1); __builtin_amdgcn_sched_barrier(0);
        if (t + 3 < NT) MD_B_ISSUE(s1, t + 3);
        MD_COMPUTE(0);
        MD_END(t + 3 >= NT);
        if (t + 2 < NT) { MD_B_WAIT(s0, 8); MD_B_WRITE(s0, 0); __builtin_amdgcn_sched_barrier(0); MD_GLDS_A(0, t + 2); __builtin_amdgcn_sched_barrier(0); }
        if (t + 4 < NT) MD_B_ISSUE(s0, t + 4);
        MD_COMPUTE(1);
        MD_END(t + 4 >= NT);
        if (((t + 1) & 7) == 7) {
            const int cb = cb0 + ((t + 1) >> 3);
#pragma unroll
            for (int m = 0; m < DNM; ++m) { if (dstv[m] >= 0) {
#pragma unroll
                    for (int n = 0; n < 4; ++n) { const f32x4 v = acc[m][n] * wv[m]; u32x2 w; w.x = cvtpk(v[0], v[1]); w.y = cvtpk(v[2], v[3]); *(u32x2*)(Y + (size_t)dstv[m] * D + 128 * cb + 64 * wc + 16 * n + 4 * fq) = w; } }
#pragma unroll
                for (int n = 0; n < 4; ++n) acc[m][n] = (f32x4){0.f, 0.f, 0.f, 0.f}; } }
    }
#undef MD_SA
#undef MD_SB
#undef MD_GLDS_A
#undef MD_B_ISSUE
#undef MD_B_WAIT
#undef MD_B_WRITE
#undef MD_COMPUTE
#undef MD_END
}
}

constexpr int NWAVES = 8, NTHREADS = 512;
constexpr int N_PHASES = 11;
constexpr int MOE_TAB_OFF = 132096;
struct Args { const void* in[18]; float* out; unsigned char* ws; int ph_lo, ph_hi; };

struct Frame {
    LAS unsigned char* lds;
    int tid, lane, wave, G, bid;
    unsigned char* ws;
    const float *x, *g_mix, *w_in, *w2, *gb, *g_gla, *sinks, *w_out, *g_ffn, *rg_w, *rg_b, *re_w, *re_b, *wg, *wu, *wd, *g_fin;
    const int* pos;
    float* out;
};

template <int MODE>
__device__ __forceinline__ int dest_row(int n, int row_off) {
    if (MODE == 0) return row_off + n;
    if (MODE == 1) return n < 6144 ? n : (n < 6160 ? C_GA + (n - 6144) : n - 16);
    if (MODE == 2) return row_off + 256 * (n >> 7) + (n & 127);
    return row_off + 256 * (n >> 7) + 128 + (n & 127);
}
template <int MODE>
__device__ __forceinline__ void transpose_item(const float* W, int K, int N, bf16_t* WT, int row_off, LAS float* scr, int item, int lane) {
    const int nblk = (N + 31) / 32, nb = (item >> 3) % nblk, kb = (item & 7) + 8 * (item / (8 * nblk)), k0 = 64 * kb, n0 = 32 * nb;
    const bool nok = (n0 + (lane & 31)) < N;
    float tv[32];
#pragma unroll
    for (int i = 0; i < 32; ++i) { const int kk = 2 * i + (lane >> 5); tv[i] = nok ? W[(size_t)(k0 + kk) * N + n0 + (lane & 31)] : 0.f; }
#pragma unroll
    for (int i = 0; i < 32; ++i) { const int kk = 2 * i + (lane >> 5); scr[kk * 33 + (lane & 31)] = tv[i]; }
    LDS_WAIT(); asm volatile("" ::: "memory");
    const int c = lane & 7;
#pragma unroll
    for (int j = 0; j < 4; ++j) { const int n = (lane >> 3) + 8 * j; const LAS float* s = scr + (8 * c) * 33 + n;
        u32x4 o; o.x = pk2(s[0 * 33], s[1 * 33]); o.y = pk2(s[2 * 33], s[3 * 33]); o.z = pk2(s[4 * 33], s[5 * 33]); o.w = pk2(s[6 * 33], s[7 * 33]);
        if (n0 + n < N) *(u32x4*)(WT + (size_t)dest_row<MODE>(n0 + n, row_off) * K + k0 + 8 * c) = o; }
    LDS_WAIT(); asm volatile("" ::: "memory");
}
__device__ __forceinline__ void rms_row_to_bf16(int lane, const float* xrow, const float* g, bf16_t* orow) {
    const f32x4* xr = (const f32x4*)xrow + lane; const f32x4* gr = (const f32x4*)g + lane;
    f32x4 v[16]; float s = 0.f;
#pragma unroll
    for (int j = 0; j < 16; ++j) { v[j] = xr[64 * j]; s += (v[j].x * v[j].x + v[j].y * v[j].y) + (v[j].z * v[j].z + v[j].w * v[j].w); }
    const float rstd = 1.0f / sqrtf(wave_sum(s) * (1.f / D) + RMS_EPS);
    u32x2* o8 = (u32x2*)orow + lane;
#pragma unroll
    for (int j = 0; j < 16; ++j) { const f32x4 gg = gr[64 * j]; u32x2 w; w.x = pk2(v[j].x * rstd * gg.x, v[j].y * rstd * gg.y); w.y = pk2(v[j].z * rstd * gg.z, v[j].w * rstd * gg.w); o8[64 * j] = w; }
}

__device__ __forceinline__ void p0_prologue(Frame& F) {
    LAS float* scr = (LAS float*)(F.lds + F.wave * 16384);
    const int gw = F.bid * NWAVES + F.wave, NGW = F.G * NWAVES;
    bf16_t* WIN = (bf16_t*)(F.ws + WS_WIN); bf16_t* WOUT = (bf16_t*)(F.ws + WS_WOUT); bf16_t* WGU = (bf16_t*)(F.ws + WS_WGU); bf16_t* WD = (bf16_t*)(F.ws + WS_WD);
    constexpr int I_IN = 64 * 273, I_OUT = 64 * 128, I_G = 64 * 16, I_DN = 8 * 128;
    for (int it = gw; it < I_IN; it += NGW) transpose_item<1>(F.w_in, D, IN_COLS, WIN, 0, scr, it, F.lane);
    for (int it = gw; it < I_OUT; it += NGW) transpose_item<0>(F.w_out, D, D, WOUT, 0, scr, it, F.lane);

    { u32x4* z = (u32x4*)(WIN + (size_t)IN_COLS * D); const size_t n16 = (size_t)(LDP - IN_COLS) * D * 2 / 16;
      for (size_t i = (size_t)F.bid * NTHREADS + F.tid; i < n16; i += (size_t)F.G * NTHREADS) z[i] = (u32x4){0u, 0u, 0u, 0u}; }
    { bf16_t* RBH = (bf16_t*)(F.ws + WS_RB); bf16_t* RBL = RBH + 80 * D;
      for (int i = F.bid * NTHREADS + F.tid; i < 80 * D; i += F.G * NTHREADS) { const int c = i / D, k = i % D;
          float v = 0.f; if (c < 8) v = F.rg_w[k * 8 + c]; else if (c < 72) { const int g = (c - 8) >> 3, j = (c - 8) & 7; v = F.re_w[((size_t)g * D + k) * 8 + j]; }
          const unsigned h = f2bf(v); const float hf = __builtin_bit_cast(float, h << 16); RBH[i] = (bf16_t)h; RBL[i] = (bf16_t)f2bf(v - hf); } }
    { float* RC = (float*)(F.ws + WS_ROPE); float* RS = RC + M * 32;
      for (int i = F.bid * NTHREADS + F.tid; i < M * 32; i += F.G * NTHREADS) { const int m = i >> 5, j = i & 31;
          const float inv = exp2f(-(float)j * (13.287712379549449f / 32.0f));
          const float angf = (float)F.pos[m] * inv;
          const double a = (double)angf; const double tr = a * 0.15915494309189535; const double fr = tr - __builtin_rint(tr);
          const float r = (float)(fr * 6.283185307179586);
          RC[i] = cosf(r); RS[i] = sinf(r); } }
    { bf16_t* U = (bf16_t*)(F.ws + WS_U);
      for (int m = gw; m < M; m += NGW) rms_row_to_bf16(F.lane, F.x + (size_t)m * D, F.g_mix, U + (size_t)m * D); }
}

__device__ __forceinline__ int crow(int r, int hi) { return (r & 3) + 8 * (r >> 2) + 4 * hi; }
constexpr int SWA_KROW = 144;
__device__ __forceinline__ void rot8(const u32x4 x1, const u32x4 x2, const f32x4 c0, const f32x4 c1, const f32x4 s0, const f32x4 s1, float sc, u32x4& o1, u32x4& o2) {
    const unsigned a[4] = {x1.x, x1.y, x1.z, x1.w}, b[4] = {x2.x, x2.y, x2.z, x2.w};
    const float c[8] = {c0.x, c0.y, c0.z, c0.w, c1.x, c1.y, c1.z, c1.w}, s[8] = {s0.x, s0.y, s0.z, s0.w, s1.x, s1.y, s1.z, s1.w};
    unsigned r1[4], r2[4];
#pragma unroll
    for (int j = 0; j < 4; ++j) { const float a0 = bflo(a[j]), a1 = bfhi(a[j]), b0 = bflo(b[j]), b1 = bfhi(b[j]);
        r1[j] = cvtpk((a0 * c[2 * j] - b0 * s[2 * j]) * sc, (a1 * c[2 * j + 1] - b1 * s[2 * j + 1]) * sc);
        r2[j] = cvtpk((b0 * c[2 * j] + a0 * s[2 * j]) * sc, (b1 * c[2 * j + 1] + a1 * s[2 * j + 1]) * sc); }
    o1 = (u32x4){r1[0], r1[1], r1[2], r1[3]}; o2 = (u32x4){r2[0], r2[1], r2[2], r2[3]};
}
__device__ __forceinline__ void swa_unit(Frame& F, int b, int kvh, int qb) {
    const bf16_t* PROJ = (const bf16_t*)(F.ws + WS_PROJ); bf16_t* MIX = (bf16_t*)(F.ws + WS_MIX);
    const float* RC = (const float*)(F.ws + WS_ROPE); const float* RS = RC + M * 32;
    LAS unsigned char* Kl = F.lds; LAS unsigned char* Vl = F.lds + 192 * SWA_KROW;
    LAS float* wsf = (LAS float*)(F.lds + 2 * 192 * SWA_KROW) + F.wave * 64;
    LAS bf16_t* stg = (LAS bf16_t*)(F.lds + 2 * 192 * SWA_KROW + 2048) + F.wave * 2048;
    const int tid = F.tid, lane = F.lane, r32 = lane & 31, hi = lane >> 5;
    const int K0 = 64 * (qb - 2);
    const size_t rowb = (size_t)b * SEQ;
    for (int task = tid; task < 768; task += NTHREADS) { const int key = task >> 2, c = task & 3, kg = K0 + key;
        u32x4 o1 = (u32x4){0u, 0u, 0u, 0u}, o2 = o1;
        if (kg >= 0) { const bf16_t* src = PROJ + (rowb + kg) * LDP + C_SK + kvh * 64; const u32x4 x1 = *(const u32x4*)(src + 8 * c), x2 = *(const u32x4*)(src + 32 + 8 * c);
            const float* cs = RC + (rowb + kg) * 32 + 8 * c; const float* sn = RS + (rowb + kg) * 32 + 8 * c;
            rot8(x1, x2, *(const f32x4*)cs, *(const f32x4*)(cs + 4), *(const f32x4*)sn, *(const f32x4*)(sn + 4), 1.0f, o1, o2); }
        *(LAS u32x4*)(Kl + key * SWA_KROW + 16 * c) = o1; *(LAS u32x4*)(Kl + key * SWA_KROW + 64 + 16 * c) = o2; }
    for (int task = tid; task < 1536; task += NTHREADS) { const int key = task >> 3, c = task & 7, kg = K0 + key;
        u32x4 v = (u32x4){0u, 0u, 0u, 0u};
        if (kg >= 0) v = *(const u32x4*)(PROJ + (rowb + kg) * LDP + C_SV + kvh * 64 + 8 * c);
        *(LAS u32x4*)(Vl + key * SWA_KROW + 16 * c) = v; }
    __syncthreads();
    const int qh = kvh * 8 + F.wave;
    const float sink2 = F.sinks[qh] * 1.4426950408889634f;
#pragma unroll 1
    for (int sub = 0; sub < 2; ++sub) {
        const int qg = 64 * qb + 32 * sub + r32;
        bf16x8 qr[4];
        { const bf16_t* qsrc = PROJ + (rowb + qg) * LDP + C_SQ + qh * 64 + 8 * hi;
          const u32x4 x0 = *(const u32x4*)(qsrc), x1 = *(const u32x4*)(qsrc + 16), x2 = *(const u32x4*)(qsrc + 32), x3 = *(const u32x4*)(qsrc + 48);
          const float* cs = RC + (rowb + qg) * 32 + 8 * hi; const float* sn = RS + (rowb + qg) * 32 + 8 * hi;
          u32x4 o0, o1, o2, o3; const float sc = 0.125f * 1.4426950408889634f;
          rot8(x0, x2, *(const f32x4*)cs, *(const f32x4*)(cs + 4), *(const f32x4*)sn, *(const f32x4*)(sn + 4), sc, o0, o2);
          rot8(x1, x3, *(const f32x4*)(cs + 16), *(const f32x4*)(cs + 20), *(const f32x4*)(sn + 16), *(const f32x4*)(sn + 20), sc, o1, o3);
          qr[0] = __builtin_bit_cast(bf16x8, o0); qr[1] = __builtin_bit_cast(bf16x8, o1); qr[2] = __builtin_bit_cast(bf16x8, o2); qr[3] = __builtin_bit_cast(bf16x8, o3); }
        f32x16 p[5];
#pragma unroll
        for (int j = 0; j < 5; ++j) {
#pragma unroll
            for (int r = 0; r < 16; ++r) p[j][r] = 0.f;
#pragma unroll
            for (int d0 = 0; d0 < 4; ++d0) { const bf16x8 kf = *(const LAS bf16x8*)(Kl + (32 * sub + 32 * j + r32) * SWA_KROW + (16 * d0 + 8 * hi) * 2);
                p[j] = __builtin_amdgcn_mfma_f32_32x32x16_bf16(kf, qr[d0], p[j], 0, 0, 0); } }
        const int kneg = -(K0 + 32 * sub);
        const float NEG = -INFINITY;
#pragma unroll
        for (int j = 0; j < 5; ++j)
#pragma unroll
            for (int r = 0; r < 16; ++r) { const int c = crow(r, hi); bool ok = (32 * j >= kneg);
                if (j == 0) ok = ok && (c > r32); if (j == 4) ok = ok && (c <= r32);
                p[j][r] = ok ? p[j][r] : NEG; }
        float mx = sink2;
#pragma unroll
        for (int j = 0; j < 5; ++j)
#pragma unroll
            for (int r = 0; r < 16; ++r) mx = fmaxf(mx, p[j][r]);
        mx = fmaxf(mx, __shfl_xor(mx, 32));
        float sum = 0.f;
#pragma unroll
        for (int j = 0; j < 5; ++j)
#pragma unroll
            for (int r = 0; r < 16; ++r) { p[j][r] = __builtin_amdgcn_exp2f(p[j][r] - mx); sum += p[j][r]; }
        sum += __shfl_xor(sum, 32);
        sum += __builtin_amdgcn_exp2f(sink2 - mx);
        f32x16 o[2];
#pragma unroll
        for (int r = 0; r < 16; ++r) { o[0][r] = 0.f; o[1][r] = 0.f; }
        const int vrow0 = 32 * sub + 4 * hi + ((lane & 15) >> 2), vcol = ((lane >> 4) & 1) * 32 + (lane & 3) * 8;
#pragma unroll
        for (int j = 0; j < 5; ++j)
#pragma unroll
            for (int s = 0; s < 2; ++s) {
                u32x4 pw; pw.x = cvtpk(p[j][8 * s], p[j][8 * s + 1]); pw.y = cvtpk(p[j][8 * s + 2], p[j][8 * s + 3]); pw.z = cvtpk(p[j][8 * s + 4], p[j][8 * s + 5]); pw.w = cvtpk(p[j][8 * s + 6], p[j][8 * s + 7]);
                const bf16x8 pa = __builtin_bit_cast(bf16x8, pw);
#pragma unroll
                for (int d0 = 0; d0 < 2; ++d0) { const LAS unsigned char* vp = Vl + (vrow0 + 32 * j + 16 * s) * SWA_KROW + d0 * 64 + vcol;
                    const s16x4 lo = __builtin_bit_cast(s16x4, __builtin_amdgcn_ds_read_tr16_b64_v4i16((LAS s16x4*)vp));
                    const s16x4 hh = __builtin_bit_cast(s16x4, __builtin_amdgcn_ds_read_tr16_b64_v4i16((LAS s16x4*)(vp + 8 * SWA_KROW)));
                    const bf16x8 vf = (bf16x8){lo[0], lo[1], lo[2], lo[3], hh[0], hh[1], hh[2], hh[3]};
                    o[d0] = __builtin_amdgcn_mfma_f32_32x32x16_bf16(pa, vf, o[d0], 0, 0, 0); } }
        if (hi == 0) wsf[r32] = 1.0f / sum;
        LDS_WAIT();
#pragma unroll
        for (int r = 0; r < 16; ++r) { const int orow = crow(r, hi); const float rl = wsf[orow];
#pragma unroll
            for (int d0 = 0; d0 < 2; ++d0) stg[orow * 64 + d0 * 32 + r32] = (bf16_t)f2bf(o[d0][r] * rl); }
        LDS_WAIT();
#pragma unroll
        for (int i = 0; i < 4; ++i) { const int row = i * 8 + (lane >> 3), ch = lane & 7; const u32x4 v = *(const LAS u32x4*)(stg + row * 64 + ch * 8);
            *(u32x4*)(MIX + (rowb + 64 * qb + 32 * sub + row) * D + 2048 + qh * 64 + ch * 8) = v; }
        LDS_WAIT();
    }
    __syncthreads();
}

constexpr int GP_ROW = 136;
__device__ __forceinline__ void gla_prep_unit(Frame& F, int unit) {
    const int bh = unit >> 7, n = unit & 127, b = bh >> 3, h = bh & 7, tid = F.tid, lane = F.lane;
    const bf16_t* PROJ = (const bf16_t*)(F.ws + WS_PROJ);
    bf16_t* QIN = (bf16_t*)(F.ws + WS_QIN) + (size_t)unit * 64 * 128; bf16_t* KDT = (bf16_t*)(F.ws + WS_KDT) + (size_t)unit * 128 * 64;
    bf16_t* AM = (bf16_t*)(F.ws + WS_AM) + (size_t)unit * 64 * 64; float* DEC = (float*)(F.ws + WS_DEC) + (size_t)unit * 128;
    LAS float* gaS = (LAS float*)F.lds; LAS float* tot = gaS + 1024; LAS bf16_t* qinS = (LAS bf16_t*)(F.lds + 8192); LAS bf16_t* kinS = qinS + 64 * GP_ROW;
    const size_t m0 = (size_t)b * SEQ + 64 * n;
    const int d = tid & 127, cg = tid >> 7;
    bf16_t qv[16], kv[16];
#pragma unroll
    for (int i = 0; i < 16; ++i) { const bf16_t* pr = PROJ + (m0 + cg * 16 + i) * LDP + h * 128 + d; qv[i] = pr[C_GQ]; kv[i] = pr[C_GK]; }
    { const int c = tid >> 3, r2 = (tid & 7) * 2; const unsigned w = *(const unsigned*)(PROJ + (m0 + c) * LDP + C_GA + r2); gaS[c * 16 + r2] = bflo(w); gaS[c * 16 + r2 + 1] = bfhi(w); }
    float w2r[16];
#pragma unroll
    for (int r = 0; r < 16; ++r) w2r[r] = F.w2[r * 1024 + h * 128 + d];
    const float bias = F.gb[h * 128 + d];
    __syncthreads();
    float bl[16]; float run = 0.f;
#pragma unroll
    for (int i = 0; i < 16; ++i) { const int c = cg * 16 + i; float z = bias;
#pragma unroll
        for (int r4 = 0; r4 < 4; ++r4) { const f32x4 g4 = *(const LAS f32x4*)(gaS + c * 16 + 4 * r4); z += g4.x * w2r[4 * r4] + g4.y * w2r[4 * r4 + 1] + g4.z * w2r[4 * r4 + 2] + g4.w * w2r[4 * r4 + 3]; }
        const float ls = fminf(z, 0.f) - __logf(1.0f + __expf(-fabsf(z)));
        run += ls * (1.f / 16.f); bl[i] = run; }
    tot[cg * 128 + d] = run;
    __syncthreads();
    float offs = 0.f, blast = 0.f;
#pragma unroll
    for (int g = 0; g < 4; ++g) { const float t = tot[g * 128 + d]; blast += t; if (g < cg) offs += t; }
    const float eblast = __expf(blast);
    unsigned kd[8];
#pragma unroll
    for (int i = 0; i < 16; i += 2) { float kdv[2];
#pragma unroll
        for (int u = 0; u < 2; ++u) { const int c = cg * 16 + i + u; const float bb = bl[i + u] + offs;
            const float q = bf2f(qv[i + u]) * 0.08838834764831845f, k = bf2f(kv[i + u]);
            const float eb = __expf(bb), einv = __builtin_amdgcn_rcpf(eb);
            const float qin = q * eb, kin = k * einv; kdv[u] = kin * eblast;
            const bf16_t qb16 = (bf16_t)f2bf(qin); qinS[c * GP_ROW + d] = qb16; kinS[c * GP_ROW + d] = (bf16_t)f2bf(kin); QIN[c * 128 + d] = qb16; }
        kd[i >> 1] = pk2(kdv[0], kdv[1]); }
    *(u32x4*)(KDT + d * 64 + cg * 16) = (u32x4){kd[0], kd[1], kd[2], kd[3]}; *(u32x4*)(KDT + d * 64 + cg * 16 + 8) = (u32x4){kd[4], kd[5], kd[6], kd[7]};
    if (cg == 0) DEC[d] = eblast;
    __syncthreads();
    { const int mi = F.wave >> 1, fr = lane & 15, fq = lane >> 4;
#pragma unroll
      for (int t = 0; t < 2; ++t) { const int ni = 2 * (F.wave & 1) + t; f32x4 acc = (f32x4){0.f, 0.f, 0.f, 0.f};
          if (ni <= mi) {
#pragma unroll
              for (int ks = 0; ks < 4; ++ks) { const bf16x8 kf = *(const LAS bf16x8*)(kinS + (16 * ni + fr) * GP_ROW + 32 * ks + 8 * fq), qf = *(const LAS bf16x8*)(qinS + (16 * mi + fr) * GP_ROW + 32 * ks + 8 * fq);
                  acc = __builtin_amdgcn_mfma_f32_16x16x32_bf16(kf, qf, acc, 0, 0, 0); } }
          const int c = 16 * mi + fr, j0 = 16 * ni + 4 * fq; float v[4];
#pragma unroll
          for (int i = 0; i < 4; ++i) v[i] = (j0 + i <= c) ? acc[i] : 0.f;
          u32x2 w; w.x = pk2(v[0], v[1]); w.y = pk2(v[2], v[3]); *(u32x2*)(AM + c * 64 + j0) = w; } }
    __syncthreads();
}

constexpr int GS_AM = 0, GS_QIN = 8192, GS_KDT = 24576, GS_V = 40960, GS_DEC = 43008, GS_SLOT = 44032;
constexpr int GS_SB = 3 * GS_SLOT, GS_SBROW = 272, GS_SBBUF = 16 * GS_SBROW;
__device__ __forceinline__ void gs_load(Frame& F, int bh, int et, int n, int slot) {
    const int lane = F.lane, unit = bh * 128 + n, b = bh >> 3, h = bh & 7, wave = F.wave;
    LAS unsigned char* base = F.lds + slot * GS_SLOT;
    if (wave >= 1 && wave <= 4) { const int m = wave - 1;
        const char* am = (const char*)(F.ws + WS_AM) + (size_t)unit * 8192; const char* qin = (const char*)(F.ws + WS_QIN) + (size_t)unit * 16384;
#pragma unroll
        for (int i = 0; i < 2; ++i) { const int r = 16 * m + i * 8 + (lane >> 3), ch = (lane & 7) ^ (r & 7);
            __builtin_amdgcn_global_load_lds((const unsigned*)(am + r * 128 + ch * 16), (LAS unsigned*)(base + GS_AM + (2 * m + i) * 1024), 16, 0, 0); }
#pragma unroll
        for (int i = 0; i < 4; ++i) { const int r = 16 * m + i * 4 + (lane >> 4), ch = (lane & 15) ^ (r & 15);
            __builtin_amdgcn_global_load_lds((const unsigned*)(qin + r * 256 + ch * 16), (LAS unsigned*)(base + GS_QIN + (4 * m + i) * 1024), 16, 0, 0); }
    } else if (wave == 5 || wave == 6) { const char* kdt = (const char*)(F.ws + WS_KDT) + (size_t)unit * 16384; const int i0 = (wave - 5) * 8;
#pragma unroll
        for (int i = 0; i < 8; ++i) { const int r = (i0 + i) * 8 + (lane >> 3), ch = (lane & 7) ^ (r & 7);
            __builtin_amdgcn_global_load_lds((const unsigned*)(kdt + r * 128 + ch * 16), (LAS unsigned*)(base + GS_KDT + (i0 + i) * 1024), 16, 0, 0); }
    } else if (wave == 7) { const char* dec = (const char*)(F.ws + WS_DEC) + (size_t)unit * 512;
        const char* v = (const char*)((const bf16_t*)(F.ws + WS_PROJ) + ((size_t)b * SEQ + 64 * n) * LDP + C_GV + h * 256 + et * 16);
#pragma unroll
        for (int i = 0; i < 2; ++i) { const int r = i * 32 + (lane >> 1);
            __builtin_amdgcn_global_load_lds((const unsigned*)(v + (size_t)r * LDP * 2 + (lane & 1) * 16), (LAS unsigned*)(base + GS_V + i * 1024), 16, 0, 0); }
        __builtin_amdgcn_global_load_lds((const unsigned*)(dec + (lane & 31) * 16), (LAS unsigned*)(base + GS_DEC), 16, 0, 0);
    }
}
__device__ __forceinline__ void gs_vfrag(const LAS unsigned char* vbase, int lane, bf16x8 (&vf)[2]) {
    const unsigned a = (unsigned)(uintptr_t)(vbase + (8 * (lane >> 4) + ((lane & 15) >> 2)) * 32 + (lane & 3) * 8);
    s16x4 r0, r1, r2, r3;
    asm volatile("ds_read_b64_tr_b16 %0, %4\n\tds_read_b64_tr_b16 %1, %4 offset:128\n\tds_read_b64_tr_b16 %2, %4 offset:1024\n\tds_read_b64_tr_b16 %3, %4 offset:1152\n\ts_waitcnt lgkmcnt(0)"
                 : "=&v"(r0), "=&v"(r1), "=&v"(r2), "=&v"(r3) : "v"(a) : "memory");
    vf[0] = (bf16x8){r0[0], r0[1], r0[2], r0[3], r1[0], r1[1], r1[2], r1[3]}; vf[1] = (bf16x8){r2[0], r2[1], r2[2], r2[3], r3[0], r3[1], r3[2], r3[3]};
}
__device__ __forceinline__ void gs_wait_older(int wave, bool first) {
    if (wave >= 1 && wave <= 4) { if (first) asm volatile("s_waitcnt vmcnt(6)" ::: "memory"); else asm volatile("s_waitcnt vmcnt(14)" ::: "memory"); }
    else if (wave == 5 || wave == 6) asm volatile("s_waitcnt vmcnt(8)" ::: "memory");
    else if (wave == 7) asm volatile("s_waitcnt vmcnt(3)" ::: "memory");
}
__device__ __forceinline__ void gla_scan_chain(Frame& F, int chain) {
    const int bh = chain >> 4, et = chain & 15, b = bh >> 3, h = bh & 7, lane = F.lane, fr = lane & 15, fq = lane >> 4, wave = F.wave;
    bf16_t* ORAW = (bf16_t*)(F.ws + WS_ORAW);
    f32x4 S[8];
#pragma unroll
    for (int i = 0; i < 8; ++i) S[i] = (f32x4){0.f, 0.f, 0.f, 0.f};
    if (wave >= 1) { gs_load(F, bh, et, 0, 0); gs_load(F, bh, et, 1, 1); gs_wait_older(wave, true); }
    if (wave == 0) { for (int i = lane; i < GS_SBBUF / 16; i += 64) *(LAS u32x4*)(F.lds + GS_SB + i * 16) = (u32x4){0u, 0u, 0u, 0u}; }
    asm volatile("s_waitcnt lgkmcnt(0)" ::: "memory"); __builtin_amdgcn_s_barrier(); asm volatile("" ::: "memory");
#pragma unroll 1
    for (int n = 0; n < 128; ++n) {
        const LAS unsigned char* base = F.lds + (n % 3) * GS_SLOT;
        if (wave >= 1 && n + 2 < 128) gs_load(F, bh, et, n + 2, (n + 2) % 3);
        if (wave == 0) {
            bf16x8 vf[2]; gs_vfrag(base + GS_V, lane, vf);
            bf16x8 kf[8][2]; f32x4 dc[8];
#pragma unroll
            for (int mt = 0; mt < 8; ++mt) { const int r = 16 * mt + fr; dc[mt] = *(const LAS f32x4*)(base + GS_DEC + (16 * mt + 4 * fq) * 4);
#pragma unroll
                for (int ks = 0; ks < 2; ++ks) kf[mt][ks] = *(const LAS bf16x8*)(base + GS_KDT + r * 128 + (((4 * ks + fq) ^ (r & 7)) * 16)); }
            __builtin_amdgcn_sched_barrier(0);
            LAS unsigned char* sb = F.lds + GS_SB + ((n + 1) & 1) * GS_SBBUF + fr * GS_SBROW + 8 * fq;
#pragma unroll
            for (int mt = 0; mt < 8; ++mt) { f32x4 s = S[mt] * dc[mt];
                s = __builtin_amdgcn_mfma_f32_16x16x32_bf16(kf[mt][0], vf[0], s, 0, 0, 0); s = __builtin_amdgcn_mfma_f32_16x16x32_bf16(kf[mt][1], vf[1], s, 0, 0, 0); S[mt] = s; }
#pragma unroll
            for (int mt = 0; mt < 8; ++mt) { u32x2 w; w.x = cvtpk(S[mt][0], S[mt][1]); w.y = cvtpk(S[mt][2], S[mt][3]); *(LAS u32x2*)(sb + 32 * mt) = w; }
        } else if (wave <= 4) {
            const int m = wave - 1, r = 16 * m + fr;
            bf16x8 vf[2]; gs_vfrag(base + GS_V, lane, vf);
            const LAS unsigned char* sb = F.lds + GS_SB + (n & 1) * GS_SBBUF + fr * GS_SBROW + 16 * fq;
            bf16x8 af[2], qf[4], sf[4];
#pragma unroll
            for (int ks = 0; ks < 2; ++ks) af[ks] = *(const LAS bf16x8*)(base + GS_AM + r * 128 + (((4 * ks + fq) ^ (r & 7)) * 16));
#pragma unroll
            for (int ks = 0; ks < 4; ++ks) { qf[ks] = *(const LAS bf16x8*)(base + GS_QIN + r * 256 + (((4 * ks + fq) ^ (r & 15)) * 16)); sf[ks] = *(const LAS bf16x8*)(sb + 64 * ks); }
            __builtin_amdgcn_sched_barrier(0);
            f32x4 acc = (f32x4){0.f, 0.f, 0.f, 0.f};
#pragma unroll
            for (int ks = 0; ks < 2; ++ks) acc = __builtin_amdgcn_mfma_f32_16x16x32_bf16(af[ks], vf[ks], acc, 0, 0, 0);
#pragma unroll
            for (int ks = 0; ks < 4; ++ks) acc = __builtin_amdgcn_mfma_f32_16x16x32_bf16(qf[ks], sf[ks], acc, 0, 0, 0);
            bf16_t* op = ORAW + ((size_t)b * SEQ + 64 * n + 16 * m + 4 * fq) * 2048 + h * 256 + et * 16 + fr;
#pragma unroll
            for (int i = 0; i < 4; ++i) op[(size_t)i * 2048] = (bf16_t)f2bf(acc[i]);
        }
        if (wave >= 1) { if (n + 2 < 128) gs_wait_older(wave, false); else asm volatile("s_waitcnt vmcnt(0)" ::: "memory"); }
        asm volatile("s_waitcnt lgkmcnt(0)" ::: "memory"); __builtin_amdgcn_s_barrier(); asm volatile("" ::: "memory");
    }
    asm volatile("s_waitcnt vmcnt(0) lgkmcnt(0)" ::: "memory");
}
__device__ __forceinline__ void gla_norm(Frame& F) {
    const bf16_t* PROJ = (const bf16_t*)(F.ws + WS_PROJ); const bf16_t* ORAW = (const bf16_t*)(F.ws + WS_ORAW); bf16_t* MIX = (bf16_t*)(F.ws + WS_MIX);
    const int gw = F.bid * NWAVES + F.wave, NGW = F.G * NWAVES, lane = F.lane;
    const int col = 8 * (lane & 31);
    const f32x4 gn0 = *(const f32x4*)(F.g_gla + col), gn1 = *(const f32x4*)(F.g_gla + col + 4);
    const float gn[8] = {gn0.x, gn0.y, gn0.z, gn0.w, gn1.x, gn1.y, gn1.z, gn1.w};
    for (int m = gw; m < M; m += NGW) {
        u32x4 ow[4], gw4[4];
#pragma unroll
        for (int j = 0; j < 4; ++j) { const int hc = (2 * j + (lane >> 5)) * 256 + col; ow[j] = *(const u32x4*)(ORAW + (size_t)m * 2048 + hc); gw4[j] = *(const u32x4*)(PROJ + (size_t)m * LDP + C_GR + hc); }
#pragma unroll
        for (int j = 0; j < 4; ++j) { const unsigned a[4] = {ow[j].x, ow[j].y, ow[j].z, ow[j].w}, g[4] = {gw4[j].x, gw4[j].y, gw4[j].z, gw4[j].w};
            float o[8], ss = 0.f;
#pragma unroll
            for (int i = 0; i < 4; ++i) { o[2 * i] = bflo(a[i]); o[2 * i + 1] = bfhi(a[i]); ss += o[2 * i] * o[2 * i] + o[2 * i + 1] * o[2 * i + 1]; }
#pragma unroll
            for (int s = 1; s < 32; s <<= 1) ss += __shfl_xor(ss, s);
            const float rstd = 1.0f / sqrtf(ss * (1.f / 256.f) + RMS_EPS);
            unsigned w[4];
#pragma unroll
            for (int i = 0; i < 4; ++i) { const float g0 = bflo(g[i]), g1 = bfhi(g[i]);
                w[i] = pk2(o[2 * i] * rstd * gn[2 * i] * (g0 / (1.f + __expf(-g0))), o[2 * i + 1] * rstd * gn[2 * i + 1] * (g1 / (1.f + __expf(-g1)))); }
            *(u32x4*)(MIX + (size_t)m * D + (2 * j + (lane >> 5)) * 256 + col) = (u32x4){w[0], w[1], w[2], w[3]}; }
    }
}

struct RtLoad { u32x4 x[2]; f32x4 g[2]; };
struct RtW { bf16x8 wh[5], wl[5]; };
__device__ __forceinline__ void rt_load(RtLoad& L, const bf16_t* h0, const bf16_t* h1, const float* gp, int ko) {
    L.x[0] = *(const u32x4*)(h0 + ko); L.x[1] = *(const u32x4*)(h1 + ko);
    L.g[0] = *(const f32x4*)(gp + ko); L.g[1] = *(const f32x4*)(gp + ko + 4);
}
__device__ __forceinline__ void rt_step(const RtLoad& L, const bf16_t* bh, const bf16_t* bl, f32x4 (&acc)[2][5], float (&ss)[2], int ko) {
    RtW W;
#pragma unroll
    for (int n = 0; n < 5; ++n) { W.wh[n] = *(const bf16x8*)(bh + (size_t)n * 16 * D + ko); W.wl[n] = *(const bf16x8*)(bl + (size_t)n * 16 * D + ko); }
    bf16x8 ahi[2], alo[2];
#pragma unroll
    for (int mi = 0; mi < 2; ++mi) { const u32x4 xw = L.x[mi]; const f32x4 xa = (f32x4){bflo(xw.x), bfhi(xw.x), bflo(xw.y), bfhi(xw.y)}, xb = (f32x4){bflo(xw.z), bfhi(xw.z), bflo(xw.w), bfhi(xw.w)};
        ss[mi] += (xa.x * xa.x + xa.y * xa.y) + (xa.z * xa.z + xa.w * xa.w) + (xb.x * xb.x + xb.y * xb.y) + (xb.z * xb.z + xb.w * xb.w);
        const float u[8] = {xa.x * L.g[0].x, xa.y * L.g[0].y, xa.z * L.g[0].z, xa.w * L.g[0].w, xb.x * L.g[1].x, xb.y * L.g[1].y, xb.z * L.g[1].z, xb.w * L.g[1].w};
        unsigned hb[8]; float lo[8];
#pragma unroll
        for (int j = 0; j < 8; ++j) { hb[j] = f2bf(u[j]); lo[j] = u[j] - __builtin_bit_cast(float, hb[j] << 16); }
        const u32x4 hw = (u32x4){hb[0] | (hb[1] << 16), hb[2] | (hb[3] << 16), hb[4] | (hb[5] << 16), hb[6] | (hb[7] << 16)};
        const u32x4 lw = (u32x4){pk2(lo[0], lo[1]), pk2(lo[2], lo[3]), pk2(lo[4], lo[5]), pk2(lo[6], lo[7])};
        ahi[mi] = __builtin_bit_cast(bf16x8, hw); alo[mi] = __builtin_bit_cast(bf16x8, lw); }
#pragma unroll
    for (int n = 0; n < 5; ++n)
#pragma unroll
        for (int mi = 0; mi < 2; ++mi) { acc[mi][n] = __builtin_amdgcn_mfma_f32_16x16x32_bf16(ahi[mi], W.wh[n], acc[mi][n], 0, 0, 0);
            acc[mi][n] = __builtin_amdgcn_mfma_f32_16x16x32_bf16(alo[mi], W.wh[n], acc[mi][n], 0, 0, 0);
            acc[mi][n] = __builtin_amdgcn_mfma_f32_16x16x32_bf16(ahi[mi], W.wl[n], acc[mi][n], 0, 0, 0); }
}
__device__ __forceinline__ void p5_router(Frame& F) {
    const bf16_t* H = (const bf16_t*)(F.ws + WS_HB);
    const bf16_t* RBH = (const bf16_t*)(F.ws + WS_RB); const bf16_t* RBL = RBH + 80 * D;
    unsigned* ctl = (unsigned*)(F.ws + WS_CTL);
    LAS float* part = (LAS float*)F.lds;
    LAS float* lg = part + 4 * 64 * 80;
    LAS float* ssp = lg + 64 * 80;
    LAS float* rs = ssp + 256;
    const int lane = F.lane, wave = F.wave;
    for (int tile = F.bid; tile < M / 64; tile += F.G) {
        const int m0 = tile * 64;
        { const int tg = wave & 1, kq = wave >> 1, fr = lane & 15, fq = lane >> 4;
          f32x4 acc[2][5];
#pragma unroll
          for (int a = 0; a < 2; ++a)
#pragma unroll
              for (int n = 0; n < 5; ++n) acc[a][n] = (f32x4){0.f, 0.f, 0.f, 0.f};
          float ss[2] = {0.f, 0.f};
          const size_t roff = (size_t)(m0 + 32 * tg + fr) * D + kq * 1024 + 8 * fq;
          const bf16_t* h0 = H + roff; const bf16_t* h1 = h0 + (size_t)16 * D;
          const float* gp = F.g_ffn + kq * 1024 + 8 * fq;
          const bf16_t* bh = RBH + (size_t)fr * D + kq * 1024 + 8 * fq; const bf16_t* bl = RBL + (size_t)fr * D + kq * 1024 + 8 * fq;
          RtLoad La, Lb; rt_load(La, h0, h1, gp, 0);
#pragma unroll 1
          for (int ks = 0; ks < 32; ks += 2) {
              rt_load(Lb, h0, h1, gp, (ks + 1) * 32); rt_step(La, bh, bl, acc, ss, ks * 32);
              if (ks + 2 < 32) rt_load(La, h0, h1, gp, (ks + 2) * 32);
              rt_step(Lb, bh, bl, acc, ss, (ks + 1) * 32); }
#pragma unroll
          for (int mi = 0; mi < 2; ++mi) { float s = ss[mi]; s += __shfl_xor(s, 16); s += __shfl_xor(s, 32); if (fq == 0) ssp[kq * 64 + 32 * tg + 16 * mi + fr] = s;
#pragma unroll
              for (int n = 0; n < 5; ++n)
#pragma unroll
                  for (int i = 0; i < 4; ++i) part[(kq * 64 + 32 * tg + 16 * mi + 4 * fq + i) * 80 + 16 * n + fr] = acc[mi][n][i]; } }
        __syncthreads();
        if (F.tid < 64) { const float s = (ssp[F.tid] + ssp[64 + F.tid]) + (ssp[128 + F.tid] + ssp[192 + F.tid]); const float r = 1.0f / sqrtf(s * (1.f / D) + RMS_EPS); rs[F.tid] = r; }
        __syncthreads();
        for (int i = F.tid; i < 64 * 80; i += NTHREADS) lg[i] = ((part[i] + part[5120 + i]) + (part[10240 + i] + part[15360 + i])) * rs[i / 80];
        __syncthreads();
        if (F.tid < 64) { const int tk = F.tid, m = m0 + tk; const LAS float* L = lg + tk * 80;
            float gl[8]; int g = 0; float gm;
#pragma unroll
            for (int c = 0; c < 8; ++c) gl[c] = L[c] + F.rg_b[c];
            gm = gl[0];
#pragma unroll
            for (int c = 1; c < 8; ++c) if (gl[c] > gm) { gm = gl[c]; g = c; }
            float gs = 0.f;
#pragma unroll
            for (int c = 0; c < 8; ++c) gs += expf(gl[c] - gm);
            const float gw = 1.0f / gs;
            float el[8];
#pragma unroll
            for (int j = 0; j < 8; ++j) el[j] = L[8 + g * 8 + j] + F.re_b[g * 8 + j];
            int i0 = 0; float e0 = el[0];
#pragma unroll
            for (int j = 1; j < 8; ++j) if (el[j] > e0) { e0 = el[j]; i0 = j; }
            int i1 = -1; float e1 = -3.0e38f;
#pragma unroll
            for (int j = 0; j < 8; ++j) if (j != i0 && el[j] > e1) { e1 = el[j]; i1 = j; }
            const float tt = expf(e1 - e0); const float w0 = 1.0f / (1.0f + tt), w1 = tt / (1.0f + tt);
            const int x0 = g * 8 + i0, x1 = g * 8 + i1;
            const size_t s0 = (size_t)x0 * CAPS + atomicAdd(ctl + CW_CNT + x0, 1u), s1 = (size_t)x1 * CAPS + atomicAdd(ctl + CW_CNT + x1, 1u); const float rr = rs[tk];
            int* t2tok = (int*)(F.ws + WS_T2 + T2_TOK); float* t2w = (float*)(F.ws + WS_T2 + T2_W); int* t2dst = (int*)(F.ws + WS_T2 + T2_DST); float* t2rs = (float*)(F.ws + WS_T2 + T2_RS);
            t2tok[s0] = m; t2w[s0] = gw * w0; t2dst[s0] = 2 * m; t2rs[s0] = rr; t2tok[s1] = m; t2w[s1] = gw * w1; t2dst[s1] = 2 * m + 1; t2rs[s1] = rr; }
        __syncthreads();
    }
}
__device__ __forceinline__ void p6_tables(Frame& F) {
    unsigned* ctl = (unsigned*)(F.ws + WS_CTL);
    const int* tok_e = (const int*)(F.ws + WS_TAB + T_TOKE); const float* tok_w = (const float*)(F.ws + WS_TAB + T_TOKW); const int* tok_r = (const int*)(F.ws + WS_TAB + T_TOKR);
    int* slot_tok = (int*)(F.ws + WS_TAB + T_SLOTTOK); float* slot_w = (float*)(F.ws + WS_TAB + T_SLOTW); int* slot_dst = (int*)(F.ws + WS_TAB + T_SLOTDST); int* tile_e = (int*)(F.ws + WS_TAB + T_TILEE);
    float* slot_rs = (float*)(F.ws + WS_TAB + T_SLOTRS); const float* RSTD = (const float*)(F.ws + WS_TAB + T_RSTD);
    LAS int* off = (LAS int*)F.lds; LAS int* cnt = off + 80;
    if (F.tid < 64) cnt[F.tid] = (int)ctl[CW_CNT + F.tid];
    __syncthreads();
    if (F.tid == 0) { int a = 0; for (int e = 0; e < 64; ++e) { off[e] = a; a += (cnt[e] + 255) & ~255; } off[64] = a; }
    __syncthreads();
    for (int i = F.bid * NTHREADS + F.tid; i < 2 * M; i += F.G * NTHREADS) { const int e = tok_e[i], s = off[e] + tok_r[i]; slot_tok[s] = i >> 1; slot_w[s] = tok_w[i]; slot_dst[s] = i; slot_rs[s] = RSTD[i >> 1]; }
    for (int e = F.bid; e < 64; e += F.G) for (int s = off[e] + cnt[e] + F.tid; s < off[e + 1]; s += NTHREADS) { slot_tok[s] = 0; slot_w[s] = 0.f; slot_dst[s] = -1; slot_rs[s] = 0.f; }
    if (F.bid == 1 % F.G) { int* eoff = (int*)(F.ws + WS_TAB + T_EOFF); if (F.tid < 65) eoff[F.tid] = off[F.tid];
        if (F.tid < 8) { int* ul = (int*)(F.ws + WS_TAB + T_ULUP) + F.tid * UL_UP; int n = 0;
            for (int e = F.tid; e < 64; e += 8) { const int nrb = (cnt[e] + mu::MR - 1) / mu::MR; for (int rb = 0; rb < nrb; ++rb) for (int cb = 0; cb < 8; ++cb) ul[n++] = (e << 16) | (rb << 8) | cb; }
            ctl[CW_NUP + F.tid] = (unsigned)n; }
        else if (F.tid >= 64 && F.tid < 72) { const int x = F.tid - 64; int* ul = (int*)(F.ws + WS_TAB + T_ULDN) + x * UL_DN; int n = 0;
            for (int e = x; e < 64; e += 8) { const int nrb = (cnt[e] + mu::DR - 1) / mu::DR; for (int rb = 0; rb < nrb; ++rb) for (int cq = 0; cq < 4; ++cq) ul[n++] = (e << 16) | (rb << 8) | cq; }
            ctl[CW_NDN + x] = (unsigned)n; } }
    if (F.bid == 0) { if (F.tid < 64) for (int t = off[F.tid] >> 8; t < (off[F.tid + 1] >> 8); ++t) tile_e[t] = F.tid;
        if (F.tid == 0) ctl[CW_NT] = (unsigned)(off[64] >> 8); }
}
__device__ __forceinline__ void p9_row(float* O, const bf16_t* Hb, const bf16_t* Y, const LAS float* g  , int m, int mnext, int lane, u32x2 (&v)[16], u32x2 (&vn)[16]) {
    const u32x2* y0 = (const u32x2*)(Y + (size_t)(2 * m) * D) + lane; const u32x2* y1 = (const u32x2*)(Y + (size_t)(2 * m + 1) * D) + lane;
    u32x2 a[16], b[16];
#pragma unroll
    for (int j = 0; j < 16; ++j) { a[j] = y0[64 * j]; b[j] = y1[64 * j]; }
    if (mnext < M) { const u32x2* xn = (const u32x2*)(Hb + (size_t)mnext * D) + lane;
#pragma unroll
        for (int j = 0; j < 16; ++j) vn[j] = xn[64 * j]; }
    f32x4* xr = (f32x4*)(O + (size_t)m * D) + lane; const LAS f32x4* gr = (const LAS f32x4*)g + lane; float s = 0.f;
    f32x4 t[16];
#pragma unroll
    for (int j = 0; j < 16; ++j) { t[j].x = bflo(v[j].x) + (bflo(a[j].x) + bflo(b[j].x)); t[j].y = bfhi(v[j].x) + (bfhi(a[j].x) + bfhi(b[j].x)); t[j].z = bflo(v[j].y) + (bflo(a[j].y) + bflo(b[j].y)); t[j].w = bfhi(v[j].y) + (bfhi(a[j].y) + bfhi(b[j].y));
        s += (t[j].x * t[j].x + t[j].y * t[j].y) + (t[j].z * t[j].z + t[j].w * t[j].w); }
    const float rstd = 1.0f / sqrtf(wave_sum(s) * (1.f / D) + RMS_EPS);
    asm volatile("" ::: "memory"); __builtin_amdgcn_sched_barrier(0);
#pragma unroll
    for (int j = 0; j < 16; ++j) { const f32x4 gg = gr[64 * j]; xr[64 * j] = (f32x4){t[j].x * rstd * gg.x, t[j].y * rstd * gg.y, t[j].z * rstd * gg.z, t[j].w * rstd * gg.w}; if ((j & 3) == 3) __builtin_amdgcn_sched_barrier(0); }
}
__device__ __forceinline__ void p9_final(Frame& F) {
    const bf16_t* Y = (const bf16_t*)(F.ws + WS_Y); const bf16_t* Hb = (const bf16_t*)(F.ws + WS_HB); float* O = F.out;
    const int gw = F.bid * NWAVES + F.wave, NGW = F.G * NWAVES, lane = F.lane;
    LAS float* gl = (LAS float*)F.lds;
    __syncthreads(); for (int i = F.tid; i < D / 4; i += NTHREADS) ((LAS f32x4*)gl)[i] = ((const f32x4*)F.g_fin)[i]; __syncthreads();
    u32x2 va[16], vb[16];
    int m = gw;
    if (m < M) { const u32x2* xr = (const u32x2*)(Hb + (size_t)m * D) + lane;
#pragma unroll
        for (int j = 0; j < 16; ++j) va[j] = xr[64 * j]; }
    while (m < M) {
        p9_row(O, Hb, Y, gl, m, m + NGW, lane, va, vb); m += NGW; if (m >= M) break;
        p9_row(O, Hb, Y, gl, m, m + NGW, lane, vb, va); m += NGW;
    }
}

__global__ void __launch_bounds__(NTHREADS, 2) hymba_fwd(Args args) {
    extern __shared__ __attribute__((aligned(16))) unsigned char lds[];
    Frame F;
    F.lds = (LAS unsigned char*)lds;
    F.tid = threadIdx.x; F.lane = F.tid & 63; F.wave = __builtin_amdgcn_readfirstlane(F.tid >> 6);
    F.G = gridDim.x; F.bid = blockIdx.x; F.ws = args.ws; F.out = args.out;
    F.x = (const float*)args.in[0]; F.pos = (const int*)args.in[1]; F.g_mix = (const float*)args.in[2]; F.w_in = (const float*)args.in[3]; F.w2 = (const float*)args.in[4];
    F.gb = (const float*)args.in[5]; F.g_gla = (const float*)args.in[6]; F.sinks = (const float*)args.in[7]; F.w_out = (const float*)args.in[8]; F.g_ffn = (const float*)args.in[9];
    F.rg_w = (const float*)args.in[10]; F.rg_b = (const float*)args.in[11]; F.re_w = (const float*)args.in[12]; F.re_b = (const float*)args.in[13];
    F.wg = (const float*)args.in[14]; F.wu = (const float*)args.in[15]; F.wd = (const float*)args.in[16]; F.g_fin = (const float*)args.in[17];
    volatile LAS unsigned* MISC = (volatile LAS unsigned*)(F.lds + MISC_OFF);
    for (int u = F.tid; u < (LDS_BYTES - LDSCTL_OFF) / 4; u += NTHREADS) ((LAS unsigned*)(F.lds + LDSCTL_OFF))[u] = 0u;
    __syncthreads();
    unsigned* ctl = (unsigned*)(F.ws + WS_CTL);
    XcdBarrier bar; bar.bar = ctl + CW_BAR; bar.x = 0; bar.st = nullptr;
    if (MK_N_LAUNCHES == 1) bar = xcd_barrier_post(ctl + CW_BAR, MISC + 8);
    const int lo = args.ph_lo, hi = args.ph_hi;
#define IN(k) (lo <= (k) && (k) < hi)
#define SEAM(k) do { if (IN(k) && IN((k) + 1)) xcd_barrier(bar); } while (0)
    bf16_t* U = (bf16_t*)(F.ws + WS_U); bf16_t* PROJ = (bf16_t*)(F.ws + WS_PROJ); bf16_t* MIX = (bf16_t*)(F.ws + WS_MIX);

    if (IN(0)) REP(0) { p0_prologue(F); } SEAM(0);
    if (IN(1)) REP(1) {
        pg8::DenseSched S; S.init(U, (const bf16_t*)(F.ws + WS_WIN), M, LDP, D, F.G, F.bid);
        pg8::EpiBf16 E{PROJ, LDP};
        pg8::gemm_phase<pg8::EpiBf16, pg8::DenseSched, true>(F.lds, D, S, E);
    } SEAM(1);
    if (IN(2)) {
        REP(20) for (int u = F.bid; u < 2048; u += F.G) gla_prep_unit(F, u);
        REP(21) for (int u = F.bid; u < 1024; u += F.G) swa_unit(F, u >> 9, (u >> 7) & 3, u & 127);
    } SEAM(2);
    if (IN(3)) REP(3) { for (int c = F.bid; c < 256; c += F.G) { const int cc = (F.G == 256) ? (((c & 7) * 2 + (c >> 7)) << 4) | ((c >> 3) & 15) : c; gla_scan_chain(F, cc); } } SEAM(3);
    if (IN(4)) REP(4) { gla_norm(F); } SEAM(4);
    if (IN(5)) REP(5) {
        pg8::DenseSched S; S.init(MIX, (const bf16_t*)(F.ws + WS_WOUT), M, D, D, F.G, F.bid);
        pg8::EpiResBf16 E{F.x, (bf16_t*)(F.ws + WS_HB), D};
        pg8::gemm_phase<pg8::EpiResBf16, pg8::DenseSched, true>(F.lds, D, S, E);
    } SEAM(5);
    if (IN(6)) { p5_router(F); } SEAM(6);
    LAS int* eo = (LAS int*)(F.lds + MOE_TAB_OFF); LAS int* ecnt = eo + 80;
#define MOE_OFFSETS() do { __syncthreads(); if (F.tid < 64) { const int c_ = (int)ctl[CW_CNT + F.tid]; int s_ = c_; _Pragma("unroll") for (int d_ = 1; d_ < 64; d_ <<= 1) { const int t_ = __shfl_up(s_, d_); if (F.lane >= d_) s_ += t_; } \
        eo[F.tid + 1] = s_; ecnt[F.tid] = c_; if (F.tid == 0) eo[0] = 0; } __syncthreads(); } while (0)
#define MOE_UNIT(idx_, x_, RMAX, CBN, e_, rb_, cb_, ok_) do { int b_ = 0; ok_ = false; for (int k_ = 0; k_ < 8; ++k_) { const int ee_ = (x_) + 8 * k_, n_ = ((ecnt[ee_] + (RMAX) - 1) / (RMAX)) * (CBN); \
        if ((idx_) < b_ + n_) { e_ = ee_; rb_ = ((idx_) - b_) / (CBN); cb_ = ((idx_) - b_) % (CBN); ok_ = true; break; } b_ += n_; } } while (0)
    if (IN(8)) REP(8) {
        __syncthreads(); for (int i = F.tid; i < D / 4; i += NTHREADS) ((LAS f32x4*)(F.lds + mu::GAIN_OFF))[i] = ((const f32x4*)F.g_ffn)[i];
        MOE_OFFSETS();
        const int x = F.bid & 7;
        for (int j = F.bid >> 3; ; j += F.G >> 3) { int e = 0, rb = 0, cb = 0; bool ok; MOE_UNIT(j, x, mu::MR, 8, e, rb, cb, ok); if (!ok) break;
            const int n = ecnt[e], nrb = (n + mu::MR - 1) / mu::MR, base = n / nrb, rem = n % nrb, r0 = rb * base + (rb < rem ? rb : rem), nv = base + (rb < rem ? 1 : 0);
            const long adj = (long)e * CAPS - eo[e];
            mu::moe_unit<0>(F.lds, e, cb, eo[e] + r0, nv, (const bf16_t*)(F.ws + WS_HB), (const int*)(F.ws + WS_T2 + T2_TOK) + adj, F.wg, F.wu, (bf16_t*)(F.ws + WS_HID), (const float*)(F.ws + WS_T2 + T2_RS) + adj, nullptr); }
    } SEAM(8);
    if (IN(9)) REP(9) {
        MOE_OFFSETS();
        const int x = F.bid & 7;
        for (int j = F.bid >> 3; ; j += F.G >> 3) { int e = 0, rb = 0, cq = 0; bool ok; MOE_UNIT(j, x, mu::DR, 4, e, rb, cq, ok); if (!ok) break;
            const int n = ecnt[e], nrb = (n + mu::DR - 1) / mu::DR, base = n / nrb, rem = n % nrb, r0 = rb * base + (rb < rem ? rb : rem), nv = base + (rb < rem ? 1 : 0);
            const long adj = (long)e * CAPS - eo[e];
            mu::moe_down_stream(F.lds, e, 8 * cq, eo[e] + r0, nv, (const bf16_t*)(F.ws + WS_HID), F.wd, (bf16_t*)(F.ws + WS_Y), (const float*)(F.ws + WS_T2 + T2_W) + adj, (const int*)(F.ws + WS_T2 + T2_DST) + adj); }
    } SEAM(9);
#undef MOE_OFFSETS
#undef MOE_UNIT
    if (IN(10)) { p9_final(F); }
#undef IN
#undef SEAM
}

extern "C" void kernel_launch(void* const* d_in, const int* in_sizes, int n_in, void* d_out, int out_size, void* d_ws, size_t ws_size, hipStream_t stream) {
    static int grid = 0;
    if (grid == 0) {
        if (n_in != 18 || out_size != M * D || ws_size < WS_END) { fprintf(stderr, "kernel_launch: unexpected shapes (n_in %d, out %d, ws %zu < %zu)\n", n_in, out_size, ws_size, (size_t)WS_END); grid = -1; return; }
        int dev = 0, cus = 0, per_cu = 0;
        if (hipGetDevice(&dev) != hipSuccess || hipDeviceGetAttribute(&cus, hipDeviceAttributeMultiprocessorCount, dev) != hipSuccess) { grid = -1; return; }
        if (hipFuncSetAttribute((const void*)hymba_fwd, hipFuncAttributeMaxDynamicSharedMemorySize, LDS_BYTES) != hipSuccess) { fprintf(stderr, "kernel_launch: hipFuncSetAttribute failed\n"); grid = -1; return; }
        if (hipOccupancyMaxActiveBlocksPerMultiprocessor(&per_cu, (const void*)hymba_fwd, NTHREADS, LDS_BYTES) != hipSuccess || per_cu < 1) { fprintf(stderr, "kernel_launch: occupancy query says %d\n", per_cu); }
        (void)hipGetLastError();
        grid = cus;
    }
    if (grid < 0) return;
    (void)in_sizes;
    if (hipMemsetAsync((char*)d_ws + WS_CTL, 0, CTL_ZERO_BYTES, stream) != hipSuccess) return;
    Args a{};
    for (int i = 0; i < 18; ++i) a.in[i] = d_in[i];
    a.out = (float*)d_out; a.ws = (unsigned char*)d_ws;
    if (MK_N_LAUNCHES == 1) { a.ph_lo = 0; a.ph_hi = N_PHASES; hipLaunchKernelGGL(hymba_fwd, dim3(grid), dim3(NTHREADS), LDS_BYTES, stream, a); }
    else for (int p = 0; p < N_PHASES; ++p) { a.ph_lo = p; a.ph_hi = p + 1; hipLaunchKernelGGL(hymba_fwd, dim3(grid), dim3(NTHREADS), LDS_BYTES, stream, a); }
}
```

```cpp
#include <hip/hip_runtime.h>
#include <cstdio>
#include <cstdint>

#ifndef MK_N_LAUNCHES
#define MK_N_LAUNCHES 1
#endif

#ifndef PROBE_DUP
#define PROBE_DUP -1
#endif
#define REP(k) for (int rep_ = 0; rep_ < ((PROBE_DUP) == (k) ? 2 : 1); ++rep_)
#define GAS __attribute__((address_space(1)))
#define LAS __attribute__((address_space(3)))
#define PG8_LAS __attribute__((address_space(3)))

typedef unsigned short bf16_t;
typedef short bf16x8 __attribute__((ext_vector_type(8)));
typedef float f32x4 __attribute__((ext_vector_type(4)));
typedef float f32x2 __attribute__((ext_vector_type(2)));
typedef unsigned u32x4 __attribute__((ext_vector_type(4)));
typedef unsigned u32x2 __attribute__((ext_vector_type(2)));

constexpr int D = 4096, BATCH = 2, SEQ = 8192, M = BATCH * SEQ;
constexpr int IN_COLS = 8720, LDP = 8960;
constexpr int C_GQ = 0, C_GK = 1024, C_GV = 2048, C_GR = 4096, C_SQ = 6144, C_SK = 8192, C_SV = 8448, C_GA = 8704;
constexpr int NEXP = 64, DFF = 512;
constexpr int MAXSLOT = 49152;
constexpr float RMS_EPS = 1e-6f;

constexpr size_t MiB = 1u << 20;
constexpr size_t WS_CTL = 0, CTL_ZERO_BYTES = 1 * MiB;
constexpr size_t WS_TAB = 1 * MiB;
constexpr size_t WS_ROPE = 8 * MiB;
constexpr size_t WS_RB = 14 * MiB;
constexpr size_t WS_WIN = 32 * MiB;
constexpr size_t WS_WOUT = 102 * MiB;
constexpr size_t WS_U = 134 * MiB;
constexpr size_t WS_MIX = 262 * MiB;
constexpr size_t WS_PROJ = 390 * MiB;
constexpr size_t WS_Y = 390 * MiB;
constexpr size_t WS_HB = 670 * MiB;
constexpr size_t WS_WGU = 670 * MiB;
constexpr size_t WS_T2 = 1182 * MiB;
constexpr size_t T2_TOK = 0, T2_W = 4 * MiB, T2_DST = 8 * MiB, T2_RS = 12 * MiB; constexpr int CAPS = 16384;
constexpr size_t WS_WD = 1182 * MiB;
constexpr size_t WS_HID = 1438 * MiB;
constexpr size_t WS_QIN = 1486 * MiB;
constexpr size_t WS_KDT = 1518 * MiB;
constexpr size_t WS_AM = 1550 * MiB;
constexpr size_t WS_DEC = 1566 * MiB;
constexpr size_t WS_ORAW = 1568 * MiB;
constexpr size_t WS_END = 1632 * MiB;
constexpr size_t T_TOKE = 0;
constexpr size_t T_TOKW = 256 * 1024;
constexpr size_t T_TOKR = 512 * 1024;
constexpr size_t T_SLOTTOK = 768 * 1024;
constexpr size_t T_SLOTW = 1024 * 1024;
constexpr size_t T_SLOTDST = 1280 * 1024;
constexpr size_t T_TILEE = 1536 * 1024;
constexpr int UL_UP = 2048, UL_DN = 8192;
constexpr size_t T_ULUP = 1800 * 1024;
constexpr size_t T_EOFF = 1900 * 1024;
constexpr size_t T_ULDN = 2048 * 1024;
constexpr size_t T_RSTD = 1540 * 1024;
constexpr size_t T_SLOTRS = 1604 * 1024;
constexpr int CW_CNT = 1024;
constexpr int CW_NT = 1100;
constexpr int CW_NUP = 1200, CW_NDN = 1216;
constexpr int CW_BAR = 4096;

constexpr int RING_BYTES = 141312;
constexpr int LDSCTL_OFF = RING_BYTES, MISC_OFF = LDSCTL_OFF + 320;
constexpr int LDS_BYTES = 142336;

#define LDS_WAIT() asm volatile("s_waitcnt lgkmcnt(0)" ::: "memory")
#define VM_WAIT() asm volatile("s_waitcnt vmcnt(0)" ::: "memory")
__device__ __forceinline__ unsigned f2bf(float f) { unsigned u = __builtin_bit_cast(unsigned, f); return (u + 0x7fffu + ((u >> 16) & 1u)) >> 16; }
__device__ __forceinline__ unsigned pk2(float lo, float hi) { return f2bf(lo) | (f2bf(hi) << 16); }
__device__ __forceinline__ float bf2f(unsigned short b) { return __builtin_bit_cast(float, ((unsigned)b) << 16); }
__device__ __forceinline__ float bflo(unsigned w) { return __builtin_bit_cast(float, w << 16); }
__device__ __forceinline__ float bfhi(unsigned w) { return __builtin_bit_cast(float, w & 0xffff0000u); }
__device__ __forceinline__ unsigned cvt_pk_bf16(float lo, float hi) { unsigned r; asm volatile("v_cvt_pk_bf16_f32 %0, %1, %2" : "=v"(r) : "v"(lo), "v"(hi)); return r; }
typedef float f32x16 __attribute__((ext_vector_type(16)));
typedef short s16x4 __attribute__((ext_vector_type(4)));
typedef __bf16 bf16x2_t __attribute__((ext_vector_type(2)));
__device__ __forceinline__ unsigned cvtpk(float lo, float hi) { f32x2 v = {lo, hi}; bf16x2_t b = __builtin_convertvector(v, bf16x2_t); return __builtin_bit_cast(unsigned, b); }
__device__ __forceinline__ float wave_sum(float v) {
#pragma unroll
    for (int o = 1; o < 64; o <<= 1) v += __shfl_xor(v, o);
    return v;
}

#define XB_TMO      128
#define XB_XCNT(j)  (256  + 64 * (j))
#define XB_XSUB(j)  (1280 + 64 * (j))
#define XB_XGEN(j)  (2304 + 64 * (j))
#define XB_TOP      3328
#define XB_TOPGEN   3392
#define XCD_BAR_WORDS 3456
#define XB_SPIN_CAP (1u << 18)

__device__ __forceinline__ unsigned xb_ld(unsigned* p)              { return __hip_atomic_load(p, __ATOMIC_RELAXED, __HIP_MEMORY_SCOPE_AGENT); }
__device__ __forceinline__ unsigned xb_add(unsigned* p, unsigned v) { return __hip_atomic_fetch_add(p, v, __ATOMIC_RELAXED, __HIP_MEMORY_SCOPE_AGENT); }
__device__ __forceinline__ unsigned xb_xcc_id() { return (unsigned)__builtin_amdgcn_s_getreg((3 << 11) | 20) & 0xFu; }
#define XB_SPIN(cond, bar) do { unsigned _sp = 0; while (cond) { __builtin_amdgcn_s_sleep(1); \
    if ((++_sp & 255u) == 0u) { if (xb_ld(&(bar)[XB_TMO])) break; if (_sp > XB_SPIN_CAP) { atomicAdd(&(bar)[XB_TMO], 1u); break; } } } } while (0)

struct XcdBarrier { unsigned* bar; unsigned x; volatile LAS unsigned* st; };

__device__ __forceinline__ XcdBarrier xcd_barrier_post(unsigned* bar, volatile LAS unsigned* st) {
    XcdBarrier b; b.bar = bar; b.x = xb_xcc_id(); b.st = st;
    if (threadIdx.x == 0) (void)xb_add(&bar[XB_XCNT(b.x)], 1u);
    return b;
}
__device__ __forceinline__ void xcd_barrier_complete(unsigned* bar, unsigned x, unsigned& nloc, unsigned& nx) {
    const unsigned G = gridDim.x * gridDim.y * gridDim.z;
    unsigned sum, cnt, mine, sp = 0u;
    for (;;) {
        sum = 0u; cnt = 0u; mine = 0u;
#pragma unroll
        for (unsigned j = 0; j < 16; ++j) { const unsigned c = xb_ld(&bar[XB_XCNT(j)]); sum += c; cnt += (c > 0u) ? 1u : 0u; mine = (j == x) ? c : mine; }
        if (sum == G) break;
        __builtin_amdgcn_s_sleep(1);
        if ((++sp & 255u) == 0u) { if (xb_ld(&bar[XB_TMO])) break; if (sp > XB_SPIN_CAP) { atomicAdd(&bar[XB_TMO], 1u); break; } }
    }
    nloc = mine > 0u ? mine : 1u; nx = cnt > 0u ? cnt : 1u;
}
__device__ __forceinline__ void xcd_barrier(const XcdBarrier& b) {
    asm volatile("s_waitcnt vmcnt(0)" ::: "memory");
    __syncthreads();
    if (threadIdx.x == 0) {
        unsigned* bar = b.bar;
        __builtin_amdgcn_s_waitcnt(0);
        unsigned nloc = b.st[0], nx = b.st[1];
        if (nloc == 0u) { xcd_barrier_complete(bar, b.x, nloc, nx); b.st[0] = nloc; b.st[1] = nx; }
        const unsigned old = xb_add(&bar[XB_XSUB(b.x)], 1u);
        const unsigned gen = old / nloc;
        if (old + 1u == (gen + 1u) * nloc) {
            __builtin_amdgcn_fence(__ATOMIC_RELEASE, "agent");
            asm volatile("s_waitcnt vmcnt(0)" ::: "memory");
            const unsigned og = xb_add(&bar[XB_TOP], 1u);
            const unsigned tg = og / nx;
            if (og + 1u == (tg + 1u) * nx) xb_add(&bar[XB_TOPGEN], 1u);
            else XB_SPIN(xb_ld(&bar[XB_TOPGEN]) == tg, bar);
            __builtin_amdgcn_fence(__ATOMIC_ACQUIRE, "agent");
            xb_add(&bar[XB_XGEN(b.x)], 1u);
            asm volatile("s_waitcnt vmcnt(0)" ::: "memory");
        } else {
            XB_SPIN(xb_ld(&bar[XB_XGEN(b.x)]) == gen, bar);
            __builtin_amdgcn_fence(__ATOMIC_ACQUIRE, "agent");
            asm volatile("s_waitcnt vmcnt(0)" ::: "memory");
        }
    }
    __syncthreads();
}

namespace pg8 {
constexpr int BM = 256, BK = 64, HALF = 128, HTB = HALF * BK * 2, STAGE_BYTES = 8 * HTB, NXCD = 8, WGM = 8;
__host__ __device__ __forceinline__ int lds_byte(int r, int c) { const int st = (r >> 4) * 2 + (c >> 5), rr = r & 15, cc = c & 31, ob = rr * 64 + cc * 2; return st * 1024 + (ob ^ (((ob >> 9) & 1) << 5)); }
__host__ __device__ __forceinline__ void stage_rc(int b, int& R, int& C) { const int st = b / 1024, sb = b % 1024, swz = sb ^ (((sb >> 9) & 1) << 5); R = (st >> 1) * 16 + swz / 64; C = (st & 1) * 32 + (swz % 64) / 2; }
__host__ __device__ __forceinline__ int perm32(int rho) { const int n = rho >> 4, i = rho & 15; return 8 * (i >> 2) + 4 * n + (i & 3); }

struct Unit { int pm, pn, e; };

struct DenseSched {
    static constexpr bool GATHER = false;
    const bf16_t* A; const bf16_t* Bt; int K;
    int nM, nN, nwg, G, c;
    __device__ void init(const bf16_t* A_, const bf16_t* Bt_, int Mr, int N, int K_, int G_, int c_) { A = A_; Bt = Bt_; K = K_; nM = Mr / BM; nN = N / BM; nwg = nM * nN; G = G_; c = c_; }
    __device__ bool next(int i, Unit& u) const {
        const long L = (long)i * G + c; if (L >= nwg) return false;
        int wgid = (int)L; { const int q = nwg / NXCD, r = nwg % NXCD, xcd = wgid % NXCD, off = wgid / NXCD; wgid = (xcd < r ? xcd * (q + 1) : r * (q + 1) + (xcd - r) * q) + off; }
        const int nig = WGM * nN, gid = wgid / nig, fm = gid * WGM, gsz = (nM - fm) < WGM ? (nM - fm) : WGM;
        u.pm = fm + ((wgid % nig) % gsz); u.pn = (wgid % nig) / gsz; u.e = 0; return true;
    }
    __device__ __forceinline__ const char* a_ptr(const Unit& u) const { return (const char*)A + (size_t)u.pm * BM * K * 2; }
    __device__ __forceinline__ const char* b_ptr(const Unit& u) const { return (const char*)Bt + (size_t)u.pn * BM * K * 2; }
    __device__ __forceinline__ unsigned row(const Unit&, int) const { return 0u; }
};
struct MoeUpSched {
    static constexpr bool GATHER = true;
    const bf16_t* A; const bf16_t* Bt; const int* tile_e; const int* slot_tok; int ntiles, G, c;
    __device__ bool next(int i, Unit& u) const {
        if ((G & 7) == 0) { const int x = c & 7, idx = (c >> 3) + (G >> 3) * i; u.pm = 8 * (idx >> 2) + x; u.pn = idx & 3; if (u.pm >= ntiles) return false; }
        else { const int L = i * G + c; if (L >= ntiles * 4) return false; u.pm = L >> 2; u.pn = L & 3; }
        u.e = tile_e[u.pm]; return true;
    }
    __device__ __forceinline__ const char* a_ptr(const Unit&) const { return (const char*)A; }
    __device__ __forceinline__ const char* b_ptr(const Unit& u) const { return (const char*)Bt + ((size_t)u.e * 1024 + (size_t)u.pn * 256) * 4096 * 2; }
    __device__ __forceinline__ unsigned row(const Unit& u, int r) const { return (unsigned)slot_tok[u.pm * 256 + r]; }
};
struct MoeDownSched {
    static constexpr bool GATHER = false;
    const bf16_t* A; const bf16_t* Bt; const int* tile_e; int ntiles, G, c;
    __device__ bool next(int i, Unit& u) const {
        const int L = i * G + c; if (L >= ntiles * 16) return false;
        u.pm = L >> 4; u.pn = L & 15; u.e = tile_e[u.pm]; return true;
    }
    __device__ __forceinline__ const char* a_ptr(const Unit& u) const { return (const char*)A + (size_t)u.pm * 256 * 512 * 2; }
    __device__ __forceinline__ const char* b_ptr(const Unit& u) const { return (const char*)Bt + ((size_t)u.e * 4096 + (size_t)u.pn * 256) * 512 * 2; }
    __device__ __forceinline__ unsigned row(const Unit&, int) const { return 0u; }
};

struct EpiBf16 {
    static constexpr bool PERM = true;
    bf16_t* O; int ldc;
    __device__ __forceinline__ void operator()(const f32x4 (&acc)[2][2][4][2], const Unit& u, int wr, int wc, int fr, int fq) const {
        const int row0 = u.pm * BM + wr * 64 + fr, col0 = u.pn * BM + wc * 32 + 8 * fq;
#pragma unroll
        for (int ai = 0; ai < 2; ++ai)
#pragma unroll
            for (int m = 0; m < 4; ++m) { bf16_t* rowp = O + (size_t)(row0 + ai * HALF + m * 16) * ldc + col0;
#pragma unroll
                for (int bj = 0; bj < 2; ++bj) { const f32x4 v0 = acc[ai][bj][m][0], v1 = acc[ai][bj][m][1];
                    u32x4 w; w.x = cvt_pk_bf16(v0[0], v0[1]); w.y = cvt_pk_bf16(v0[2], v0[3]); w.z = cvt_pk_bf16(v1[0], v1[1]); w.w = cvt_pk_bf16(v1[2], v1[3]);
                    *(u32x4*)(rowp + bj * HALF) = w; } }
    }
};
struct EpiResF32 {
    static constexpr bool PERM = false;
    const float* res; float* out; int ldc;
    __device__ __forceinline__ void operator()(const f32x4 (&acc)[2][2][4][2], const Unit& u, int wr, int wc, int fr, int fq) const {
        const int row0 = u.pm * BM + wr * 64 + fr, col0 = u.pn * BM + wc * 32 + 4 * fq;
#pragma unroll
        for (int ai = 0; ai < 2; ++ai)
#pragma unroll
            for (int m = 0; m < 4; ++m) { const size_t off = (size_t)(row0 + ai * HALF + m * 16) * ldc + col0;
#pragma unroll
                for (int bj = 0; bj < 2; ++bj)
#pragma unroll
                    for (int n = 0; n < 2; ++n) { const f32x4 r = *(const f32x4*)(res + off + bj * HALF + n * 16); *(f32x4*)(out + off + bj * HALF + n * 16) = r + acc[ai][bj][m][n]; }
                if (m & 1) asm volatile("" ::: "memory"); }
    }
};
struct EpiResBf16 {
    static constexpr bool PERM = true;
    const float* res; bf16_t* out; int ldc;
    __device__ __forceinline__ void issue(f32x4 (&x)[8], int row0, int col0, int b) const {
#pragma unroll
        for (int mm = 0; mm < 2; ++mm)
#pragma unroll
            for (int bj = 0; bj < 2; ++bj) { const float* p = res + (size_t)(row0 + (b >> 1) * HALF + (2 * (b & 1) + mm) * 16) * ldc + col0 + bj * HALF;
                asm volatile("global_load_dwordx4 %0, %1, off" : "=&v"(x[4 * mm + 2 * bj]) : "v"(p) : "memory");
                asm volatile("global_load_dwordx4 %0, %1, off offset:16" : "=&v"(x[4 * mm + 2 * bj + 1]) : "v"(p) : "memory"); }
    }
    __device__ __forceinline__ void finish(f32x4 (&x)[8], const f32x4 (&acc)[2][2][4][2], int row0, int col0, int b) const {
        const int ai = b >> 1;
#pragma unroll
        for (int mm = 0; mm < 2; ++mm) { const int m = 2 * (b & 1) + mm; const size_t off = (size_t)(row0 + ai * HALF + m * 16) * ldc + col0;
#pragma unroll
            for (int bj = 0; bj < 2; ++bj) { const f32x4 v0 = x[4 * mm + 2 * bj] + acc[ai][bj][m][0], v1 = x[4 * mm + 2 * bj + 1] + acc[ai][bj][m][1];
                u32x4 w; w.x = cvt_pk_bf16(v0[0], v0[1]); w.y = cvt_pk_bf16(v0[2], v0[3]); w.z = cvt_pk_bf16(v1[0], v1[1]); w.w = cvt_pk_bf16(v1[2], v1[3]);
                *(u32x4*)(out + off + bj * HALF) = w; } }
    }
#define ERB_WAIT(x, N) asm volatile("s_waitcnt vmcnt(" #N ")" : "+v"(x[0]), "+v"(x[1]), "+v"(x[2]), "+v"(x[3]), "+v"(x[4]), "+v"(x[5]), "+v"(x[6]), "+v"(x[7]) :: "memory")
    __device__ __forceinline__ void operator()(const f32x4 (&acc)[2][2][4][2], const Unit& u, int wr, int wc, int fr, int fq) const {
        const int row0 = u.pm * BM + wr * 64 + fr, col0 = u.pn * BM + wc * 32 + 8 * fq;
        f32x4 xa[8], xb[8];
        issue(xa, row0, col0, 0); issue(xb, row0, col0, 1);
        ERB_WAIT(xa, 8);  finish(xa, acc, row0, col0, 0); __builtin_amdgcn_sched_barrier(0); issue(xa, row0, col0, 2);
        ERB_WAIT(xb, 12); finish(xb, acc, row0, col0, 1); __builtin_amdgcn_sched_barrier(0); issue(xb, row0, col0, 3);
        ERB_WAIT(xa, 12); finish(xa, acc, row0, col0, 2); __builtin_amdgcn_sched_barrier(0);
        ERB_WAIT(xb, 4);  finish(xb, acc, row0, col0, 3);
    }
#undef ERB_WAIT
};
struct EpiSwiGlu {
    static constexpr bool PERM = true;
    bf16_t* HID; const float* slot_rs;
    __device__ __forceinline__ void operator()(const f32x4 (&acc)[2][2][4][2], const Unit& u, int wr, int wc, int fr, int fq) const {
        const int row0 = u.pm * BM + wr * 64 + fr, col0 = u.pn * 128 + wc * 32 + 8 * fq;
#pragma unroll
        for (int ai = 0; ai < 2; ++ai)
#pragma unroll
            for (int m = 0; m < 4; ++m) { bf16_t* rowp = HID + (size_t)(row0 + ai * HALF + m * 16) * DFF + col0; const float rs = slot_rs[row0 + ai * HALF + m * 16];
                float h[8];
#pragma unroll
                for (int n = 0; n < 2; ++n)
#pragma unroll
                    for (int j = 0; j < 4; ++j) { const float g = acc[ai][0][m][n][j] * rs, up = acc[ai][1][m][n][j] * rs; h[n * 4 + j] = g * __builtin_amdgcn_rcpf(1.0f + __expf(-g)) * up; }
                u32x4 w; w.x = cvt_pk_bf16(h[0], h[1]); w.y = cvt_pk_bf16(h[2], h[3]); w.z = cvt_pk_bf16(h[4], h[5]); w.w = cvt_pk_bf16(h[6], h[7]);
                *(u32x4*)rowp = w; }
    }
};
struct EpiDown {
    static constexpr bool PERM = true;
    bf16_t* Y; const int* slot_dst; const float* slot_w;
    __device__ __forceinline__ void operator()(const f32x4 (&acc)[2][2][4][2], const Unit& u, int wr, int wc, int fr, int fq) const {
        const int slot0 = u.pm * BM + wr * 64 + fr, col0 = u.pn * BM + wc * 32 + 8 * fq;
#pragma unroll
        for (int ai = 0; ai < 2; ++ai)
#pragma unroll
            for (int m = 0; m < 4; ++m) { const int slot = slot0 + ai * HALF + m * 16; const int dst = slot_dst[slot]; const float sw = slot_w[slot];
                if (dst >= 0) { bf16_t* rowp = Y + (size_t)dst * D + col0;
#pragma unroll
                    for (int bj = 0; bj < 2; ++bj) { const f32x4 v0 = acc[ai][bj][m][0] * sw, v1 = acc[ai][bj][m][1] * sw;
                        u32x4 w; w.x = cvt_pk_bf16(v0[0], v0[1]); w.y = cvt_pk_bf16(v0[2], v0[3]); w.z = cvt_pk_bf16(v1[0], v1[1]); w.w = cvt_pk_bf16(v1[2], v1[3]);
                        *(u32x4*)(rowp + bj * HALF) = w; } } }
    }
};

template <class Epi, class Sched, bool ALIGN_EPI>
__device__ __forceinline__ void gemm_phase(PG8_LAS unsigned char* lds, const int K, const Sched& S, const Epi& E) {
    const int tid = threadIdx.x, wid = __builtin_amdgcn_readfirstlane(tid >> 6), lane = tid & 63, wr = wid >> 2, wc = wid & 3, fr = lane & 15, fq = lane >> 4;
    const int nt = K / BK;
    unsigned voffA[2], voffB[2]; int RA[2], CA[2];
#pragma unroll
    for (int i = 0; i < 2; ++i) { int R, C; stage_rc(tid * 16 + i * 8192, R, C); const int Rb = Epi::PERM ? ((R & ~31) + perm32(R & 31)) : R;
        voffA[i] = (unsigned)(R * K + C) * 2u; voffB[i] = (unsigned)(Rb * K + C) * 2u; RA[i] = R; CA[i] = C; }
    const size_t kstep = (size_t)(BK * 2);
    const size_t hstep = (size_t)HALF * K * 2;
    const unsigned ldsw = (unsigned)wid * 1024u;
    const int aoff = lds_byte(wr * 64 + fr, fq * 8), boff = lds_byte(wc * 32 + fr, fq * 8);
#define PG8_SA(b, h) (((b) * 2 + (h)) * HTB)
#define PG8_SB(b, h) ((4 + (b) * 2 + (h)) * HTB)
#define PG8_STAGE(bufoff, gbase, voff) do { _Pragma("unroll") for (int _i = 0; _i < 2; ++_i) \
        __builtin_amdgcn_global_load_lds((const unsigned*)((const char*)(gbase) + (voff)[_i]), (PG8_LAS unsigned*)(lds + (bufoff) + ldsw + _i * 8192), 16, 0, 0); } while (0)
#define PG8_STAGE_A(bufoff, gb, vo, h) do { if constexpr (Sched::GATHER) { PG8_STAGE(bufoff, gb, (vo)[h]); } else { PG8_STAGE(bufoff, (gb) + (h) * hstep, voffA); } } while (0)
#define PG8_LDA(dst, b, h) do { _Pragma("unroll") for (int m = 0; m < 4; ++m) _Pragma("unroll") for (int k = 0; k < 2; ++k) dst[m][k] = *(const PG8_LAS bf16x8*)(lds + PG8_SA(b, h) + aoff + m * 2048 + k * 1024); } while (0)
#define PG8_LDB(dst, b, h) do { _Pragma("unroll") for (int n = 0; n < 2; ++n) _Pragma("unroll") for (int k = 0; k < 2; ++k) dst[n][k] = *(const PG8_LAS bf16x8*)(lds + PG8_SB(b, h) + boff + n * 2048 + k * 1024); } while (0)
#define PG8_MMA(ai, bj, At, Bt) do { __builtin_amdgcn_s_setprio(1); _Pragma("unroll") for (int m = 0; m < 4; ++m) _Pragma("unroll") for (int n = 0; n < 2; ++n) _Pragma("unroll") for (int k = 0; k < 2; ++k) \
        acc[ai][bj][m][n] = __builtin_amdgcn_mfma_f32_16x16x32_bf16(Bt[n][k], At[m][k], acc[ai][bj][m][n], 0, 0, 0); __builtin_amdgcn_s_setprio(0); } while (0)
#define PG8_WAIT_V(n) asm volatile("s_waitcnt vmcnt(" #n ")" ::: "memory")
#define PG8_WAIT_L(n) asm volatile("s_waitcnt lgkmcnt(" #n ")" ::: "memory")
#define PG8_BAR __builtin_amdgcn_s_barrier()
#define PG8_SCHED __builtin_amdgcn_sched_barrier(0)
    Unit cur, nxt; int ui = 0;
    if (!S.next(0, cur)) return;
    f32x4 acc[2][2][4][2];
#pragma unroll
    for (int a = 0; a < 2; ++a)
#pragma unroll
        for (int b = 0; b < 2; ++b)
#pragma unroll
            for (int m = 0; m < 4; ++m)
#pragma unroll
                for (int n = 0; n < 2; ++n) acc[a][b][m][n] = (f32x4){0.f, 0.f, 0.f, 0.f};
    bf16x8 At[4][2], B0[2][2], B1[2][2];
    unsigned cvo[2][2], nvo[2][2];
#pragma unroll
    for (int h = 0; h < 2; ++h)
#pragma unroll
        for (int i = 0; i < 2; ++i) { cvo[h][i] = Sched::GATHER ? (S.row(cur, h * HALF + RA[i]) * (unsigned)K + (unsigned)CA[i]) * 2u : 0u; nvo[h][i] = cvo[h][i]; }
    const char* cA = S.a_ptr(cur); const char* cB = S.b_ptr(cur);
    PG8_STAGE(PG8_SB(0, 0), cB, voffB); PG8_STAGE(PG8_SB(0, 1), cB + hstep, voffB); PG8_STAGE_A(PG8_SA(0, 0), cA, cvo, 0); PG8_STAGE_A(PG8_SA(0, 1), cA, cvo, 1);
    if (wr == 1) PG8_BAR;
    PG8_WAIT_V(2); PG8_BAR;
    PG8_STAGE(PG8_SB(1, 0), cB + kstep, voffB); PG8_STAGE_A(PG8_SA(1, 0), cA + kstep, cvo, 0); PG8_STAGE(PG8_SB(1, 1), cB + hstep + kstep, voffB);
    PG8_WAIT_V(6); PG8_BAR;
    for (;;) {
        const bool has_next = S.next(ui + 1, nxt);
        const char* nA = has_next ? S.a_ptr(nxt) : cA; const char* nB = has_next ? S.b_ptr(nxt) : cB;
        if constexpr (Sched::GATHER) {
#pragma unroll
            for (int h = 0; h < 2; ++h)
#pragma unroll
                for (int i = 0; i < 2; ++i) nvo[h][i] = has_next ? (S.row(nxt, h * HALF + RA[i]) * (unsigned)K + (unsigned)CA[i]) * 2u : cvo[h][i];
        }
        for (int t = 0; t < nt; t += 2) {
            const bool last = (t == nt - 2);
            const char* a1 = cA + (size_t)(t + 1) * kstep;
            const char* a2 = last ? nA : cA + (size_t)(t + 2) * kstep; const char* b2 = last ? nB : cB + (size_t)(t + 2) * kstep;
            const char* a3 = a2 + kstep; const char* b3 = b2 + kstep;
            unsigned vo2[2][2];
#pragma unroll
            for (int h = 0; h < 2; ++h)
#pragma unroll
                for (int i = 0; i < 2; ++i) vo2[h][i] = last ? nvo[h][i] : cvo[h][i];
            PG8_LDB(B0, 0, 0); PG8_LDB(B1, 0, 1); PG8_SCHED; PG8_LDA(At, 0, 0); PG8_STAGE_A(PG8_SA(1, 1), a1, cvo, 1);
            PG8_WAIT_V(8); PG8_WAIT_L(0); PG8_BAR; PG8_MMA(0, 0, At, B0); PG8_MMA(0, 1, At, B1); PG8_BAR; PG8_SCHED;
            PG8_LDA(At, 0, 1); PG8_STAGE(PG8_SB(0, 0), b2, voffB); PG8_STAGE(PG8_SB(0, 1), b2 + hstep, voffB); PG8_STAGE_A(PG8_SA(0, 0), a2, vo2, 0);
            PG8_WAIT_V(8); PG8_WAIT_L(0); PG8_BAR; PG8_MMA(1, 0, At, B0); PG8_MMA(1, 1, At, B1); PG8_BAR; PG8_SCHED;
            PG8_LDB(B0, 1, 0); PG8_LDB(B1, 1, 1); PG8_SCHED; PG8_LDA(At, 1, 0); PG8_STAGE_A(PG8_SA(0, 1), a2, vo2, 1);
            PG8_WAIT_V(8); PG8_WAIT_L(0); PG8_BAR; PG8_MMA(0, 0, At, B0); PG8_MMA(0, 1, At, B1); PG8_BAR; PG8_SCHED;
            PG8_LDA(At, 1, 1); PG8_STAGE(PG8_SB(1, 0), b3, voffB); PG8_STAGE(PG8_SB(1, 1), b3 + hstep, voffB); PG8_STAGE_A(PG8_SA(1, 0), a3, vo2, 0);
            PG8_WAIT_V(8); PG8_WAIT_L(0); PG8_BAR; PG8_MMA(1, 0, At, B0); PG8_MMA(1, 1, At, B1); PG8_BAR; PG8_SCHED;
        }
        if constexpr (ALIGN_EPI) { if (wr == 0) PG8_BAR; }
        E(acc, cur, wr, wc, fr, fq);
        if (!has_next) break;
#pragma unroll
        for (int a = 0; a < 2; ++a)
#pragma unroll
            for (int b = 0; b < 2; ++b)
#pragma unroll
                for (int m = 0; m < 4; ++m)
#pragma unroll
                    for (int n = 0; n < 2; ++n) acc[a][b][m][n] = (f32x4){0.f, 0.f, 0.f, 0.f};
        cur = nxt; cA = nA; cB = nB; ++ui;
#pragma unroll
        for (int h = 0; h < 2; ++h)
#pragma unroll
            for (int i = 0; i < 2; ++i) cvo[h][i] = nvo[h][i];
        if constexpr (ALIGN_EPI) { if (wr == 1) PG8_BAR; }
    }
    PG8_WAIT_V(0);
    if constexpr (!ALIGN_EPI) { if (wr == 0) PG8_BAR; }
    PG8_BAR;
#undef PG8_SA
#undef PG8_SB
#undef PG8_STAGE
#undef PG8_STAGE_A
#undef PG8_LDA
#undef PG8_LDB
#undef PG8_MMA
#undef PG8_WAIT_V
#undef PG8_WAIT_L
#undef PG8_BAR
#undef PG8_SCHED
}
}

namespace mu {
constexpr int MR = 320, RWU = 80, NMU = 5, ABYTES = MR * 64 * 2, BBYTES = 128 * 64 * 2;
constexpr int GAIN_OFF = 2 * ABYTES + 2 * BBYTES;
__device__ __forceinline__ int lds_byte(int r, int c) { const int st = (r >> 4) * 2 + (c >> 5), ob = (r & 15) * 64 + (c & 31) * 2; return st * 1024 + (ob ^ (((ob >> 9) & 1) << 5)); }
__device__ __forceinline__ void stage_rc(int b, int& R, int& C) { const int st = b >> 10, sb = b & 1023, swz = sb ^ (((sb >> 9) & 1) << 5); R = (st >> 1) * 16 + swz / 64; C = (st & 1) * 32 + (swz % 64) / 2; }
template <int MODE>
__device__ __forceinline__ void moe_unit(PG8_LAS unsigned char* lds, int e, int cb, int slot0  , int nv  , const bf16_t* A, const int* slot_tok,
                                         const float* W0, const float* W1, bf16_t* OUT, const float* slot_rs  , const int* slot_dst) {
    constexpr int K = MODE == 0 ? 4096 : 512, nt = K / 64, LDB = MODE == 0 ? 512 : 4096, RB = LDB * 4  ;
    const int tid = threadIdx.x, wid = __builtin_amdgcn_readfirstlane(tid >> 6), lane = tid & 63, wr = wid >> 1, wc = wid & 1, fr = lane & 15, fq = lane >> 4;
    unsigned aoff[NMU];
#pragma unroll
    for (int i = 0; i < NMU; ++i) { int R, C; stage_rc(wid * 1024 + i * 8192 + lane * 16, R, C); const int w4 = R / RWU, r = 4 * (R - RWU * w4) + w4;
        const unsigned row = r < nv ? (MODE == 0 ? (unsigned)slot_tok[slot0 + r] : (unsigned)(slot0 + r)) : (MODE == 0 ? 0u : (unsigned)slot0); aoff[i] = (row * (unsigned)K + (unsigned)C) * 2u; }
    const int jj0 = 2 * (lane & 31), typ = lane >> 5;
    const int R0 = MODE == 0 ? 64 * (jj0 >> 5) + 32 * typ + 16 * ((jj0 >> 4) & 1) + (jj0 & 15) : 2 * lane;
    const char* Bb = MODE == 0 ? (const char*)((typ ? W1 : W0) + (size_t)e * K * LDB + 64 * cb + jj0) + (size_t)(8 * wid) * RB
                               : (const char*)(W0 + (size_t)e * K * LDB + 128 * cb + 2 * lane) + (size_t)(8 * wid) * RB;
    const unsigned bw0 = (unsigned)(R0 * 128 + ((wid ^ ((R0 >> 1) & 7)) * 16)), bw1 = bw0 + 128u;
    const int nvw = (nv - wr + 3) >> 2, mcnt = nvw <= 0 ? 0 : (((nvw + 15) >> 4) > NMU ? NMU : ((nvw + 15) >> 4));
#define MU_SA(b) (lds + (b) * ABYTES)
#define MU_SB(b) (lds + 2 * ABYTES + (b) * BBYTES)
#define MU_GLDS_A(buf, kt) do { _Pragma("unroll") for (int i = 0; i < NMU; ++i) \
        __builtin_amdgcn_global_load_lds((const unsigned*)((const char*)A + aoff[i] + (size_t)(kt) * 128), (PG8_LAS unsigned*)(MU_SA(buf) + wid * 1024 + i * 8192), 16, 0, 0); } while (0)
#define MU_B_ISSUE(sb, kt) do { const char* kb_ = Bb + (size_t)(kt) * (64 * (size_t)RB); _Pragma("unroll") for (int j = 0; j < 8; ++j) { const char* p_ = kb_ + (size_t)j * RB; \
        asm volatile("global_load_dwordx2 %0, %1, off" : "=&v"(sb[j]) : "v"(p_) : "memory"); } } while (0)
#define MU_B_WAIT(sb, N) asm volatile("s_waitcnt vmcnt(%8)" : "+v"(sb[0]), "+v"(sb[1]), "+v"(sb[2]), "+v"(sb[3]), "+v"(sb[4]), "+v"(sb[5]), "+v"(sb[6]), "+v"(sb[7]) : "n"(N) : "memory")
#define MU_G_LOAD(ga, kt) do { const PG8_LAS f32x4* gk_ = (const PG8_LAS f32x4*)(lds + GAIN_OFF) + 16 * (kt) + 2 * wid; const f32x4 ga_ = gk_[0], gb_ = gk_[1]; \
        ga[0] = ga_[0]; ga[1] = ga_[1]; ga[2] = ga_[2]; ga[3] = ga_[3]; ga[4] = gb_[0]; ga[5] = gb_[1]; ga[6] = gb_[2]; ga[7] = gb_[3]; } while (0)
#define MU_B_WRITE(sb, buf, ga) do { u32x4 w0_, w1_; w0_.x = cvtpk(sb[0].x * ga[0], sb[1].x * ga[1]); w0_.y = cvtpk(sb[2].x * ga[2], sb[3].x * ga[3]); w0_.z = cvtpk(sb[4].x * ga[4], sb[5].x * ga[5]); w0_.w = cvtpk(sb[6].x * ga[6], sb[7].x * ga[7]); \
        w1_.x = cvtpk(sb[0].y * ga[0], sb[1].y * ga[1]); w1_.y = cvtpk(sb[2].y * ga[2], sb[3].y * ga[3]); w1_.z = cvtpk(sb[4].y * ga[4], sb[5].y * ga[5]); w1_.w = cvtpk(sb[6].y * ga[6], sb[7].y * ga[7]); \
        *(PG8_LAS u32x4*)(MU_SB(buf) + bw0) = w0_; *(PG8_LAS u32x4*)(MU_SB(buf) + bw1) = w1_; } while (0)
#define MU_COMPUTE(buf) do { _Pragma("unroll") for (int ks = 0; ks < 2; ++ks) { bf16x8 At[NMU], Bf[4]; \
        _Pragma("unroll") for (int n = 0; n < 4; ++n) { const int R_ = 64 * wc + 16 * n + fr; Bf[n] = *(const PG8_LAS bf16x8*)(MU_SB(buf) + R_ * 128 + (((4 * ks + fq) ^ ((R_ >> 1) & 7)) * 16)); } \
        _Pragma("unroll") for (int m = 0; m < NMU; ++m) if (m < mcnt) At[m] = *(const PG8_LAS bf16x8*)(MU_SA(buf) + lds_byte(RWU * wr + 16 * m + fr, 32 * ks + 8 * fq)); \
        _Pragma("unroll") for (int m = 0; m < NMU; ++m) if (m < mcnt) { _Pragma("unroll") for (int n = 0; n < 4; ++n) acc[m][n] = __builtin_amdgcn_mfma_f32_16x16x32_bf16(Bf[n], At[m], acc[m][n], 0, 0, 0); } \
        __builtin_amdgcn_sched_barrier(0); } } while (0)
#define MU_END(last) do { if (last) asm volatile("s_waitcnt vmcnt(0)" ::: "memory"); else asm volatile("s_waitcnt vmcnt(8)" ::: "memory"); \
        asm volatile("s_waitcnt lgkmcnt(0)" ::: "memory"); __builtin_amdgcn_s_barrier(); asm volatile("" ::: "memory"); } while (0)
    f32x4 acc[NMU][4];
#pragma unroll
    for (int m = 0; m < NMU; ++m)
#pragma unroll
        for (int n = 0; n < 4; ++n) acc[m][n] = (f32x4){0.f, 0.f, 0.f, 0.f};
    f32x2 s0[8], s1[8];
    float g0[8], g1[8];
    MU_GLDS_A(0, 0); MU_B_ISSUE(s0, 0); MU_G_LOAD(g0, 0); MU_B_ISSUE(s1, 1); MU_G_LOAD(g1, 1);
    MU_B_WAIT(s0, 8); MU_B_WRITE(s0, 0, g0); __builtin_amdgcn_sched_barrier(0); MU_B_ISSUE(s0, 2); MU_G_LOAD(g0, 2);
    asm volatile("s_waitcnt vmcnt(16)" ::: "memory");
    asm volatile("s_waitcnt lgkmcnt(0)" ::: "memory"); __builtin_amdgcn_s_barrier(); asm volatile("" ::: "memory");
#pragma unroll 1
    for (int t = 0; t < nt; t += 2) {
        if (t + 2 < nt) MU_B_WAIT(s1, 8); else MU_B_WAIT(s1, 0);
        MU_B_WRITE(s1, 1, g1); __builtin_amdgcn_sched_barrier(0); MU_GLDS_A(1, t + 1); __builtin_amdgcn_sched_barrier(0);
        if (t + 3 < nt) { MU_B_ISSUE(s1, t + 3); MU_G_LOAD(g1, t + 3); }
        MU_COMPUTE(0);
        MU_END(t + 3 >= nt);
        if (t + 2 < nt) { MU_B_WAIT(s0, 8); MU_B_WRITE(s0, 0, g0); __builtin_amdgcn_sched_barrier(0); MU_GLDS_A(0, t + 2); __builtin_amdgcn_sched_barrier(0); }
        if (t + 4 < nt) { MU_B_ISSUE(s0, t + 4); MU_G_LOAD(g0, t + 4); }
        MU_COMPUTE(1);
        MU_END(t + 4 >= nt);
    }
#pragma unroll
    for (int m = 0; m < NMU; ++m) if (m < mcnt) { const int r = 4 * (16 * m + fr) + wr;
        if (r < nv) { const int slot = slot0 + r; const float rs = slot_rs[slot];
            if (MODE == 0) {
#pragma unroll
                for (int n = 0; n < 2; ++n) { float h[4];
#pragma unroll
                    for (int i = 0; i < 4; ++i) { const float g = acc[m][n][i] * rs, up = acc[m][n + 2][i] * rs; h[i] = g * __builtin_amdgcn_rcpf(1.0f + __expf(-g)) * up; }
                    u32x2 w; w.x = cvtpk(h[0], h[1]); w.y = cvtpk(h[2], h[3]); *(u32x2*)(OUT + (size_t)slot * DFF + 64 * cb + 32 * wc + 16 * n + 4 * fq) = w; }
            } else { const int dst = slot_dst[slot];
#pragma unroll
                for (int n = 0; n < 4; ++n) { const f32x4 v = acc[m][n] * rs; u32x2 w; w.x = cvtpk(v[0], v[1]); w.y = cvtpk(v[2], v[3]); *(u32x2*)(OUT + (size_t)dst * D + 128 * cb + 64 * wc + 16 * n + 4 * fq) = w; } } } }
#undef MU_SA
#undef MU_SB
#undef MU_GLDS_A
#undef MU_B_ISSUE
#undef MU_B_WAIT
#undef MU_B_WRITE
#undef MU_G_LOAD
#undef MU_COMPUTE
#undef MU_END
}

constexpr int DR = 320, DRW = 80, DNM = 5, DABYTES = DR * 64 * 2;
__device__ __forceinline__ void moe_down_stream(PG8_LAS unsigned char* lds, int e, int cb0, int slot0, int nv, const bf16_t* HIDp, const float* Wd, bf16_t* Y, const float* slot_w, const int* slot_dst) {
    constexpr int K = 512, NT = 64, RB = 4096 * 4;
    const int tid = threadIdx.x, wid = __builtin_amdgcn_readfirstlane(tid >> 6), lane = tid & 63, wr = wid >> 1, wc = wid & 1, fr = lane & 15, fq = lane >> 4;
    unsigned aoff[5];
#pragma unroll
    for (int i = 0; i < 5; ++i) { int R, C; stage_rc(wid * 1024 + i * 8192 + lane * 16, R, C); const int w4 = R / DRW; int r = 4 * (R - DRW * w4) + w4; r = r < nv ? r : r % nv;
        aoff[i] = ((unsigned)(slot0 + r) * (unsigned)K + (unsigned)C) * 2u; }
    const int R0 = 2 * lane;
    const char* Bb = (const char*)(Wd + (size_t)e * K * 4096 + 128 * cb0 + 2 * lane) + (size_t)(8 * wid) * RB;
    const unsigned bw0 = (unsigned)(R0 * 128 + ((wid ^ ((R0 >> 1) & 7)) * 16)), bw1 = bw0 + 128u;
    const int nvw = (nv - wr + 3) >> 2, mcnt = nvw <= 0 ? 0 : (((nvw + 15) >> 4) > DNM ? DNM : ((nvw + 15) >> 4));
    unsigned amask = 0u;
#pragma unroll
    for (int i = 0; i < 5; ++i) { const int grp = 4 * i + (wid >> 1), w4 = grp / DNM, mf = grp % DNM, nv4 = (nv - w4 + 3) >> 2, mc4 = nv4 <= 0 ? 0 : ((nv4 + 15) >> 4); if (mf < mc4) amask |= 1u << i; }
    int dstv[DNM]; float wv[DNM];
#pragma unroll
    for (int m = 0; m < DNM; ++m) { const int r = 4 * (16 * m + fr) + wr; const bool ok = (m < mcnt) && (16 * m + fr < DRW) && (r < nv); dstv[m] = ok ? slot_dst[slot0 + r] : -1; wv[m] = ok ? slot_w[slot0 + r] : 0.f; }
    asm volatile("s_waitcnt vmcnt(0)" : "+v"(dstv[0]), "+v"(dstv[1]), "+v"(dstv[2]), "+v"(dstv[3]), "+v"(dstv[4]), "+v"(wv[0]), "+v"(wv[1]), "+v"(wv[2]), "+v"(wv[3]), "+v"(wv[4]) :: "memory");
#define MD_SA(b) (lds + (b) * DABYTES)
#define MD_SB(b) (lds + 2 * DABYTES + (b) * BBYTES)
#define MD_GLDS_A(buf, tau) do { _Pragma("unroll") for (int i = 0; i < 5; ++i) if (amask & (1u << i)) \
        __builtin_amdgcn_global_load_lds((const unsigned*)((const char*)HIDp + aoff[i] + (size_t)((tau) & 7) * 128), (PG8_LAS unsigned*)(MD_SA(buf) + wid * 1024 + i * 8192), 16, 0, 0); } while (0)
#define MD_B_ISSUE(sb, tau) do { const char* kb_ = Bb + (size_t)((tau) >> 3) * 512 + (size_t)((tau) & 7) * (64 * (size_t)RB); _Pragma("unroll") for (int j = 0; j < 8; ++j) { const char* p_ = kb_ + (size_t)j * RB; \
        asm volatile("global_load_dwordx2 %0, %1, off" : "=&v"(sb[j]) : "v"(p_) : "memory"); } } while (0)
#define MD_B_WAIT(sb, N) asm volatile("s_waitcnt vmcnt(%8)" : "+v"(sb[0]), "+v"(sb[1]), "+v"(sb[2]), "+v"(sb[3]), "+v"(sb[4]), "+v"(sb[5]), "+v"(sb[6]), "+v"(sb[7]) : "n"(N) : "memory")
#define MD_B_WRITE(sb, buf) do { u32x4 w0_, w1_; w0_.x = cvtpk(sb[0].x, sb[1].x); w0_.y = cvtpk(sb[2].x, sb[3].x); w0_.z = cvtpk(sb[4].x, sb[5].x); w0_.w = cvtpk(sb[6].x, sb[7].x); \
        w1_.x = cvtpk(sb[0].y, sb[1].y); w1_.y = cvtpk(sb[2].y, sb[3].y); w1_.z = cvtpk(sb[4].y, sb[5].y); w1_.w = cvtpk(sb[6].y, sb[7].y); \
        *(PG8_LAS u32x4*)(MD_SB(buf) + bw0) = w0_; *(PG8_LAS u32x4*)(MD_SB(buf) + bw1) = w1_; } while (0)
#define MD_COMPUTE(buf) do { _Pragma("unroll") for (int ks = 0; ks < 2; ++ks) { bf16x8 At[DNM], Bf[4]; \
        _Pragma("unroll") for (int n = 0; n < 4; ++n) { const int R_ = 64 * wc + 16 * n + fr; Bf[n] = *(const PG8_LAS bf16x8*)(MD_SB(buf) + R_ * 128 + (((4 * ks + fq) ^ ((R_ >> 1) & 7)) * 16)); } \
        _Pragma("unroll") for (int m = 0; m < DNM; ++m) if (m < mcnt) At[m] = *(const PG8_LAS bf16x8*)(MD_SA(buf) + lds_byte(DRW * wr + 16 * m + fr, 32 * ks + 8 * fq)); \
        _Pragma("unroll") for (int m = 0; m < DNM; ++m) if (m < mcnt) { _Pragma("unroll") for (int n = 0; n < 4; ++n) acc[m][n] = __builtin_amdgcn_mfma_f32_16x16x32_bf16(Bf[n], At[m], acc[m][n], 0, 0, 0); } \
        __builtin_amdgcn_sched_barrier(0); } } while (0)
#define MD_END(last) do { if (last) asm volatile("s_waitcnt vmcnt(0)" ::: "memory"); else asm volatile("s_waitcnt vmcnt(8)" ::: "memory"); \
        asm volatile("s_waitcnt lgkmcnt(0)" ::: "memory"); __builtin_amdgcn_s_barrier(); asm volatile("" ::: "memory"); } while (0)
    f32x4 acc[DNM][4];
#pragma unroll
    for (int m = 0; m < DNM; ++m)
#pragma unroll
        for (int n = 0; n < 4; ++n) acc[m][n] = (f32x4){0.f, 0.f, 0.f, 0.f};
    f32x2 s0[8], s1[8];
    MD_GLDS_A(0, 0); MD_B_ISSUE(s0, 0); MD_B_ISSUE(s1, 1);
    MD_B_WAIT(s0, 8); MD_B_WRITE(s0, 0); __builtin_amdgcn_sched_barrier(0); MD_B_ISSUE(s0, 2);
    asm volatile("s_waitcnt vmcnt(16)" ::: "memory");
    asm volatile("s_waitcnt lgkmcnt(0)" ::: "memory"); __builtin_amdgcn_s_barrier(); asm volatile("" ::: "memory");
#pragma unroll 1
    for (int t = 0; t < NT; t += 2) {
        if (t + 2 < NT) MD_B_WAIT(s1, 8); else MD_B_WAIT(s1, 0);
        MD_B_WRITE(s1, 1); __builtin_amdgcn_sched_barrier(0); MD_GLDS_A(1, t + 1); __builtin_amdgcn_sched_barrier(0);
        if (t + 3 < NT) MD_B_ISSUE(s1, t + 3);
        MD_COMPUTE(0);
        MD_END(t + 3 >= NT);
        if (t + 2 < NT) { MD_B_WAIT(s0, 8); MD_B_WRITE(s0, 0); __builtin_amdgcn_sched_barrier(0); MD_GLDS_A(0, t + 2); __builtin_amdgcn_sched_barrier(0); }
        if (t + 4 < NT) MD_B_ISSUE(s0, t + 4);
        MD_COMPUTE(1);
        MD_END(t + 4 >= NT);
        if (((t + 1) & 7) == 7) {
            const int cb = cb0 + ((t + 1) >> 3);
#pragma unroll
            for (int m = 0; m < DNM; ++m) { if (dstv[m] >= 0) {
#pragma unroll
                    for (int n = 0; n < 4; ++n) { const f32x4 v = acc[m][n] * wv[m]; u32x2 w; w.x = cvtpk(v[0], v[1]); w.y = cvtpk(v[2], v[3]); *(u32x2*)(Y + (size_t)dstv[m] * D + 128 * cb + 64 * wc + 16 * n + 4 * fq) = w; } }
#pragma unroll
                for (int n = 0; n < 4; ++n) acc[m][n] = (f32x4){0.f, 0.f, 0.f, 0.f}; } }
    }
#undef MD_SA
#undef MD_SB
#undef MD_GLDS_A
#undef MD_B_ISSUE
#undef MD_B_WAIT
#undef MD_B_WRITE
#undef MD_COMPUTE
#undef MD_END
}
}

constexpr int NWAVES = 8, NTHREADS = 512;
constexpr int N_PHASES = 11;
constexpr int MOE_TAB_OFF = 132096;
struct Args { const void* in[18]; float* out; unsigned char* ws; int ph_lo, ph_hi; };

struct Frame {
    LAS unsigned char* lds;
    int tid, lane, wave, G, bid;
    unsigned char* ws;
    const float *x, *g_mix, *w_in, *w2, *gb, *g_gla, *sinks, *w_out, *g_ffn, *rg_w, *rg_b, *re_w, *re_b, *wg, *wu, *wd, *g_fin;
    const int* pos;
    float* out;
};

template <int MODE>
__device__ __forceinline__ int dest_row(int n, int row_off) {
    if (MODE == 0) return row_off + n;
    if (MODE == 1) return n < 6144 ? n : (n < 6160 ? C_GA + (n - 6144) : n - 16);
    if (MODE == 2) return row_off + 256 * (n >> 7) + (n & 127);
    return row_off + 256 * (n >> 7) + 128 + (n & 127);
}
template <int MODE>
__device__ __forceinline__ void transpose_item(const float* W, int K, int N, bf16_t* WT, int row_off, LAS float* scr, int item, int lane) {
    const int nblk = (N + 31) / 32, nb = (item >> 3) % nblk, kb = (item & 7) + 8 * (item / (8 * nblk)), k0 = 64 * kb, n0 = 32 * nb;
    const bool nok = (n0 + (lane & 31)) < N;
    float tv[32];
#pragma unroll
    for (int i = 0; i < 32; ++i) { const int kk = 2 * i + (lane >> 5); tv[i] = nok ? W[(size_t)(k0 + kk) * N + n0 + (lane & 31)] : 0.f; }
#pragma unroll
    for (int i = 0; i < 32; ++i) { const int kk = 2 * i + (lane >> 5); scr[kk * 33 + (lane & 31)] = tv[i]; }
    LDS_WAIT(); asm volatile("" ::: "memory");
    const int c = lane & 7;
#pragma unroll
    for (int j = 0; j < 4; ++j) { const int n = (lane >> 3) + 8 * j; const LAS float* s = scr + (8 * c) * 33 + n;
        u32x4 o; o.x = pk2(s[0 * 33], s[1 * 33]); o.y = pk2(s[2 * 33], s[3 * 33]); o.z = pk2(s[4 * 33], s[5 * 33]); o.w = pk2(s[6 * 33], s[7 * 33]);
        if (n0 + n < N) *(u32x4*)(WT + (size_t)dest_row<MODE>(n0 + n, row_off) * K + k0 + 8 * c) = o; }
    LDS_WAIT(); asm volatile("" ::: "memory");
}
__device__ __forceinline__ void rms_row_to_bf16(int lane, const float* xrow, const float* g, bf16_t* orow) {
    const f32x4* xr = (const f32x4*)xrow + lane; const f32x4* gr = (const f32x4*)g + lane;
    f32x4 v[16]; float s = 0.f;
#pragma unroll
    for (int j = 0; j < 16; ++j) { v[j] = xr[64 * j]; s += (v[j].x * v[j].x + v[j].y * v[j].y) + (v[j].z * v[j].z + v[j].w * v[j].w); }
    const float rstd = 1.0f / sqrtf(wave_sum(s) * (1.f / D) + RMS_EPS);
    u32x2* o8 = (u32x2*)orow + lane;
#pragma unroll
    for (int j = 0; j < 16; ++j) { const f32x4 gg = gr[64 * j]; u32x2 w; w.x = pk2(v[j].x * rstd * gg.x, v[j].y * rstd * gg.y); w.y = pk2(v[j].z * rstd * gg.z, v[j].w * rstd * gg.w); o8[64 * j] = w; }
}

__device__ __forceinline__ void p0_prologue(Frame& F) {
    LAS float* scr = (LAS float*)(F.lds + F.wave * 16384);
    const int gw = F.bid * NWAVES + F.wave, NGW = F.G * NWAVES;
    bf16_t* WIN = (bf16_t*)(F.ws + WS_WIN); bf16_t* WOUT = (bf16_t*)(F.ws + WS_WOUT); bf16_t* WGU = (bf16_t*)(F.ws + WS_WGU); bf16_t* WD = (bf16_t*)(F.ws + WS_WD);
    constexpr int I_IN = 64 * 273, I_OUT = 64 * 128, I_G = 64 * 16, I_DN = 8 * 128;
    for (int it = gw; it < I_IN; it += NGW) transpose_item<1>(F.w_in, D, IN_COLS, WIN, 0, scr, it, F.lane);
    for (int it = gw; it < I_OUT; it += NGW) transpose_item<0>(F.w_out, D, D, WOUT, 0, scr, it, F.lane);

    { u32x4* z = (u32x4*)(WIN + (size_t)IN_COLS * D); const size_t n16 = (size_t)(LDP - IN_COLS) * D * 2 / 16;
      for (size_t i = (size_t)F.bid * NTHREADS + F.tid; i < n16; i += (size_t)F.G * NTHREADS) z[i] = (u32x4){0u, 0u, 0u, 0u}; }
    { bf16_t* RBH = (bf16_t*)(F.ws + WS_RB); bf16_t* RBL = RBH + 80 * D;
      for (int i = F.bid * NTHREADS + F.tid; i < 80 * D; i += F.G * NTHREADS) { const int c = i / D, k = i % D;
          float v = 0.f; if (c < 8) v = F.rg_w[k * 8 + c]; else if (c < 72) { const int g = (c - 8) >> 3, j = (c - 8) & 7; v = F.re_w[((size_t)g * D + k) * 8 + j]; }
          const unsigned h = f2bf(v); const float hf = __builtin_bit_cast(float, h << 16); RBH[i] = (bf16_t)h; RBL[i] = (bf16_t)f2bf(v - hf); } }
    { float* RC = (float*)(F.ws + WS_ROPE); float* RS = RC + M * 32;
      for (int i = F.bid * NTHREADS + F.tid; i < M * 32; i += F.G * NTHREADS) { const int m = i >> 5, j = i & 31;
          const float inv = exp2f(-(float)j * (13.287712379549449f / 32.0f));
          const float angf = (float)F.pos[m] * inv;
          const double a = (double)angf; const double tr = a * 0.15915494309189535; const double fr = tr - __builtin_rint(tr);
          const float r = (float)(fr * 6.283185307179586);
          RC[i] = cosf(r); RS[i] = sinf(r); } }
    { bf16_t* U = (bf16_t*)(F.ws + WS_U);
      for (int m = gw; m < M; m += NGW) rms_row_to_bf16(F.lane, F.x + (size_t)m * D, F.g_mix, U + (size_t)m * D); }
}

__device__ __forceinline__ int crow(int r, int hi) { return (r & 3) + 8 * (r >> 2) + 4 * hi; }
constexpr int SWA_KROW = 144;
__device__ __forceinline__ void rot8(const u32x4 x1, const u32x4 x2, const f32x4 c0, const f32x4 c1, const f32x4 s0, const f32x4 s1, float sc, u32x4& o1, u32x4& o2) {
    const unsigned a[4] = {x1.x, x1.y, x1.z, x1.w}, b[4] = {x2.x, x2.y, x2.z, x2.w};
    const float c[8] = {c0.x, c0.y, c0.z, c0.w, c1.x, c1.y, c1.z, c1.w}, s[8] = {s0.x, s0.y, s0.z, s0.w, s1.x, s1.y, s1.z, s1.w};
    unsigned r1[4], r2[4];
#pragma unroll
    for (int j = 0; j < 4; ++j) { const float a0 = bflo(a[j]), a1 = bfhi(a[j]), b0 = bflo(b[j]), b1 = bfhi(b[j]);
        r1[j] = cvtpk((a0 * c[2 * j] - b0 * s[2 * j]) * sc, (a1 * c[2 * j + 1] - b1 * s[2 * j + 1]) * sc);
        r2[j] = cvtpk((b0 * c[2 * j] + a0 * s[2 * j]) * sc, (b1 * c[2 * j + 1] + a1 * s[2 * j + 1]) * sc); }
    o1 = (u32x4){r1[0], r1[1], r1[2], r1[3]}; o2 = (u32x4){r2[0], r2[1], r2[2], r2[3]};
}
__device__ __forceinline__ void swa_unit(Frame& F, int b, int kvh, int qb) {
    const bf16_t* PROJ = (const bf16_t*)(F.ws + WS_PROJ); bf16_t* MIX = (bf16_t*)(F.ws + WS_MIX);
    const float* RC = (const float*)(F.ws + WS_ROPE); const float* RS = RC + M * 32;
    LAS unsigned char* Kl = F.lds; LAS unsigned char* Vl = F.lds + 192 * SWA_KROW;
    LAS float* wsf = (LAS float*)(F.lds + 2 * 192 * SWA_KROW) + F.wave * 64;
    LAS bf16_t* stg = (LAS bf16_t*)(F.lds + 2 * 192 * SWA_KROW + 2048) + F.wave * 2048;
    const int tid = F.tid, lane = F.lane, r32 = lane & 31, hi = lane >> 5;
    const int K0 = 64 * (qb - 2);
    const size_t rowb = (size_t)b * SEQ;
    for (int task = tid; task < 768; task += NTHREADS) { const int key = task >> 2, c = task & 3, kg = K0 + key;
        u32x4 o1 = (u32x4){0u, 0u, 0u, 0u}, o2 = o1;
        if (kg >= 0) { const bf16_t* src = PROJ + (rowb + kg) * LDP + C_SK + kvh * 64; const u32x4 x1 = *(const u32x4*)(src + 8 * c), x2 = *(const u32x4*)(src + 32 + 8 * c);
            const float* cs = RC + (rowb + kg) * 32 + 8 * c; const float* sn = RS + (rowb + kg) * 32 + 8 * c;
            rot8(x1, x2, *(const f32x4*)cs, *(const f32x4*)(cs + 4), *(const f32x4*)sn, *(const f32x4*)(sn + 4), 1.0f, o1, o2); }
        *(LAS u32x4*)(Kl + key * SWA_KROW + 16 * c) = o1; *(LAS u32x4*)(Kl + key * SWA_KROW + 64 + 16 * c) = o2; }
    for (int task = tid; task < 1536; task += NTHREADS) { const int key = task >> 3, c = task & 7, kg = K0 + key;
        u32x4 v = (u32x4){0u, 0u, 0u, 0u};
        if (kg >= 0) v = *(const u32x4*)(PROJ + (rowb + kg) * LDP + C_SV + kvh * 64 + 8 * c);
        *(LAS u32x4*)(Vl + key * SWA_KROW + 16 * c) = v; }
    __syncthreads();
    const int qh = kvh * 8 + F.wave;
    const float sink2 = F.sinks[qh] * 1.4426950408889634f;
#pragma unroll 1
    for (int sub = 0; sub < 2; ++sub) {
        const int qg = 64 * qb + 32 * sub + r32;
        bf16x8 qr[4];
        { const bf16_t* qsrc = PROJ + (rowb + qg) * LDP + C_SQ + qh * 64 + 8 * hi;
          const u32x4 x0 = *(const u32x4*)(qsrc), x1 = *(const u32x4*)(qsrc + 16), x2 = *(const u32x4*)(qsrc + 32), x3 = *(const u32x4*)(qsrc + 48);
          const float* cs = RC + (rowb + qg) * 32 + 8 * hi; const float* sn = RS + (rowb + qg) * 32 + 8 * hi;
          u32x4 o0, o1, o2, o3; const float sc = 0.125f * 1.4426950408889634f;
          rot8(x0, x2, *(const f32x4*)cs, *(const f32x4*)(cs + 4), *(const f32x4*)sn, *(const f32x4*)(sn + 4), sc, o0, o2);
          rot8(x1, x3, *(const f32x4*)(cs + 16), *(const f32x4*)(cs + 20), *(const f32x4*)(sn + 16), *(const f32x4*)(sn + 20), sc, o1, o3);
          qr[0] = __builtin_bit_cast(bf16x8, o0); qr[1] = __builtin_bit_cast(bf16x8, o1); qr[2] = __builtin_bit_cast(bf16x8, o2); qr[3] = __builtin_bit_cast(bf16x8, o3); }
        f32x16 p[5];
#pragma unroll
        for (int j = 0; j < 5; ++j) {
#pragma unroll
            for (int r = 0; r < 16; ++r) p[j][r] = 0.f;
#pragma unroll
            for (int d0 = 0; d0 < 4; ++d0) { const bf16x8 kf = *(const LAS bf16x8*)(Kl + (32 * sub + 32 * j + r32) * SWA_KROW + (16 * d0 + 8 * hi) * 2);
                p[j] = __builtin_amdgcn_mfma_f32_32x32x16_bf16(kf, qr[d0], p[j], 0, 0, 0); } }
        const int kneg = -(K0 + 32 * sub);
        const float NEG = -INFINITY;
#pragma unroll
        for (int j = 0; j < 5; ++j)
#pragma unroll
            for (int r = 0; r < 16; ++r) { const int c = crow(r, hi); bool ok = (32 * j >= kneg);
                if (j == 0) ok = ok && (c > r32); if (j == 4) ok = ok && (c <= r32);
                p[j][r] = ok ? p[j][r] : NEG; }
        float mx = sink2;
#pragma unroll
        for (int j = 0; j < 5; ++j)
#pragma unroll
            for (int r = 0; r < 16; ++r) mx = fmaxf(mx, p[j][r]);
        mx = fmaxf(mx, __shfl_xor(mx, 32));
        float sum = 0.f;
#pragma unroll
        for (int j = 0; j < 5; ++j)
#pragma unroll
            for (int r = 0; r < 16; ++r) { p[j][r] = __builtin_amdgcn_exp2f(p[j][r] - mx); sum += p[j][r]; }
        sum += __shfl_xor(sum, 32);
        sum += __builtin_amdgcn_exp2f(sink2 - mx);
        f32x16 o[2];
#pragma unroll
        for (int r = 0; r < 16; ++r) { o[0][r] = 0.f; o[1][r] = 0.f; }
        const int vrow0 = 32 * sub + 4 * hi + ((lane & 15) >> 2), vcol = ((lane >> 4) & 1) * 32 + (lane & 3) * 8;
#pragma unroll
        for (int j = 0; j < 5; ++j)
#pragma unroll
            for (int s = 0; s < 2; ++s) {
                u32x4 pw; pw.x = cvtpk(p[j][8 * s], p[j][8 * s + 1]); pw.y = cvtpk(p[j][8 * s + 2], p[j][8 * s + 3]); pw.z = cvtpk(p[j][8 * s + 4], p[j][8 * s + 5]); pw.w = cvtpk(p[j][8 * s + 6], p[j][8 * s + 7]);
                const bf16x8 pa = __builtin_bit_cast(bf16x8, pw);
#pragma unroll
                for (int d0 = 0; d0 < 2; ++d0) { const LAS unsigned char* vp = Vl + (vrow0 + 32 * j + 16 * s) * SWA_KROW + d0 * 64 + vcol;
                    const s16x4 lo = __builtin_bit_cast(s16x4, __builtin_amdgcn_ds_read_tr16_b64_v4i16((LAS s16x4*)vp));
                    const s16x4 hh = __builtin_bit_cast(s16x4, __builtin_amdgcn_ds_read_tr16_b64_v4i16((LAS s16x4*)(vp + 8 * SWA_KROW)));
                    const bf16x8 vf = (bf16x8){lo[0], lo[1], lo[2], lo[3], hh[0], hh[1], hh[2], hh[3]};
                    o[d0] = __builtin_amdgcn_mfma_f32_32x32x16_bf16(pa, vf, o[d0], 0, 0, 0); } }
        if (hi == 0) wsf[r32] = 1.0f / sum;
        LDS_WAIT();
#pragma unroll
        for (int r = 0; r < 16; ++r) { const int orow = crow(r, hi); const float rl = wsf[orow];
#pragma unroll
            for (int d0 = 0; d0 < 2; ++d0) stg[orow * 64 + d0 * 32 + r32] = (bf16_t)f2bf(o[d0][r] * rl); }
        LDS_WAIT();
#pragma unroll
        for (int i = 0; i < 4; ++i) { const int row = i * 8 + (lane >> 3), ch = lane & 7; const u32x4 v = *(const LAS u32x4*)(stg + row * 64 + ch * 8);
            *(u32x4*)(MIX + (rowb + 64 * qb + 32 * sub + row) * D + 2048 + qh * 64 + ch * 8) = v; }
        LDS_WAIT();
    }
    __syncthreads();
}

constexpr int GP_ROW = 136;
__device__ __forceinline__ void gla_prep_unit(Frame& F, int unit) {
    const int bh = unit >> 7, n = unit & 127, b = bh >> 3, h = bh & 7, tid = F.tid, lane = F.lane;
    const bf16_t* PROJ = (const bf16_t*)(F.ws + WS_PROJ);
    bf16_t* QIN = (bf16_t*)(F.ws + WS_QIN) + (size_t)unit * 64 * 128; bf16_t* KDT = (bf16_t*)(F.ws + WS_KDT) + (size_t)unit * 128 * 64;
    bf16_t* AM = (bf16_t*)(F.ws + WS_AM) + (size_t)unit * 64 * 64; float* DEC = (float*)(F.ws + WS_DEC) + (size_t)unit * 128;
    LAS float* gaS = (LAS float*)F.lds; LAS float* tot = gaS + 1024; LAS bf16_t* qinS = (LAS bf16_t*)(F.lds + 8192); LAS bf16_t* kinS = qinS + 64 * GP_ROW;
    const size_t m0 = (size_t)b * SEQ + 64 * n;
    const int d = tid & 127, cg = tid >> 7;
    bf16_t qv[16], kv[16];
#pragma unroll
    for (int i = 0; i < 16; ++i) { const bf16_t* pr = PROJ + (m0 + cg * 16 + i) * LDP + h * 128 + d; qv[i] = pr[C_GQ]; kv[i] = pr[C_GK]; }
    { const int c = tid >> 3, r2 = (tid & 7) * 2; const unsigned w = *(const unsigned*)(PROJ + (m0 + c) * LDP + C_GA + r2); gaS[c * 16 + r2] = bflo(w); gaS[c * 16 + r2 + 1] = bfhi(w); }
    float w2r[16];
#pragma unroll
    for (int r = 0; r < 16; ++r) w2r[r] = F.w2[r * 1024 + h * 128 + d];
    const float bias = F.gb[h * 128 + d];
    __syncthreads();
    float bl[16]; float run = 0.f;
#pragma unroll
    for (int i = 0; i < 16; ++i) { const int c = cg * 16 + i; float z = bias;
#pragma unroll
        for (int r4 = 0; r4 < 4; ++r4) { const f32x4 g4 = *(const LAS f32x4*)(gaS + c * 16 + 4 * r4); z += g4.x * w2r[4 * r4] + g4.y * w2r[4 * r4 + 1] + g4.z * w2r[4 * r4 + 2] + g4.w * w2r[4 * r4 + 3]; }
        const float ls = fminf(z, 0.f) - __logf(1.0f + __expf(-fabsf(z)));
        run += ls * (1.f / 16.f); bl[i] = run; }
    tot[cg * 128 + d] = run;
    __syncthreads();
    float offs = 0.f, blast = 0.f;
#pragma unroll
    for (int g = 0; g < 4; ++g) { const float t = tot[g * 128 + d]; blast += t; if (g < cg) offs += t; }
    const float eblast = __expf(blast);
    unsigned kd[8];
#pragma unroll
    for (int i = 0; i < 16; i += 2) { float kdv[2];
#pragma unroll
        for (int u = 0; u < 2; ++u) { const int c = cg * 16 + i + u; const float bb = bl[i + u] + offs;
            const float q = bf2f(qv[i + u]) * 0.08838834764831845f, k = bf2f(kv[i + u]);
            const float eb = __expf(bb), einv = __builtin_amdgcn_rcpf(eb);
            const float qin = q * eb, kin = k * einv; kdv[u] = kin * eblast;
            const bf16_t qb16 = (bf16_t)f2bf(qin); qinS[c * GP_ROW + d] = qb16; kinS[c * GP_ROW + d] = (bf16_t)f2bf(kin); QIN[c * 128 + d] = qb16; }
        kd[i >> 1] = pk2(kdv[0], kdv[1]); }
    *(u32x4*)(KDT + d * 64 + cg * 16) = (u32x4){kd[0], kd[1], kd[2], kd[3]}; *(u32x4*)(KDT + d * 64 + cg * 16 + 8) = (u32x4){kd[4], kd[5], kd[6], kd[7]};
    if (cg == 0) DEC[d] = eblast;
    __syncthreads();
    { const int mi = F.wave >> 1, fr = lane & 15, fq = lane >> 4;
#pragma unroll
      for (int t = 0; t < 2; ++t) { const int ni = 2 * (F.wave & 1) + t; f32x4 acc = (f32x4){0.f, 0.f, 0.f, 0.f};
          if (ni <= mi) {
#pragma unroll
              for (int ks = 0; ks < 4; ++ks) { const bf16x8 kf = *(const LAS bf16x8*)(kinS + (16 * ni + fr) * GP_ROW + 32 * ks + 8 * fq), qf = *(const LAS bf16x8*)(qinS + (16 * mi + fr) * GP_ROW + 32 * ks + 8 * fq);
                  acc = __builtin_amdgcn_mfma_f32_16x16x32_bf16(kf, qf, acc, 0, 0, 0); } }
          const int c = 16 * mi + fr, j0 = 16 * ni + 4 * fq; float v[4];
#pragma unroll
          for (int i = 0; i < 4; ++i) v[i] = (j0 + i <= c) ? acc[i] : 0.f;
          u32x2 w; w.x = pk2(v[0], v[1]); w.y = pk2(v[2], v[3]); *(u32x2*)(AM + c * 64 + j0) = w; } }
    __syncthreads();
}

constexpr int GS_AM = 0, GS_QIN = 8192, GS_KDT = 24576, GS_V = 40960, GS_DEC = 43008, GS_SLOT = 44032;
constexpr int GS_SB = 3 * GS_SLOT, GS_SBROW = 272, GS_SBBUF = 16 * GS_SBROW;
__device__ __forceinline__ void gs_load(Frame& F, int bh, int et, int n, int slot) {
    const int lane = F.lane, unit = bh * 128 + n, b = bh >> 3, h = bh & 7, wave = F.wave;
    LAS unsigned char* base = F.lds + slot * GS_SLOT;
    if (wave >= 1 && wave <= 4) { const int m = wave - 1;
        const char* am = (const char*)(F.ws + WS_AM) + (size_t)unit * 8192; const char* qin = (const char*)(F.ws + WS_QIN) + (size_t)unit * 16384;
#pragma unroll
        for (int i = 0; i < 2; ++i) { const int r = 16 * m + i * 8 + (lane >> 3), ch = (lane & 7) ^ (r & 7);
            __builtin_amdgcn_global_load_lds((const unsigned*)(am + r * 128 + ch * 16), (LAS unsigned*)(base + GS_AM + (2 * m + i) * 1024), 16, 0, 0); }
#pragma unroll
        for (int i = 0; i < 4; ++i) { const int r = 16 * m + i * 4 + (lane >> 4), ch = (lane & 15) ^ (r & 15);
            __builtin_amdgcn_global_load_lds((const unsigned*)(qin + r * 256 + ch * 16), (LAS unsigned*)(base + GS_QIN + (4 * m + i) * 1024), 16, 0, 0); }
    } else if (wave == 5 || wave == 6) { const char* kdt = (const char*)(F.ws + WS_KDT) + (size_t)unit * 16384; const int i0 = (wave - 5) * 8;
#pragma unroll
        for (int i = 0; i < 8; ++i) { const int r = (i0 + i) * 8 + (lane >> 3), ch = (lane & 7) ^ (r & 7);
            __builtin_amdgcn_global_load_lds((const unsigned*)(kdt + r * 128 + ch * 16), (LAS unsigned*)(base + GS_KDT + (i0 + i) * 1024), 16, 0, 0); }
    } else if (wave == 7) { const char* dec = (const char*)(F.ws + WS_DEC) + (size_t)unit * 512;
        const char* v = (const char*)((const bf16_t*)(F.ws + WS_PROJ) + ((size_t)b * SEQ + 64 * n) * LDP + C_GV + h * 256 + et * 16);
#pragma unroll
        for (int i = 0; i < 2; ++i) { const int r = i * 32 + (lane >> 1);
            __builtin_amdgcn_global_load_lds((const unsigned*)(v + (size_t)r * LDP * 2 + (lane & 1) * 16), (LAS unsigned*)(base + GS_V + i * 1024), 16, 0, 0); }
        __builtin_amdgcn_global_load_lds((const unsigned*)(dec + (lane & 31) * 16), (LAS unsigned*)(base + GS_DEC), 16, 0, 0);
    }
}
__device__ __forceinline__ void gs_vfrag(const LAS unsigned char* vbase, int lane, bf16x8 (&vf)[2]) {
    const unsigned a = (unsigned)(uintptr_t)(vbase + (8 * (lane >> 4) + ((lane & 15) >> 2)) * 32 + (lane & 3) * 8);
    s16x4 r0, r1, r2, r3;
    asm volatile("ds_read_b64_tr_b16 %0, %4\n\tds_read_b64_tr_b16 %1, %4 offset:128\n\tds_read_b64_tr_b16 %2, %4 offset:1024\n\tds_read_b64_tr_b16 %3, %4 offset:1152\n\ts_waitcnt lgkmcnt(0)"
                 : "=&v"(r0), "=&v"(r1), "=&v"(r2), "=&v"(r3) : "v"(a) : "memory");
    vf[0] = (bf16x8){r0[0], r0[1], r0[2], r0[3], r1[0], r1[1], r1[2], r1[3]}; vf[1] = (bf16x8){r2[0], r2[1], r2[2], r2[3], r3[0], r3[1], r3[2], r3[3]};
}
__device__ __forceinline__ void gs_wait_older(int wave, bool first) {
    if (wave >= 1 && wave <= 4) { if (first) asm volatile("s_waitcnt vmcnt(6)" ::: "memory"); else asm volatile("s_waitcnt vmcnt(14)" ::: "memory"); }
    else if (wave == 5 || wave == 6) asm volatile("s_waitcnt vmcnt(8)" ::: "memory");
    else if (wave == 7) asm volatile("s_waitcnt vmcnt(3)" ::: "memory");
}
__device__ __forceinline__ void gla_scan_chain(Frame& F, int chain) {
    const int bh = chain >> 4, et = chain & 15, b = bh >> 3, h = bh & 7, lane = F.lane, fr = lane & 15, fq = lane >> 4, wave = F.wave;
    bf16_t* ORAW = (bf16_t*)(F.ws + WS_ORAW);
    f32x4 S[8];
#pragma unroll
    for (int i = 0; i < 8; ++i) S[i] = (f32x4){0.f, 0.f, 0.f, 0.f};
    if (wave >= 1) { gs_load(F, bh, et, 0, 0); gs_load(F, bh, et, 1, 1); gs_wait_older(wave, true); }
    if (wave == 0) { for (int i = lane; i < GS_SBBUF / 16; i += 64) *(LAS u32x4*)(F.lds + GS_SB + i * 16) = (u32x4){0u, 0u, 0u, 0u}; }
    asm volatile("s_waitcnt lgkmcnt(0)" ::: "memory"); __builtin_amdgcn_s_barrier(); asm volatile("" ::: "memory");
#pragma unroll 1
    for (int n = 0; n < 128; ++n) {
        const LAS unsigned char* base = F.lds + (n % 3) * GS_SLOT;
        if (wave >= 1 && n + 2 < 128) gs_load(F, bh, et, n + 2, (n + 2) % 3);
        if (wave == 0) {
            bf16x8 vf[2]; gs_vfrag(base + GS_V, lane, vf);
            bf16x8 kf[8][2]; f32x4 dc[8];
#pragma unroll
            for (int mt = 0; mt < 8; ++mt) { const int r = 16 * mt + fr; dc[mt] = *(const LAS f32x4*)(base + GS_DEC + (16 * mt + 4 * fq) * 4);
#pragma unroll
                for (int ks = 0; ks < 2; ++ks) kf[mt][ks] = *(const LAS bf16x8*)(base + GS_KDT + r * 128 + (((4 * ks + fq) ^ (r & 7)) * 16)); }
            __builtin_amdgcn_sched_barrier(0);
            LAS unsigned char* sb = F.lds + GS_SB + ((n + 1) & 1) * GS_SBBUF + fr * GS_SBROW + 8 * fq;
#pragma unroll
            for (int mt = 0; mt < 8; ++mt) { f32x4 s = S[mt] * dc[mt];
                s = __builtin_amdgcn_mfma_f32_16x16x32_bf16(kf[mt][0], vf[0], s, 0, 0, 0); s = __builtin_amdgcn_mfma_f32_16x16x32_bf16(kf[mt][1], vf[1], s, 0, 0, 0); S[mt] = s; }
#pragma unroll
            for (int mt = 0; mt < 8; ++mt) { u32x2 w; w.x = cvtpk(S[mt][0], S[mt][1]); w.y = cvtpk(S[mt][2], S[mt][3]); *(LAS u32x2*)(sb + 32 * mt) = w; }
        } else if (wave <= 4) {
            const int m = wave - 1, r = 16 * m + fr;
            bf16x8 vf[2]; gs_vfrag(base + GS_V, lane, vf);
            const LAS unsigned char* sb = F.lds + GS_SB + (n & 1) * GS_SBBUF + fr * GS_SBROW + 16 * fq;
            bf16x8 af[2], qf[4], sf[4];
#pragma unroll
            for (int ks = 0; ks < 2; ++ks) af[ks] = *(const LAS bf16x8*)(base + GS_AM + r * 128 + (((4 * ks + fq) ^ (r & 7)) * 16));
#pragma unroll
            for (int ks = 0; ks < 4; ++ks) { qf[ks] = *(const LAS bf16x8*)(base + GS_QIN + r * 256 + (((4 * ks + fq) ^ (r & 15)) * 16)); sf[ks] = *(const LAS bf16x8*)(sb + 64 * ks); }
            __builtin_amdgcn_sched_barrier(0);
            f32x4 acc = (f32x4){0.f, 0.f, 0.f, 0.f};
#pragma unroll
            for (int ks = 0; ks < 2; ++ks) acc = __builtin_amdgcn_mfma_f32_16x16x32_bf16(af[ks], vf[ks], acc, 0, 0, 0);
#pragma unroll
            for (int ks = 0; ks < 4; ++ks) acc = __builtin_amdgcn_mfma_f32_16x16x32_bf16(qf[ks], sf[ks], acc, 0, 0, 0);
            bf16_t* op = ORAW + ((size_t)b * SEQ + 64 * n + 16 * m + 4 * fq) * 2048 + h * 256 + et * 16 + fr;
#pragma unroll
            for (int i = 0; i < 4; ++i) op[(size_t)i * 2048] = (bf16_t)f2bf(acc[i]);
        }
        if (wave >= 1) { if (n + 2 < 128) gs_wait_older(wave, false); else asm volatile("s_waitcnt vmcnt(0)" ::: "memory"); }
        asm volatile("s_waitcnt lgkmcnt(0)" ::: "memory"); __builtin_amdgcn_s_barrier(); asm volatile("" ::: "memory");
    }
    asm volatile("s_waitcnt vmcnt(0) lgkmcnt(0)" ::: "memory");
}
__device__ __forceinline__ void gla_norm(Frame& F) {
    const bf16_t* PROJ = (const bf16_t*)(F.ws + WS_PROJ); const bf16_t* ORAW = (const bf16_t*)(F.ws + WS_ORAW); bf16_t* MIX = (bf16_t*)(F.ws + WS_MIX);
    const int gw = F.bid * NWAVES + F.wave, NGW = F.G * NWAVES, lane = F.lane;
    const int col = 8 * (lane & 31);
    const f32x4 gn0 = *(const f32x4*)(F.g_gla + col), gn1 = *(const f32x4*)(F.g_gla + col + 4);
    const float gn[8] = {gn0.x, gn0.y, gn0.z, gn0.w, gn1.x, gn1.y, gn1.z, gn1.w};
    for (int m = gw; m < M; m += NGW) {
        u32x4 ow[4], gw4[4];
#pragma unroll
        for (int j = 0; j < 4; ++j) { const int hc = (2 * j + (lane >> 5)) * 256 + col; ow[j] = *(const u32x4*)(ORAW + (size_t)m * 2048 + hc); gw4[j] = *(const u32x4*)(PROJ + (size_t)m * LDP + C_GR + hc); }
#pragma unroll
        for (int j = 0; j < 4; ++j) { const unsigned a[4] = {ow[j].x, ow[j].y, ow[j].z, ow[j].w}, g[4] = {gw4[j].x, gw4[j].y, gw4[j].z, gw4[j].w};
            float o[8], ss = 0.f;
#pragma unroll
            for (int i = 0; i < 4; ++i) { o[2 * i] = bflo(a[i]); o[2 * i + 1] = bfhi(a[i]); ss += o[2 * i] * o[2 * i] + o[2 * i + 1] * o[2 * i + 1]; }
#pragma unroll
            for (int s = 1; s < 32; s <<= 1) ss += __shfl_xor(ss, s);
            const float rstd = 1.0f / sqrtf(ss * (1.f / 256.f) + RMS_EPS);
            unsigned w[4];
#pragma unroll
            for (int i = 0; i < 4; ++i) { const float g0 = bflo(g[i]), g1 = bfhi(g[i]);
                w[i] = pk2(o[2 * i] * rstd * gn[2 * i] * (g0 / (1.f + __expf(-g0))), o[2 * i + 1] * rstd * gn[2 * i + 1] * (g1 / (1.f + __expf(-g1)))); }
            *(u32x4*)(MIX + (size_t)m * D + (2 * j + (lane >> 5)) * 256 + col) = (u32x4){w[0], w[1], w[2], w[3]}; }
    }
}

struct RtLoad { u32x4 x[2]; f32x4 g[2]; };
struct RtW { bf16x8 wh[5], wl[5]; };
__device__ __forceinline__ void rt_load(RtLoad& L, const bf16_t* h0, const bf16_t* h1, const float* gp, int ko) {
    L.x[0] = *(const u32x4*)(h0 + ko); L.x[1] = *(const u32x4*)(h1 + ko);
    L.g[0] = *(const f32x4*)(gp + ko); L.g[1] = *(const f32x4*)(gp + ko + 4);
}
__device__ __forceinline__ void rt_step(const RtLoad& L, const bf16_t* bh, const bf16_t* bl, f32x4 (&acc)[2][5], float (&ss)[2], int ko) {
    RtW W;
#pragma unroll
    for (int n = 0; n < 5; ++n) { W.wh[n] = *(const bf16x8*)(bh + (size_t)n * 16 * D + ko); W.wl[n] = *(const bf16x8*)(bl + (size_t)n * 16 * D + ko); }
    bf16x8 ahi[2], alo[2];
#pragma unroll
    for (int mi = 0; mi < 2; ++mi) { const u32x4 xw = L.x[mi]; const f32x4 xa = (f32x4){bflo(xw.x), bfhi(xw.x), bflo(xw.y), bfhi(xw.y)}, xb = (f32x4){bflo(xw.z), bfhi(xw.z), bflo(xw.w), bfhi(xw.w)};
        ss[mi] += (xa.x * xa.x + xa.y * xa.y) + (xa.z * xa.z + xa.w * xa.w) + (xb.x * xb.x + xb.y * xb.y) + (xb.z * xb.z + xb.w * xb.w);
        const float u[8] = {xa.x * L.g[0].x, xa.y * L.g[0].y, xa.z * L.g[0].z, xa.w * L.g[0].w, xb.x * L.g[1].x, xb.y * L.g[1].y, xb.z * L.g[1].z, xb.w * L.g[1].w};
        unsigned hb[8]; float lo[8];
#pragma unroll
        for (int j = 0; j < 8; ++j) { hb[j] = f2bf(u[j]); lo[j] = u[j] - __builtin_bit_cast(float, hb[j] << 16); }
        const u32x4 hw = (u32x4){hb[0] | (hb[1] << 16), hb[2] | (hb[3] << 16), hb[4] | (hb[5] << 16), hb[6] | (hb[7] << 16)};
        const u32x4 lw = (u32x4){pk2(lo[0], lo[1]), pk2(lo[2], lo[3]), pk2(lo[4], lo[5]), pk2(lo[6], lo[7])};
        ahi[mi] = __builtin_bit_cast(bf16x8, hw); alo[mi] = __builtin_bit_cast(bf16x8, lw); }
#pragma unroll
    for (int n = 0; n < 5; ++n)
#pragma unroll
        for (int mi = 0; mi < 2; ++mi) { acc[mi][n] = __builtin_amdgcn_mfma_f32_16x16x32_bf16(ahi[mi], W.wh[n], acc[mi][n], 0, 0, 0);
            acc[mi][n] = __builtin_amdgcn_mfma_f32_16x16x32_bf16(alo[mi], W.wh[n], acc[mi][n], 0, 0, 0);
            acc[mi][n] = __builtin_amdgcn_mfma_f32_16x16x32_bf16(ahi[mi], W.wl[n], acc[mi][n], 0, 0, 0); }
}
__device__ __forceinline__ void p5_router(Frame& F) {
    const bf16_t* H = (const bf16_t*)(F.ws + WS_HB);
    const bf16_t* RBH = (const bf16_t*)(F.ws + WS_RB); const bf16_t* RBL = RBH + 80 * D;
    unsigned* ctl = (unsigned*)(F.ws + WS_CTL);
    LAS float* part = (LAS float*)F.lds;
    LAS float* lg = part + 4 * 64 * 80;
    LAS float* ssp = lg + 64 * 80;
    LAS float* rs = ssp + 256;
    const int lane = F.lane, wave = F.wave;
    for (int tile = F.bid; tile < M / 64; tile += F.G) {
        const int m0 = tile * 64;
        { const int tg = wave & 1, kq = wave >> 1, fr = lane & 15, fq = lane >> 4;
          f32x4 acc[2][5];
#pragma unroll
          for (int a = 0; a < 2; ++a)
#pragma unroll
              for (int n = 0; n < 5; ++n) acc[a][n] = (f32x4){0.f, 0.f, 0.f, 0.f};
          float ss[2] = {0.f, 0.f};
          const size_t roff = (size_t)(m0 + 32 * tg + fr) * D + kq * 1024 + 8 * fq;
          const bf16_t* h0 = H + roff; const bf16_t* h1 = h0 + (size_t)16 * D;
          const float* gp = F.g_ffn + kq * 1024 + 8 * fq;
          const bf16_t* bh = RBH + (size_t)fr * D + kq * 1024 + 8 * fq; const bf16_t* bl = RBL + (size_t)fr * D + kq * 1024 + 8 * fq;
          RtLoad La, Lb; rt_load(La, h0, h1, gp, 0);
#pragma unroll 1
          for (int ks = 0; ks < 32; ks += 2) {
              rt_load(Lb, h0, h1, gp, (ks + 1) * 32); rt_step(La, bh, bl, acc, ss, ks * 32);
              if (ks + 2 < 32) rt_load(La, h0, h1, gp, (ks + 2) * 32);
              rt_step(Lb, bh, bl, acc, ss, (ks + 1) * 32); }
#pragma unroll
          for (int mi = 0; mi < 2; ++mi) { float s = ss[mi]; s += __shfl_xor(s, 16); s += __shfl_xor(s, 32); if (fq == 0) ssp[kq * 64 + 32 * tg + 16 * mi + fr] = s;
#pragma unroll
              for (int n = 0; n < 5; ++n)
#pragma unroll
                  for (int i = 0; i < 4; ++i) part[(kq * 64 + 32 * tg + 16 * mi + 4 * fq + i) * 80 + 16 * n + fr] = acc[mi][n][i]; } }
        __syncthreads();
        if (F.tid < 64) { const float s = (ssp[F.tid] + ssp[64 + F.tid]) + (ssp[128 + F.tid] + ssp[192 + F.tid]); const float r = 1.0f / sqrtf(s * (1.f / D) + RMS_EPS); rs[F.tid] = r; }
        __syncthreads();
        for (int i = F.tid; i < 64 * 80; i += NTHREADS) lg[i] = ((part[i] + part[5120 + i]) + (part[10240 + i] + part[15360 + i])) * rs[i / 80];
        __syncthreads();
        if (F.tid < 64) { const int tk = F.tid, m = m0 + tk; const LAS float* L = lg + tk * 80;
            float gl[8]; int g = 0; float gm;
#pragma unroll
            for (int c = 0; c < 8; ++c) gl[c] = L[c] + F.rg_b[c];
            gm = gl[0];
#pragma unroll
            for (int c = 1; c < 8; ++c) if (gl[c] > gm) { gm = gl[c]; g = c; }
            float gs = 0.f;
#pragma unroll
            for (int c = 0; c < 8; ++c) gs += expf(gl[c] - gm);
            const float gw = 1.0f / gs;
            float el[8];
#pragma unroll
            for (int j = 0; j < 8; ++j) el[j] = L[8 + g * 8 + j] + F.re_b[g * 8 + j];
            int i0 = 0; float e0 = el[0];
#pragma unroll
            for (int j = 1; j < 8; ++j) if (el[j] > e0) { e0 = el[j]; i0 = j; }
            int i1 = -1; float e1 = -3.0e38f;
#pragma unroll
            for (int j = 0; j < 8; ++j) if (j != i0 && el[j] > e1) { e1 = el[j]; i1 = j; }
            const float tt = expf(e1 - e0); const float w0 = 1.0f / (1.0f + tt), w1 = tt / (1.0f + tt);
            const int x0 = g * 8 + i0, x1 = g * 8 + i1;
            const size_t s0 = (size_t)x0 * CAPS + atomicAdd(ctl + CW_CNT + x0, 1u), s1 = (size_t)x1 * CAPS + atomicAdd(ctl + CW_CNT + x1, 1u); const float rr = rs[tk];
            int* t2tok = (int*)(F.ws + WS_T2 + T2_TOK); float* t2w = (float*)(F.ws + WS_T2 + T2_W); int* t2dst = (int*)(F.ws + WS_T2 + T2_DST); float* t2rs = (float*)(F.ws + WS_T2 + T2_RS);
            t2tok[s0] = m; t2w[s0] = gw * w0; t2dst[s0] = 2 * m; t2rs[s0] = rr; t2tok[s1] = m; t2w[s1] = gw * w1; t2dst[s1] = 2 * m + 1; t2rs[s1] = rr; }
        __syncthreads();
    }
}
__device__ __forceinline__ void p6_tables(Frame& F) {
    unsigned* ctl = (unsigned*)(F.ws + WS_CTL);
    const int* tok_e = (const int*)(F.ws + WS_TAB + T_TOKE); const float* tok_w = (const float*)(F.ws + WS_TAB + T_TOKW); const int* tok_r = (const int*)(F.ws + WS_TAB + T_TOKR);
    int* slot_tok = (int*)(F.ws + WS_TAB + T_SLOTTOK); float* slot_w = (float*)(F.ws + WS_TAB + T_SLOTW); int* slot_dst = (int*)(F.ws + WS_TAB + T_SLOTDST); int* tile_e = (int*)(F.ws + WS_TAB + T_TILEE);
    float* slot_rs = (float*)(F.ws + WS_TAB + T_SLOTRS); const float* RSTD = (const float*)(F.ws + WS_TAB + T_RSTD);
    LAS int* off = (LAS int*)F.lds; LAS int* cnt = off + 80;
    if (F.tid < 64) cnt[F.tid] = (int)ctl[CW_CNT + F.tid];
    __syncthreads();
    if (F.tid == 0) { int a = 0; for (int e = 0; e < 64; ++e) { off[e] = a; a += (cnt[e] + 255) & ~255; } off[64] = a; }
    __syncthreads();
    for (int i = F.bid * NTHREADS + F.tid; i < 2 * M; i += F.G * NTHREADS) { const int e = tok_e[i], s = off[e] + tok_r[i]; slot_tok[s] = i >> 1; slot_w[s] = tok_w[i]; slot_dst[s] = i; slot_rs[s] = RSTD[i >> 1]; }
    for (int e = F.bid; e < 64; e += F.G) for (int s = off[e] + cnt[e] + F.tid; s < off[e + 1]; s += NTHREADS) { slot_tok[s] = 0; slot_w[s] = 0.f; slot_dst[s] = -1; slot_rs[s] = 0.f; }
    if (F.bid == 1 % F.G) { int* eoff = (int*)(F.ws + WS_TAB + T_EOFF); if (F.tid < 65) eoff[F.tid] = off[F.tid];
        if (F.tid < 8) { int* ul = (int*)(F.ws + WS_TAB + T_ULUP) + F.tid * UL_UP; int n = 0;
            for (int e = F.tid; e < 64; e += 8) { const int nrb = (cnt[e] + mu::MR - 1) / mu::MR; for (int rb = 0; rb < nrb; ++rb) for (int cb = 0; cb < 8; ++cb) ul[n++] = (e << 16) | (rb << 8) | cb; }
            ctl[CW_NUP + F.tid] = (unsigned)n; }
        else if (F.tid >= 64 && F.tid < 72) { const int x = F.tid - 64; int* ul = (int*)(F.ws + WS_TAB + T_ULDN) + x * UL_DN; int n = 0;
            for (int e = x; e < 64; e += 8) { const int nrb = (cnt[e] + mu::DR - 1) / mu::DR; for (int rb = 0; rb < nrb; ++rb) for (int cq = 0; cq < 4; ++cq) ul[n++] = (e << 16) | (rb << 8) | cq; }
            ctl[CW_NDN + x] = (unsigned)n; } }
    if (F.bid == 0) { if (F.tid < 64) for (int t = off[F.tid] >> 8; t < (off[F.tid + 1] >> 8); ++t) tile_e[t] = F.tid;
        if (F.tid == 0) ctl[CW_NT] = (unsigned)(off[64] >> 8); }
}
__device__ __forceinline__ void p9_row(float* O, const bf16_t* Hb, const bf16_t* Y, const float* g, int m, int mnext, int lane, u32x2 (&v)[16], u32x2 (&vn)[16]) {
    const u32x2* y0 = (const u32x2*)(Y + (size_t)(2 * m) * D) + lane; const u32x2* y1 = (const u32x2*)(Y + (size_t)(2 * m + 1) * D) + lane;
    u32x2 a[16], b[16];
#pragma unroll
    for (int j = 0; j < 16; ++j) { a[j] = y0[64 * j]; b[j] = y1[64 * j]; }
    if (mnext < M) { const u32x2* xn = (const u32x2*)(Hb + (size_t)mnext * D) + lane;
#pragma unroll
        for (int j = 0; j < 16; ++j) vn[j] = xn[64 * j]; }
    f32x4* xr = (f32x4*)(O + (size_t)m * D) + lane; const f32x4* gr = (const f32x4*)g + lane; float s = 0.f;
    f32x4 t[16];
#pragma unroll
    for (int j = 0; j < 16; ++j) { t[j].x = bflo(v[j].x) + (bflo(a[j].x) + bflo(b[j].x)); t[j].y = bfhi(v[j].x) + (bfhi(a[j].x) + bfhi(b[j].x)); t[j].z = bflo(v[j].y) + (bflo(a[j].y) + bflo(b[j].y)); t[j].w = bfhi(v[j].y) + (bfhi(a[j].y) + bfhi(b[j].y));
        s += (t[j].x * t[j].x + t[j].y * t[j].y) + (t[j].z * t[j].z + t[j].w * t[j].w); }
    const float rstd = 1.0f / sqrtf(wave_sum(s) * (1.f / D) + RMS_EPS);
#pragma unroll
    for (int j = 0; j < 16; ++j) { const f32x4 gg = gr[64 * j]; xr[64 * j] = (f32x4){t[j].x * rstd * gg.x, t[j].y * rstd * gg.y, t[j].z * rstd * gg.z, t[j].w * rstd * gg.w}; }
}
__device__ __forceinline__ void p9_final(Frame& F) {
    const bf16_t* Y = (const bf16_t*)(F.ws + WS_Y); const bf16_t* Hb = (const bf16_t*)(F.ws + WS_HB); float* O = F.out;
    const int gw = F.bid * NWAVES + F.wave, NGW = F.G * NWAVES, lane = F.lane;
    u32x2 va[16], vb[16];
    int m = gw;
    if (m < M) { const u32x2* xr = (const u32x2*)(Hb + (size_t)m * D) + lane;
#pragma unroll
        for (int j = 0; j < 16; ++j) va[j] = xr[64 * j]; }
    while (m < M) {
        p9_row(O, Hb, Y, F.g_fin, m, m + NGW, lane, va, vb); m += NGW; if (m >= M) break;
        p9_row(O, Hb, Y, F.g_fin, m, m + NGW, lane, vb, va); m += NGW;
    }
}

__global__ void __launch_bounds__(NTHREADS, 2) hymba_fwd(Args args) {
    extern __shared__ __attribute__((aligned(16))) unsigned char lds[];
    Frame F;
    F.lds = (LAS unsigned char*)lds;
    F.tid = threadIdx.x; F.lane = F.tid & 63; F.wave = __builtin_amdgcn_readfirstlane(F.tid >> 6);
    F.G = gridDim.x; F.bid = blockIdx.x; F.ws = args.ws; F.out = args.out;
    F.x = (const float*)args.in[0]; F.pos = (const int*)args.in[1]; F.g_mix = (const float*)args.in[2]; F.w_in = (const float*)args.in[3]; F.w2 = (const float*)args.in[4];
    F.gb = (const float*)args.in[5]; F.g_gla = (const float*)args.in[6]; F.sinks = (const float*)args.in[7]; F.w_out = (const float*)args.in[8]; F.g_ffn = (const float*)args.in[9];
    F.rg_w = (const float*)args.in[10]; F.rg_b = (const float*)args.in[11]; F.re_w = (const float*)args.in[12]; F.re_b = (const float*)args.in[13];
    F.wg = (const float*)args.in[14]; F.wu = (const float*)args.in[15]; F.wd = (const float*)args.in[16]; F.g_fin = (const float*)args.in[17];
    volatile LAS unsigned* MISC = (volatile LAS unsigned*)(F.lds + MISC_OFF);
    for (int u = F.tid; u < (LDS_BYTES - LDSCTL_OFF) / 4; u += NTHREADS) ((LAS unsigned*)(F.lds + LDSCTL_OFF))[u] = 0u;
    __syncthreads();
    unsigned* ctl = (unsigned*)(F.ws + WS_CTL);
    XcdBarrier bar; bar.bar = ctl + CW_BAR; bar.x = 0; bar.st = nullptr;
    if (MK_N_LAUNCHES == 1) bar = xcd_barrier_post(ctl + CW_BAR, MISC + 8);
    const int lo = args.ph_lo, hi = args.ph_hi;
#define IN(k) (lo <= (k) && (k) < hi)
#define SEAM(k) do { if (IN(k) && IN((k) + 1)) xcd_barrier(bar); } while (0)
    bf16_t* U = (bf16_t*)(F.ws + WS_U); bf16_t* PROJ = (bf16_t*)(F.ws + WS_PROJ); bf16_t* MIX = (bf16_t*)(F.ws + WS_MIX);

    if (IN(0)) REP(0) { p0_prologue(F); } SEAM(0);
    if (IN(1)) REP(1) {
        pg8::DenseSched S; S.init(U, (const bf16_t*)(F.ws + WS_WIN), M, LDP, D, F.G, F.bid);
        pg8::EpiBf16 E{PROJ, LDP};
        pg8::gemm_phase<pg8::EpiBf16, pg8::DenseSched, true>(F.lds, D, S, E);
    } SEAM(1);
    if (IN(2)) {
        REP(20) for (int u = F.bid; u < 2048; u += F.G) gla_prep_unit(F, u);
        REP(21) for (int u = F.bid; u < 1024; u += F.G) swa_unit(F, u >> 9, (u >> 7) & 3, u & 127);
    } SEAM(2);
    if (IN(3)) REP(3) { for (int c = F.bid; c < 256; c += F.G) { const int cc = (F.G == 256) ? (((c & 7) * 2 + (c >> 7)) << 4) | ((c >> 3) & 15) : c; gla_scan_chain(F, cc); } } SEAM(3);
    if (IN(4)) REP(4) { gla_norm(F); } SEAM(4);
    if (IN(5)) REP(5) {
        pg8::DenseSched S; S.init(MIX, (const bf16_t*)(F.ws + WS_WOUT), M, D, D, F.G, F.bid);
        pg8::EpiResBf16 E{F.x, (bf16_t*)(F.ws + WS_HB), D};
        pg8::gemm_phase<pg8::EpiResBf16, pg8::DenseSched, true>(F.lds, D, S, E);
    } SEAM(5);
    if (IN(6)) { p5_router(F); } SEAM(6);
    LAS int* eo = (LAS int*)(F.lds + MOE_TAB_OFF); LAS int* ecnt = eo + 80;
#define MOE_OFFSETS() do { __syncthreads(); if (F.tid < 64) { const int c_ = (int)ctl[CW_CNT + F.tid]; int s_ = c_; _Pragma("unroll") for (int d_ = 1; d_ < 64; d_ <<= 1) { const int t_ = __shfl_up(s_, d_); if (F.lane >= d_) s_ += t_; } \
        eo[F.tid + 1] = s_; ecnt[F.tid] = c_; if (F.tid == 0) eo[0] = 0; } __syncthreads(); } while (0)
#define MOE_UNIT(idx_, x_, RMAX, CBN, e_, rb_, cb_, ok_) do { int b_ = 0; ok_ = false; for (int k_ = 0; k_ < 8; ++k_) { const int ee_ = (x_) + 8 * k_, n_ = ((ecnt[ee_] + (RMAX) - 1) / (RMAX)) * (CBN); \
        if ((idx_) < b_ + n_) { e_ = ee_; rb_ = ((idx_) - b_) / (CBN); cb_ = ((idx_) - b_) % (CBN); ok_ = true; break; } b_ += n_; } } while (0)
    if (IN(8)) REP(8) {
        __syncthreads(); for (int i = F.tid; i < D / 4; i += NTHREADS) ((LAS f32x4*)(F.lds + mu::GAIN_OFF))[i] = ((const f32x4*)F.g_ffn)[i];
        MOE_OFFSETS();
        const int x = F.bid & 7;
        for (int j = F.bid >> 3; ; j += F.G >> 3) { int e = 0, rb = 0, cb = 0; bool ok; MOE_UNIT(j, x, mu::MR, 8, e, rb, cb, ok); if (!ok) break;
            const int n = ecnt[e], nrb = (n + mu::MR - 1) / mu::MR, base = n / nrb, rem = n % nrb, r0 = rb * base + (rb < rem ? rb : rem), nv = base + (rb < rem ? 1 : 0);
            const long adj = (long)e * CAPS - eo[e];
            mu::moe_unit<0>(F.lds, e, cb, eo[e] + r0, nv, (const bf16_t*)(F.ws + WS_HB), (const int*)(F.ws + WS_T2 + T2_TOK) + adj, F.wg, F.wu, (bf16_t*)(F.ws + WS_HID), (const float*)(F.ws + WS_T2 + T2_RS) + adj, nullptr); }
    } SEAM(8);
    if (IN(9)) REP(9) {
        MOE_OFFSETS();
        const int x = F.bid & 7;
        for (int j = F.bid >> 3; ; j += F.G >> 3) { int e = 0, rb = 0, cq = 0; bool ok; MOE_UNIT(j, x, mu::DR, 4, e, rb, cq, ok); if (!ok) break;
            const int n = ecnt[e], nrb = (n + mu::DR - 1) / mu::DR, base = n / nrb, rem = n % nrb, r0 = rb * base + (rb < rem ? rb : rem), nv = base + (rb < rem ? 1 : 0);
            const long adj = (long)e * CAPS - eo[e];
            mu::moe_down_stream(F.lds, e, 8 * cq, eo[e] + r0, nv, (const bf16_t*)(F.ws + WS_HID), F.wd, (bf16_t*)(F.ws + WS_Y), (const float*)(F.ws + WS_T2 + T2_W) + adj, (const int*)(F.ws + WS_T2 + T2_DST) + adj); }
    } SEAM(9);
#undef MOE_OFFSETS
#undef MOE_UNIT
    if (IN(10)) { p9_final(F); }
#undef IN
#undef SEAM
}

extern "C" void kernel_launch(void* const* d_in, const int* in_sizes, int n_in, void* d_out, int out_size, void* d_ws, size_t ws_size, hipStream_t stream) {
    static int grid = 0;
    if (grid == 0) {
        if (n_in != 18 || out_size != M * D || ws_size < WS_END) { fprintf(stderr, "kernel_launch: unexpected shapes (n_in %d, out %d, ws %zu < %zu)\n", n_in, out_size, ws_size, (size_t)WS_END); grid = -1; return; }
        int dev = 0, cus = 0, per_cu = 0;
        if (hipGetDevice(&dev) != hipSuccess || hipDeviceGetAttribute(&cus, hipDeviceAttributeMultiprocessorCount, dev) != hipSuccess) { grid = -1; return; }
        if (hipFuncSetAttribute((const void*)hymba_fwd, hipFuncAttributeMaxDynamicSharedMemorySize, LDS_BYTES) != hipSuccess) { fprintf(stderr, "kernel_launch: hipFuncSetAttribute failed\n"); grid = -1; return; }
        if (hipOccupancyMaxActiveBlocksPerMultiprocessor(&per_cu, (const void*)hymba_fwd, NTHREADS, LDS_BYTES) != hipSuccess || per_cu < 1) { fprintf(stderr, "kernel_launch: occupancy query says %d\n", per_cu); }
        (void)hipGetLastError();
        grid = cus;
    }
    if (grid < 0) return;
    (void)in_sizes;
    if (hipMemsetAsync((char*)d_ws + WS_CTL, 0, CTL_ZERO_BYTES, stream) != hipSuccess) return;
    Args a{};
    for (int i = 0; i < 18; ++i) a.in[i] = d_in[i];
    a.out = (float*)d_out; a.ws = (unsigned char*)d_ws;
    if (MK_N_LAUNCHES == 1) { a.ph_lo = 0; a.ph_hi = N_PHASES; hipLaunchKernelGGL(hymba_fwd, dim3(grid), dim3(NTHREADS), LDS_BYTES, stream, a); }
    else for (int p = 0; p < N_PHASES; ++p) { a.ph_lo = p; a.ph_hi = p + 1; hipLaunchKernelGGL(hymba_fwd, dim3(grid), dim3(NTHREADS), LDS_BYTES, stream, a); }
}
```

```cpp
#include <hip/hip_runtime.h>
#include <cstdio>
#include <cstdint>

#ifndef MK_N_LAUNCHES
#define MK_N_LAUNCHES 1
#endif

#ifndef PROBE_DUP
#define PROBE_DUP -1
#endif
#define REP(k) for (int rep_ = 0; rep_ < ((PROBE_DUP) == (k) ? 2 : 1); ++rep_)
#define GAS __attribute__((address_space(1)))
#define LAS __attribute__((address_space(3)))
#define PG8_LAS __attribute__((address_space(3)))

typedef unsigned short bf16_t;
typedef short bf16x8 __attribute__((ext_vector_type(8)));
typedef float f32x4 __attribute__((ext_vector_type(4)));
typedef float f32x2 __attribute__((ext_vector_type(2)));
typedef unsigned u32x4 __attribute__((ext_vector_type(4)));
typedef unsigned u32x2 __attribute__((ext_vector_type(2)));

constexpr int D = 4096, BATCH = 2, SEQ = 8192, M = BATCH * SEQ;
constexpr int IN_COLS = 8720, LDP = 8960;
constexpr int C_GQ = 0, C_GK = 1024, C_GV = 2048, C_GR = 4096, C_SQ = 6144, C_SK = 8192, C_SV = 8448, C_GA = 8704;
constexpr int NEXP = 64, DFF = 512;
constexpr int MAXSLOT = 49152;
constexpr float RMS_EPS = 1e-6f;

constexpr size_t MiB = 1u << 20;
constexpr size_t WS_CTL = 0, CTL_ZERO_BYTES = 1 * MiB;
constexpr size_t WS_TAB = 1 * MiB;
constexpr size_t WS_ROPE = 8 * MiB;
constexpr size_t WS_RB = 14 * MiB;
constexpr size_t WS_WIN = 32 * MiB;
constexpr size_t WS_WOUT = 102 * MiB;
constexpr size_t WS_U = 134 * MiB;
constexpr size_t WS_MIX = 262 * MiB;
constexpr size_t WS_PROJ = 390 * MiB;
constexpr size_t WS_Y = 390 * MiB;
constexpr size_t WS_HB = 670 * MiB;
constexpr size_t WS_WGU = 670 * MiB;
constexpr size_t WS_T2 = 1182 * MiB;
constexpr size_t T2_TOK = 0, T2_W = 4 * MiB, T2_DST = 8 * MiB, T2_RS = 12 * MiB; constexpr int CAPS = 16384;
constexpr size_t WS_WD = 1182 * MiB;
constexpr size_t WS_HID = 1438 * MiB;
constexpr size_t WS_QIN = 1486 * MiB;
constexpr size_t WS_KDT = 1518 * MiB;
constexpr size_t WS_AM = 1550 * MiB;
constexpr size_t WS_DEC = 1566 * MiB;
constexpr size_t WS_ORAW = 1568 * MiB;
constexpr size_t WS_END = 1632 * MiB;
constexpr size_t T_TOKE = 0;
constexpr size_t T_TOKW = 256 * 1024;
constexpr size_t T_TOKR = 512 * 1024;
constexpr size_t T_SLOTTOK = 768 * 1024;
constexpr size_t T_SLOTW = 1024 * 1024;
constexpr size_t T_SLOTDST = 1280 * 1024;
constexpr size_t T_TILEE = 1536 * 1024;
constexpr int UL_UP = 2048, UL_DN = 8192;
constexpr size_t T_ULUP = 1800 * 1024;
constexpr size_t T_EOFF = 1900 * 1024;
constexpr size_t T_ULDN = 2048 * 1024;
constexpr size_t T_RSTD = 1540 * 1024;
constexpr size_t T_SLOTRS = 1604 * 1024;
constexpr int CW_CNT = 1024;
constexpr int CW_NT = 1100;
constexpr int CW_NUP = 1200, CW_NDN = 1216;
constexpr int CW_BAR = 4096;

constexpr int RING_BYTES = 141312;
constexpr int LDSCTL_OFF = RING_BYTES, MISC_OFF = LDSCTL_OFF + 320;
constexpr int LDS_BYTES = 142336;

#define LDS_WAIT() asm volatile("s_waitcnt lgkmcnt(0)" ::: "memory")
#define VM_WAIT() asm volatile("s_waitcnt vmcnt(0)" ::: "memory")
__device__ __forceinline__ unsigned f2bf(float f) { unsigned u = __builtin_bit_cast(unsigned, f); return (u + 0x7fffu + ((u >> 16) & 1u)) >> 16; }
__device__ __forceinline__ unsigned pk2(float lo, float hi) { return f2bf(lo) | (f2bf(hi) << 16); }
__device__ __forceinline__ float bf2f(unsigned short b) { return __builtin_bit_cast(float, ((unsigned)b) << 16); }
__device__ __forceinline__ float bflo(unsigned w) { return __builtin_bit_cast(float, w << 16); }
__device__ __forceinline__ float bfhi(unsigned w) { return __builtin_bit_cast(float, w & 0xffff0000u); }
__device__ __forceinline__ unsigned cvt_pk_bf16(float lo, float hi) { unsigned r; asm volatile("v_cvt_pk_bf16_f32 %0, %1, %2" : "=v"(r) : "v"(lo), "v"(hi)); return r; }
typedef float f32x16 __attribute__((ext_vector_type(16)));
typedef short s16x4 __attribute__((ext_vector_type(4)));
typedef __bf16 bf16x2_t __attribute__((ext_vector_type(2)));
__device__ __forceinline__ unsigned cvtpk(float lo, float hi) { f32x2 v = {lo, hi}; bf16x2_t b = __builtin_convertvector(v, bf16x2_t); return __builtin_bit_cast(unsigned, b); }
__device__ __forceinline__ float wave_sum(float v) {
#pragma unroll
    for (int o = 1; o < 64; o <<= 1) v += __shfl_xor(v, o);
    return v;
}

#define XB_TMO      128
#define XB_XCNT(j)  (256  + 64 * (j))
#define XB_XSUB(j)  (1280 + 64 * (j))
#define XB_XGEN(j)  (2304 + 64 * (j))
#define XB_TOP      3328
#define XB_TOPGEN   3392
#define XCD_BAR_WORDS 3456
#define XB_SPIN_CAP (1u << 18)

__device__ __forceinline__ unsigned xb_ld(unsigned* p)              { return __hip_atomic_load(p, __ATOMIC_RELAXED, __HIP_MEMORY_SCOPE_AGENT); }
__device__ __forceinline__ unsigned xb_add(unsigned* p, unsigned v) { return __hip_atomic_fetch_add(p, v, __ATOMIC_RELAXED, __HIP_MEMORY_SCOPE_AGENT); }
__device__ __forceinline__ unsigned xb_xcc_id() { return (unsigned)__builtin_amdgcn_s_getreg((3 << 11) | 20) & 0xFu; }
#define XB_SPIN(cond, bar) do { unsigned _sp = 0; while (cond) { __builtin_amdgcn_s_sleep(1); \
    if ((++_sp & 255u) == 0u) { if (xb_ld(&(bar)[XB_TMO])) break; if (_sp > XB_SPIN_CAP) { atomicAdd(&(bar)[XB_TMO], 1u); break; } } } } while (0)

struct XcdBarrier { unsigned* bar; unsigned x; volatile LAS unsigned* st; };

__device__ __forceinline__ XcdBarrier xcd_barrier_post(unsigned* bar, volatile LAS unsigned* st) {
    XcdBarrier b; b.bar = bar; b.x = xb_xcc_id(); b.st = st;
    if (threadIdx.x == 0) (void)xb_add(&bar[XB_XCNT(b.x)], 1u);
    return b;
}
__device__ __forceinline__ void xcd_barrier_complete(unsigned* bar, unsigned x, unsigned& nloc, unsigned& nx) {
    const unsigned G = gridDim.x * gridDim.y * gridDim.z;
    unsigned sum, cnt, mine, sp = 0u;
    for (;;) {
        sum = 0u; cnt = 0u; mine = 0u;
#pragma unroll
        for (unsigned j = 0; j < 16; ++j) { const unsigned c = xb_ld(&bar[XB_XCNT(j)]); sum += c; cnt += (c > 0u) ? 1u : 0u; mine = (j == x) ? c : mine; }
        if (sum == G) break;
        __builtin_amdgcn_s_sleep(1);
        if ((++sp & 255u) == 0u) { if (xb_ld(&bar[XB_TMO])) break; if (sp > XB_SPIN_CAP) { atomicAdd(&bar[XB_TMO], 1u); break; } }
    }
    nloc = mine > 0u ? mine : 1u; nx = cnt > 0u ? cnt : 1u;
}
__device__ __forceinline__ void xcd_barrier(const XcdBarrier& b) {
    asm volatile("s_waitcnt vmcnt(0)" ::: "memory");
    __syncthreads();
    if (threadIdx.x == 0) {
        unsigned* bar = b.bar;
        __builtin_amdgcn_s_waitcnt(0);
        unsigned nloc = b.st[0], nx = b.st[1];
        if (nloc == 0u) { xcd_barrier_complete(bar, b.x, nloc, nx); b.st[0] = nloc; b.st[1] = nx; }
        const unsigned old = xb_add(&bar[XB_XSUB(b.x)], 1u);
        const unsigned gen = old / nloc;
        if (old + 1u == (gen + 1u) * nloc) {
            __builtin_amdgcn_fence(__ATOMIC_RELEASE, "agent");
            asm volatile("s_waitcnt vmcnt(0)" ::: "memory");
            const unsigned og = xb_add(&bar[XB_TOP], 1u);
            const unsigned tg = og / nx;
            if (og + 1u == (tg + 1u) * nx) xb_add(&bar[XB_TOPGEN], 1u);
            else XB_SPIN(xb_ld(&bar[XB_TOPGEN]) == tg, bar);
            __builtin_amdgcn_fence(__ATOMIC_ACQUIRE, "agent");
            xb_add(&bar[XB_XGEN(b.x)], 1u);
            asm volatile("s_waitcnt vmcnt(0)" ::: "memory");
        } else {
            XB_SPIN(xb_ld(&bar[XB_XGEN(b.x)]) == gen, bar);
            __builtin_amdgcn_fence(__ATOMIC_ACQUIRE, "agent");
            asm volatile("s_waitcnt vmcnt(0)" ::: "memory");
        }
    }
    __syncthreads();
}

namespace pg8 {
constexpr int BM = 256, BK = 64, HALF = 128, HTB = HALF * BK * 2, STAGE_BYTES = 8 * HTB, NXCD = 8, WGM = 8;
__host__ __device__ __forceinline__ int lds_byte(int r, int c) { const int st = (r >> 4) * 2 + (c >> 5), rr = r & 15, cc = c & 31, ob = rr * 64 + cc * 2; return st * 1024 + (ob ^ (((ob >> 9) & 1) << 5)); }
__host__ __device__ __forceinline__ void stage_rc(int b, int& R, int& C) { const int st = b / 1024, sb = b % 1024, swz = sb ^ (((sb >> 9) & 1) << 5); R = (st >> 1) * 16 + swz / 64; C = (st & 1) * 32 + (swz % 64) / 2; }
__host__ __device__ __forceinline__ int perm32(int rho) { const int n = rho >> 4, i = rho & 15; return 8 * (i >> 2) + 4 * n + (i & 3); }

struct Unit { int pm, pn, e; };

struct DenseSched {
    static constexpr bool GATHER = false;
    const bf16_t* A; const bf16_t* Bt; int K;
    int nM, nN, nwg, G, c;
    __device__ void init(const bf16_t* A_, const bf16_t* Bt_, int Mr, int N, int K_, int G_, int c_) { A = A_; Bt = Bt_; K = K_; nM = Mr / BM; nN = N / BM; nwg = nM * nN; G = G_; c = c_; }
    __device__ bool next(int i, Unit& u) const {
        const long L = (long)i * G + c; if (L >= nwg) return false;
        int wgid = (int)L; { const int q = nwg / NXCD, r = nwg % NXCD, xcd = wgid % NXCD, off = wgid / NXCD; wgid = (xcd < r ? xcd * (q + 1) : r * (q + 1) + (xcd - r) * q) + off; }
        const int nig = WGM * nN, gid = wgid / nig, fm = gid * WGM, gsz = (nM - fm) < WGM ? (nM - fm) : WGM;
        u.pm = fm + ((wgid % nig) % gsz); u.pn = (wgid % nig) / gsz; u.e = 0; return true;
    }
    __device__ __forceinline__ const char* a_ptr(const Unit& u) const { return (const char*)A + (size_t)u.pm * BM * K * 2; }
    __device__ __forceinline__ const char* b_ptr(const Unit& u) const { return (const char*)Bt + (size_t)u.pn * BM * K * 2; }
    __device__ __forceinline__ unsigned row(const Unit&, int) const { return 0u; }
};
struct MoeUpSched {
    static constexpr bool GATHER = true;
    const bf16_t* A; const bf16_t* Bt; const int* tile_e; const int* slot_tok; int ntiles, G, c;
    __device__ bool next(int i, Unit& u) const {
        if ((G & 7) == 0) { const int x = c & 7, idx = (c >> 3) + (G >> 3) * i; u.pm = 8 * (idx >> 2) + x; u.pn = idx & 3; if (u.pm >= ntiles) return false; }
        else { const int L = i * G + c; if (L >= ntiles * 4) return false; u.pm = L >> 2; u.pn = L & 3; }
        u.e = tile_e[u.pm]; return true;
    }
    __device__ __forceinline__ const char* a_ptr(const Unit&) const { return (const char*)A; }
    __device__ __forceinline__ const char* b_ptr(const Unit& u) const { return (const char*)Bt + ((size_t)u.e * 1024 + (size_t)u.pn * 256) * 4096 * 2; }
    __device__ __forceinline__ unsigned row(const Unit& u, int r) const { return (unsigned)slot_tok[u.pm * 256 + r]; }
};
struct MoeDownSched {
    static constexpr bool GATHER = false;
    const bf16_t* A; const bf16_t* Bt; const int* tile_e; int ntiles, G, c;
    __device__ bool next(int i, Unit& u) const {
        const int L = i * G + c; if (L >= ntiles * 16) return false;
        u.pm = L >> 4; u.pn = L & 15; u.e = tile_e[u.pm]; return true;
    }
    __device__ __forceinline__ const char* a_ptr(const Unit& u) const { return (const char*)A + (size_t)u.pm * 256 * 512 * 2; }
    __device__ __forceinline__ const char* b_ptr(const Unit& u) const { return (const char*)Bt + ((size_t)u.e * 4096 + (size_t)u.pn * 256) * 512 * 2; }
    __device__ __forceinline__ unsigned row(const Unit&, int) const { return 0u; }
};

struct EpiBf16 {
    static constexpr bool PERM = true;
    bf16_t* O; int ldc;
    __device__ __forceinline__ void operator()(const f32x4 (&acc)[2][2][4][2], const Unit& u, int wr, int wc, int fr, int fq) const {
        const int row0 = u.pm * BM + wr * 64 + fr, col0 = u.pn * BM + wc * 32 + 8 * fq;
#pragma unroll
        for (int ai = 0; ai < 2; ++ai)
#pragma unroll
            for (int m = 0; m < 4; ++m) { bf16_t* rowp = O + (size_t)(row0 + ai * HALF + m * 16) * ldc + col0;
#pragma unroll
                for (int bj = 0; bj < 2; ++bj) { const f32x4 v0 = acc[ai][bj][m][0], v1 = acc[ai][bj][m][1];
                    u32x4 w; w.x = cvt_pk_bf16(v0[0], v0[1]); w.y = cvt_pk_bf16(v0[2], v0[3]); w.z = cvt_pk_bf16(v1[0], v1[1]); w.w = cvt_pk_bf16(v1[2], v1[3]);
                    *(u32x4*)(rowp + bj * HALF) = w; } }
    }
};
struct EpiResF32 {
    static constexpr bool PERM = false;
    const float* res; float* out; int ldc;
    __device__ __forceinline__ void operator()(const f32x4 (&acc)[2][2][4][2], const Unit& u, int wr, int wc, int fr, int fq) const {
        const int row0 = u.pm * BM + wr * 64 + fr, col0 = u.pn * BM + wc * 32 + 4 * fq;
#pragma unroll
        for (int ai = 0; ai < 2; ++ai)
#pragma unroll
            for (int m = 0; m < 4; ++m) { const size_t off = (size_t)(row0 + ai * HALF + m * 16) * ldc + col0;
#pragma unroll
                for (int bj = 0; bj < 2; ++bj)
#pragma unroll
                    for (int n = 0; n < 2; ++n) { const f32x4 r = *(const f32x4*)(res + off + bj * HALF + n * 16); *(f32x4*)(out + off + bj * HALF + n * 16) = r + acc[ai][bj][m][n]; }
                if (m & 1) asm volatile("" ::: "memory"); }
    }
};
struct EpiResBf16 {
    static constexpr bool PERM = true;
    const float* res; bf16_t* out; int ldc;
    __device__ __forceinline__ void operator()(const f32x4 (&acc)[2][2][4][2], const Unit& u, int wr, int wc, int fr, int fq) const {
        const int row0 = u.pm * BM + wr * 64 + fr, col0 = u.pn * BM + wc * 32 + 8 * fq;
#pragma unroll
        for (int ai = 0; ai < 2; ++ai)
#pragma unroll
            for (int m = 0; m < 4; ++m) { const size_t off = (size_t)(row0 + ai * HALF + m * 16) * ldc + col0;
#pragma unroll
                for (int bj = 0; bj < 2; ++bj) { const f32x4 v0 = *(const f32x4*)(res + off + bj * HALF) + acc[ai][bj][m][0], v1 = *(const f32x4*)(res + off + bj * HALF + 4) + acc[ai][bj][m][1];
                    u32x4 w; w.x = cvt_pk_bf16(v0[0], v0[1]); w.y = cvt_pk_bf16(v0[2], v0[3]); w.z = cvt_pk_bf16(v1[0], v1[1]); w.w = cvt_pk_bf16(v1[2], v1[3]);
                    *(u32x4*)(out + off + bj * HALF) = w; }
                if (m & 1) asm volatile("" ::: "memory"); }
    }
};
struct EpiSwiGlu {
    static constexpr bool PERM = true;
    bf16_t* HID; const float* slot_rs;
    __device__ __forceinline__ void operator()(const f32x4 (&acc)[2][2][4][2], const Unit& u, int wr, int wc, int fr, int fq) const {
        const int row0 = u.pm * BM + wr * 64 + fr, col0 = u.pn * 128 + wc * 32 + 8 * fq;
#pragma unroll
        for (int ai = 0; ai < 2; ++ai)
#pragma unroll
            for (int m = 0; m < 4; ++m) { bf16_t* rowp = HID + (size_t)(row0 + ai * HALF + m * 16) * DFF + col0; const float rs = slot_rs[row0 + ai * HALF + m * 16];
                float h[8];
#pragma unroll
                for (int n = 0; n < 2; ++n)
#pragma unroll
                    for (int j = 0; j < 4; ++j) { const float g = acc[ai][0][m][n][j] * rs, up = acc[ai][1][m][n][j] * rs; h[n * 4 + j] = g * __builtin_amdgcn_rcpf(1.0f + __expf(-g)) * up; }
                u32x4 w; w.x = cvt_pk_bf16(h[0], h[1]); w.y = cvt_pk_bf16(h[2], h[3]); w.z = cvt_pk_bf16(h[4], h[5]); w.w = cvt_pk_bf16(h[6], h[7]);
                *(u32x4*)rowp = w; }
    }
};
struct EpiDown {
    static constexpr bool PERM = true;
    bf16_t* Y; const int* slot_dst; const float* slot_w;
    __device__ __forceinline__ void operator()(const f32x4 (&acc)[2][2][4][2], const Unit& u, int wr, int wc, int fr, int fq) const {
        const int slot0 = u.pm * BM + wr * 64 + fr, col0 = u.pn * BM + wc * 32 + 8 * fq;
#pragma unroll
        for (int ai = 0; ai < 2; ++ai)
#pragma unroll
            for (int m = 0; m < 4; ++m) { const int slot = slot0 + ai * HALF + m * 16; const int dst = slot_dst[slot]; const float sw = slot_w[slot];
                if (dst >= 0) { bf16_t* rowp = Y + (size_t)dst * D + col0;
#pragma unroll
                    for (int bj = 0; bj < 2; ++bj) { const f32x4 v0 = acc[ai][bj][m][0] * sw, v1 = acc[ai][bj][m][1] * sw;
                        u32x4 w; w.x = cvt_pk_bf16(v0[0], v0[1]); w.y = cvt_pk_bf16(v0[2], v0[3]); w.z = cvt_pk_bf16(v1[0], v1[1]); w.w = cvt_pk_bf16(v1[2], v1[3]);
                        *(u32x4*)(rowp + bj * HALF) = w; } } }
    }
};

template <class Epi, class Sched, bool ALIGN_EPI>
__device__ __forceinline__ void gemm_phase(PG8_LAS unsigned char* lds, const int K, const Sched& S, const Epi& E) {
    const int tid = threadIdx.x, wid = __builtin_amdgcn_readfirstlane(tid >> 6), lane = tid & 63, wr = wid >> 2, wc = wid & 3, fr = lane & 15, fq = lane >> 4;
    const int nt = K / BK;
    unsigned voffA[2], voffB[2]; int RA[2], CA[2];
#pragma unroll
    for (int i = 0; i < 2; ++i) { int R, C; stage_rc(tid * 16 + i * 8192, R, C); const int Rb = Epi::PERM ? ((R & ~31) + perm32(R & 31)) : R;
        voffA[i] = (unsigned)(R * K + C) * 2u; voffB[i] = (unsigned)(Rb * K + C) * 2u; RA[i] = R; CA[i] = C; }
    const size_t kstep = (size_t)(BK * 2);
    const size_t hstep = (size_t)HALF * K * 2;
    const unsigned ldsw = (unsigned)wid * 1024u;
    const int aoff = lds_byte(wr * 64 + fr, fq * 8), boff = lds_byte(wc * 32 + fr, fq * 8);
#define PG8_SA(b, h) (((b) * 2 + (h)) * HTB)
#define PG8_SB(b, h) ((4 + (b) * 2 + (h)) * HTB)
#define PG8_STAGE(bufoff, gbase, voff) do { _Pragma("unroll") for (int _i = 0; _i < 2; ++_i) \
        __builtin_amdgcn_global_load_lds((const unsigned*)((const char*)(gbase) + (voff)[_i]), (PG8_LAS unsigned*)(lds + (bufoff) + ldsw + _i * 8192), 16, 0, 0); } while (0)
#define PG8_STAGE_A(bufoff, gb, vo, h) do { if constexpr (Sched::GATHER) { PG8_STAGE(bufoff, gb, (vo)[h]); } else { PG8_STAGE(bufoff, (gb) + (h) * hstep, voffA); } } while (0)
#define PG8_LDA(dst, b, h) do { _Pragma("unroll") for (int m = 0; m < 4; ++m) _Pragma("unroll") for (int k = 0; k < 2; ++k) dst[m][k] = *(const PG8_LAS bf16x8*)(lds + PG8_SA(b, h) + aoff + m * 2048 + k * 1024); } while (0)
#define PG8_LDB(dst, b, h) do { _Pragma("unroll") for (int n = 0; n < 2; ++n) _Pragma("unroll") for (int k = 0; k < 2; ++k) dst[n][k] = *(const PG8_LAS bf16x8*)(lds + PG8_SB(b, h) + boff + n * 2048 + k * 1024); } while (0)
#define PG8_MMA(ai, bj, At, Bt) do { __builtin_amdgcn_s_setprio(1); _Pragma("unroll") for (int m = 0; m < 4; ++m) _Pragma("unroll") for (int n = 0; n < 2; ++n) _Pragma("unroll") for (int k = 0; k < 2; ++k) \
        acc[ai][bj][m][n] = __builtin_amdgcn_mfma_f32_16x16x32_bf16(Bt[n][k], At[m][k], acc[ai][bj][m][n], 0, 0, 0); __builtin_amdgcn_s_setprio(0); } while (0)
#define PG8_WAIT_V(n) asm volatile("s_waitcnt vmcnt(" #n ")" ::: "memory")
#define PG8_WAIT_L(n) asm volatile("s_waitcnt lgkmcnt(" #n ")" ::: "memory")
#define PG8_BAR __builtin_amdgcn_s_barrier()
#define PG8_SCHED __builtin_amdgcn_sched_barrier(0)
    Unit cur, nxt; int ui = 0;
    if (!S.next(0, cur)) return;
    f32x4 acc[2][2][4][2];
#pragma unroll
    for (int a = 0; a < 2; ++a)
#pragma unroll
        for (int b = 0; b < 2; ++b)
#pragma unroll
            for (int m = 0; m < 4; ++m)
#pragma unroll
                for (int n = 0; n < 2; ++n) acc[a][b][m][n] = (f32x4){0.f, 0.f, 0.f, 0.f};
    bf16x8 At[4][2], B0[2][2], B1[2][2];
    unsigned cvo[2][2], nvo[2][2];
#pragma unroll
    for (int h = 0; h < 2; ++h)
#pragma unroll
        for (int i = 0; i < 2; ++i) { cvo[h][i] = Sched::GATHER ? (S.row(cur, h * HALF + RA[i]) * (unsigned)K + (unsigned)CA[i]) * 2u : 0u; nvo[h][i] = cvo[h][i]; }
    const char* cA = S.a_ptr(cur); const char* cB = S.b_ptr(cur);
    PG8_STAGE(PG8_SB(0, 0), cB, voffB); PG8_STAGE(PG8_SB(0, 1), cB + hstep, voffB); PG8_STAGE_A(PG8_SA(0, 0), cA, cvo, 0); PG8_STAGE_A(PG8_SA(0, 1), cA, cvo, 1);
    if (wr == 1) PG8_BAR;
    PG8_WAIT_V(2); PG8_BAR;
    PG8_STAGE(PG8_SB(1, 0), cB + kstep, voffB); PG8_STAGE_A(PG8_SA(1, 0), cA + kstep, cvo, 0); PG8_STAGE(PG8_SB(1, 1), cB + hstep + kstep, voffB);
    PG8_WAIT_V(6); PG8_BAR;
    for (;;) {
        const bool has_next = S.next(ui + 1, nxt);
        const char* nA = has_next ? S.a_ptr(nxt) : cA; const char* nB = has_next ? S.b_ptr(nxt) : cB;
        if constexpr (Sched::GATHER) {
#pragma unroll
            for (int h = 0; h < 2; ++h)
#pragma unroll
                for (int i = 0; i < 2; ++i) nvo[h][i] = has_next ? (S.row(nxt, h * HALF + RA[i]) * (unsigned)K + (unsigned)CA[i]) * 2u : cvo[h][i];
        }
        for (int t = 0; t < nt; t += 2) {
            const bool last = (t == nt - 2);
            const char* a1 = cA + (size_t)(t + 1) * kstep;
            const char* a2 = last ? nA : cA + (size_t)(t + 2) * kstep; const char* b2 = last ? nB : cB + (size_t)(t + 2) * kstep;
            const char* a3 = a2 + kstep; const char* b3 = b2 + kstep;
            unsigned vo2[2][2];
#pragma unroll
            for (int h = 0; h < 2; ++h)
#pragma unroll
                for (int i = 0; i < 2; ++i) vo2[h][i] = last ? nvo[h][i] : cvo[h][i];
            PG8_LDB(B0, 0, 0); PG8_LDB(B1, 0, 1); PG8_SCHED; PG8_LDA(At, 0, 0); PG8_STAGE_A(PG8_SA(1, 1), a1, cvo, 1);
            PG8_WAIT_V(8); PG8_WAIT_L(0); PG8_BAR; PG8_MMA(0, 0, At, B0); PG8_MMA(0, 1, At, B1); PG8_BAR; PG8_SCHED;
            PG8_LDA(At, 0, 1); PG8_STAGE(PG8_SB(0, 0), b2, voffB); PG8_STAGE(PG8_SB(0, 1), b2 + hstep, voffB); PG8_STAGE_A(PG8_SA(0, 0), a2, vo2, 0);
            PG8_WAIT_V(8); PG8_WAIT_L(0); PG8_BAR; PG8_MMA(1, 0, At, B0); PG8_MMA(1, 1, At, B1); PG8_BAR; PG8_SCHED;
            PG8_LDB(B0, 1, 0); PG8_LDB(B1, 1, 1); PG8_SCHED; PG8_LDA(At, 1, 0); PG8_STAGE_A(PG8_SA(0, 1), a2, vo2, 1);
            PG8_WAIT_V(8); PG8_WAIT_L(0); PG8_BAR; PG8_MMA(0, 0, At, B0); PG8_MMA(0, 1, At, B1); PG8_BAR; PG8_SCHED;
            PG8_LDA(At, 1, 1); PG8_STAGE(PG8_SB(1, 0), b3, voffB); PG8_STAGE(PG8_SB(1, 1), b3 + hstep, voffB); PG8_STAGE_A(PG8_SA(1, 0), a3, vo2, 0);
            PG8_WAIT_V(8); PG8_WAIT_L(0); PG8_BAR; PG8_MMA(1, 0, At, B0); PG8_MMA(1, 1, At, B1); PG8_BAR; PG8_SCHED;
        }
        if constexpr (ALIGN_EPI) { if (wr == 0) PG8_BAR; }
        E(acc, cur, wr, wc, fr, fq);
        if (!has_next) break;
#pragma unroll
        for (int a = 0; a < 2; ++a)
#pragma unroll
            for (int b = 0; b < 2; ++b)
#pragma unroll
                for (int m = 0; m < 4; ++m)
#pragma unroll
                    for (int n = 0; n < 2; ++n) acc[a][b][m][n] = (f32x4){0.f, 0.f, 0.f, 0.f};
        cur = nxt; cA = nA; cB = nB; ++ui;
#pragma unroll
        for (int h = 0; h < 2; ++h)
#pragma unroll
            for (int i = 0; i < 2; ++i) cvo[h][i] = nvo[h][i];
        if constexpr (ALIGN_EPI) { if (wr == 1) PG8_BAR; }
    }
    PG8_WAIT_V(0);
    if constexpr (!ALIGN_EPI) { if (wr == 0) PG8_BAR; }
    PG8_BAR;
#undef PG8_SA
#undef PG8_SB
#undef PG8_STAGE
#undef PG8_STAGE_A
#undef PG8_LDA
#undef PG8_LDB
#undef PG8_MMA
#undef PG8_WAIT_V
#undef PG8_WAIT_L
#undef PG8_BAR
#undef PG8_SCHED
}
}

namespace mu {
constexpr int MR = 320, RWU = 80, NMU = 5, ABYTES = MR * 64 * 2, BBYTES = 128 * 64 * 2;
constexpr int GAIN_OFF = 2 * ABYTES + 2 * BBYTES;
__device__ __forceinline__ int lds_byte(int r, int c) { const int st = (r >> 4) * 2 + (c >> 5), ob = (r & 15) * 64 + (c & 31) * 2; return st * 1024 + (ob ^ (((ob >> 9) & 1) << 5)); }
__device__ __forceinline__ void stage_rc(int b, int& R, int& C) { const int st = b >> 10, sb = b & 1023, swz = sb ^ (((sb >> 9) & 1) << 5); R = (st >> 1) * 16 + swz / 64; C = (st & 1) * 32 + (swz % 64) / 2; }
template <int MODE>
__device__ __forceinline__ void moe_unit(PG8_LAS unsigned char* lds, int e, int cb, int slot0  , int nv  , const bf16_t* A, const int* slot_tok,
                                         const float* W0, const float* W1, bf16_t* OUT, const float* slot_rs  , const int* slot_dst) {
    constexpr int K = MODE == 0 ? 4096 : 512, nt = K / 64, LDB = MODE == 0 ? 512 : 4096, RB = LDB * 4  ;
    const int tid = threadIdx.x, wid = __builtin_amdgcn_readfirstlane(tid >> 6), lane = tid & 63, wr = wid >> 1, wc = wid & 1, fr = lane & 15, fq = lane >> 4;
    unsigned aoff[NMU];
#pragma unroll
    for (int i = 0; i < NMU; ++i) { int R, C; stage_rc(wid * 1024 + i * 8192 + lane * 16, R, C); const int w4 = R / RWU, r = 4 * (R - RWU * w4) + w4;
        const unsigned row = r < nv ? (MODE == 0 ? (unsigned)slot_tok[slot0 + r] : (unsigned)(slot0 + r)) : (MODE == 0 ? 0u : (unsigned)slot0); aoff[i] = (row * (unsigned)K + (unsigned)C) * 2u; }
    const int jj0 = 2 * (lane & 31), typ = lane >> 5;
    const int R0 = MODE == 0 ? 64 * (jj0 >> 5) + 32 * typ + 16 * ((jj0 >> 4) & 1) + (jj0 & 15) : 2 * lane;
    const char* Bb = MODE == 0 ? (const char*)((typ ? W1 : W0) + (size_t)e * K * LDB + 64 * cb + jj0) + (size_t)(8 * wid) * RB
                               : (const char*)(W0 + (size_t)e * K * LDB + 128 * cb + 2 * lane) + (size_t)(8 * wid) * RB;
    const unsigned bw0 = (unsigned)(R0 * 128 + ((wid ^ ((R0 >> 1) & 7)) * 16)), bw1 = bw0 + 128u;
    const int nvw = (nv - wr + 3) >> 2, mcnt = nvw <= 0 ? 0 : (((nvw + 15) >> 4) > NMU ? NMU : ((nvw + 15) >> 4));
#define MU_SA(b) (lds + (b) * ABYTES)
#define MU_SB(b) (lds + 2 * ABYTES + (b) * BBYTES)
#define MU_GLDS_A(buf, kt) do { _Pragma("unroll") for (int i = 0; i < NMU; ++i) \
        __builtin_amdgcn_global_load_lds((const unsigned*)((const char*)A + aoff[i] + (size_t)(kt) * 128), (PG8_LAS unsigned*)(MU_SA(buf) + wid * 1024 + i * 8192), 16, 0, 0); } while (0)
#define MU_B_ISSUE(sb, kt) do { const char* kb_ = Bb + (size_t)(kt) * (64 * (size_t)RB); _Pragma("unroll") for (int j = 0; j < 8; ++j) { const char* p_ = kb_ + (size_t)j * RB; \
        asm volatile("global_load_dwordx2 %0, %1, off" : "=&v"(sb[j]) : "v"(p_) : "memory"); } } while (0)
#define MU_B_WAIT(sb, N) asm volatile("s_waitcnt vmcnt(%8)" : "+v"(sb[0]), "+v"(sb[1]), "+v"(sb[2]), "+v"(sb[3]), "+v"(sb[4]), "+v"(sb[5]), "+v"(sb[6]), "+v"(sb[7]) : "n"(N) : "memory")
#define MU_G_LOAD(ga, kt) do { const PG8_LAS f32x4* gk_ = (const PG8_LAS f32x4*)(lds + GAIN_OFF) + 16 * (kt) + 2 * wid; const f32x4 ga_ = gk_[0], gb_ = gk_[1]; \
        ga[0] = ga_[0]; ga[1] = ga_[1]; ga[2] = ga_[2]; ga[3] = ga_[3]; ga[4] = gb_[0]; ga[5] = gb_[1]; ga[6] = gb_[2]; ga[7] = gb_[3]; } while (0)
#define MU_B_WRITE(sb, buf, ga) do { u32x4 w0_, w1_; w0_.x = cvtpk(sb[0].x * ga[0], sb[1].x * ga[1]); w0_.y = cvtpk(sb[2].x * ga[2], sb[3].x * ga[3]); w0_.z = cvtpk(sb[4].x * ga[4], sb[5].x * ga[5]); w0_.w = cvtpk(sb[6].x * ga[6], sb[7].x * ga[7]); \
        w1_.x = cvtpk(sb[0].y * ga[0], sb[1].y * ga[1]); w1_.y = cvtpk(sb[2].y * ga[2], sb[3].y * ga[3]); w1_.z = cvtpk(sb[4].y * ga[4], sb[5].y * ga[5]); w1_.w = cvtpk(sb[6].y * ga[6], sb[7].y * ga[7]); \
        *(PG8_LAS u32x4*)(MU_SB(buf) + bw0) = w0_; *(PG8_LAS u32x4*)(MU_SB(buf) + bw1) = w1_; } while (0)
#define MU_RDA(buf, ks, m) (*(const PG8_LAS bf16x8*)(MU_SA(buf) + lds_byte(RWU * wr + 16 * (m) + fr, 32 * (ks) + 8 * fq)))
#define MU_RDB(buf, ks, n) (*(const PG8_LAS bf16x8*)(MU_SB(buf) + (64 * wc + 16 * (n) + fr) * 128 + (((4 * (ks) + fq) ^ (((64 * wc + 16 * (n) + fr) >> 1) & 7)) * 16)))
#define MU_COMPUTE_N(buf, MC) do { bf16x8 At[MC], Bf0[4], Bf1[4]; \
        _Pragma("unroll") for (int n = 0; n < 4; ++n) Bf0[n] = MU_RDB(buf, 0, n); \
        _Pragma("unroll") for (int m = 0; m < (MC); ++m) At[m] = MU_RDA(buf, 0, m); \
        _Pragma("unroll") for (int m = 0; m < (MC); ++m) { _Pragma("unroll") for (int n = 0; n < 4; ++n) acc[m][n] = __builtin_amdgcn_mfma_f32_16x16x32_bf16(Bf0[n], At[m], acc[m][n], 0, 0, 0); \
            At[m] = MU_RDA(buf, 1, m); if (m < 4) Bf1[m] = MU_RDB(buf, 1, m); } \
        _Pragma("unroll") for (int m = 0; m < (MC); ++m) { _Pragma("unroll") for (int n = 0; n < 4; ++n) acc[m][n] = __builtin_amdgcn_mfma_f32_16x16x32_bf16(Bf1[n], At[m], acc[m][n], 0, 0, 0); } \
        __builtin_amdgcn_sched_group_barrier(0x100, 4 + (MC), 0); \
        _Pragma("unroll") for (int m = 0; m < (MC); ++m) { __builtin_amdgcn_sched_group_barrier(0x008, 4, 0); __builtin_amdgcn_sched_group_barrier(0x100, 1, 0); if (m < 4) __builtin_amdgcn_sched_group_barrier(0x100, 1, 0); } \
        __builtin_amdgcn_sched_group_barrier(0x008, 4 * (MC), 0); \
        __builtin_amdgcn_sched_barrier(0); } while (0)
#define MU_COMPUTE(buf) MU_COMPUTE_N(buf, NMU)
#define MU_END(last) do { if (last) asm volatile("s_waitcnt vmcnt(0)" ::: "memory"); else asm volatile("s_waitcnt vmcnt(8)" ::: "memory"); \
        asm volatile("s_waitcnt lgkmcnt(0)" ::: "memory"); __builtin_amdgcn_s_barrier(); asm volatile("" ::: "memory"); } while (0)
    f32x4 acc[NMU][4];
#pragma unroll
    for (int m = 0; m < NMU; ++m)
#pragma unroll
        for (int n = 0; n < 4; ++n) acc[m][n] = (f32x4){0.f, 0.f, 0.f, 0.f};
    f32x2 s0[8], s1[8];
    float g0[8];
    MU_GLDS_A(0, 0); MU_B_ISSUE(s0, 0); MU_G_LOAD(g0, 0); MU_B_ISSUE(s1, 1);
    MU_B_WAIT(s0, 8); MU_B_WRITE(s0, 0, g0); __builtin_amdgcn_sched_barrier(0); MU_B_ISSUE(s0, 2);
    asm volatile("s_waitcnt vmcnt(16)" ::: "memory");
    asm volatile("s_waitcnt lgkmcnt(0)" ::: "memory"); __builtin_amdgcn_s_barrier(); asm volatile("" ::: "memory");
#pragma unroll 1
    for (int t = 0; t < nt; t += 2) {
        if (t + 2 < nt) MU_B_WAIT(s1, 8); else MU_B_WAIT(s1, 0);
        MU_G_LOAD(g0, t + 1); MU_B_WRITE(s1, 1, g0); __builtin_amdgcn_sched_barrier(0); MU_GLDS_A(1, t + 1); __builtin_amdgcn_sched_barrier(0);
        if (t + 3 < nt) { MU_B_ISSUE(s1, t + 3); }
        MU_COMPUTE(0);
        MU_END(t + 3 >= nt);
        if (t + 2 < nt) { MU_B_WAIT(s0, 8); MU_G_LOAD(g0, t + 2); MU_B_WRITE(s0, 0, g0); __builtin_amdgcn_sched_barrier(0); MU_GLDS_A(0, t + 2); __builtin_amdgcn_sched_barrier(0); }
        if (t + 4 < nt) { MU_B_ISSUE(s0, t + 4); }
        MU_COMPUTE(1);
        MU_END(t + 4 >= nt);
    }
#pragma unroll
    for (int m = 0; m < NMU; ++m) if (m < mcnt) { const int r = 4 * (16 * m + fr) + wr;
        if (r < nv) { const int slot = slot0 + r; const float rs = slot_rs[slot];
            if (MODE == 0) {
#pragma unroll
                for (int n = 0; n < 2; ++n) { float h[4];
#pragma unroll
                    for (int i = 0; i < 4; ++i) { const float g = acc[m][n][i] * rs, up = acc[m][n + 2][i] * rs; h[i] = g * __builtin_amdgcn_rcpf(1.0f + __expf(-g)) * up; }
                    u32x2 w; w.x = cvtpk(h[0], h[1]); w.y = cvtpk(h[2], h[3]); *(u32x2*)(OUT + (size_t)slot * DFF + 64 * cb + 32 * wc + 16 * n + 4 * fq) = w; }
            } else { const int dst = slot_dst[slot];
#pragma unroll
                for (int n = 0; n < 4; ++n) { const f32x4 v = acc[m][n] * rs; u32x2 w; w.x = cvtpk(v[0], v[1]); w.y = cvtpk(v[2], v[3]); *(u32x2*)(OUT + (size_t)dst * D + 128 * cb + 64 * wc + 16 * n + 4 * fq) = w; } } } }
#undef MU_SA
#undef MU_SB
#undef MU_GLDS_A
#undef MU_B_ISSUE
#undef MU_B_WAIT
#undef MU_B_WRITE
#undef MU_G_LOAD
#undef MU_COMPUTE
#undef MU_COMPUTE_N
#undef MU_RDA
#undef MU_RDB
#undef MU_END
}

constexpr int DR = 320, DRW = 80, DNM = 5, DABYTES = DR * 64 * 2;
__device__ __forceinline__ void moe_down_stream(PG8_LAS unsigned char* lds, int e, int cb0, int slot0, int nv, const bf16_t* HIDp, const float* Wd, bf16_t* Y, const float* slot_w, const int* slot_dst) {
    constexpr int K = 512, NT = 64, RB = 4096 * 4;
    const int tid = threadIdx.x, wid = __builtin_amdgcn_readfirstlane(tid >> 6), lane = tid & 63, wr = wid >> 1, wc = wid & 1, fr = lane & 15, fq = lane >> 4;
    unsigned aoff[5];
#pragma unroll
    for (int i = 0; i < 5; ++i) { int R, C; stage_rc(wid * 1024 + i * 8192 + lane * 16, R, C); const int w4 = R / DRW; int r = 4 * (R - DRW * w4) + w4; r = r < nv ? r : r % nv;
        aoff[i] = ((unsigned)(slot0 + r) * (unsigned)K + (unsigned)C) * 2u; }
    const int R0 = 2 * lane;
    const char* Bb = (const char*)(Wd + (size_t)e * K * 4096 + 128 * cb0 + 2 * lane) + (size_t)(8 * wid) * RB;
    const unsigned bw0 = (unsigned)(R0 * 128 + ((wid ^ ((R0 >> 1) & 7)) * 16)), bw1 = bw0 + 128u;
    const int nvw = (nv - wr + 3) >> 2, mcnt = nvw <= 0 ? 0 : (((nvw + 15) >> 4) > DNM ? DNM : ((nvw + 15) >> 4));
    unsigned amask = 0u;
#pragma unroll
    for (int i = 0; i < 5; ++i) { const int grp = 4 * i + (wid >> 1), w4 = grp / DNM, mf = grp % DNM, nv4 = (nv - w4 + 3) >> 2, mc4 = nv4 <= 0 ? 0 : ((nv4 + 15) >> 4); if (mf < mc4) amask |= 1u << i; }
    int dstv[DNM]; float wv[DNM];
#pragma unroll
    for (int m = 0; m < DNM; ++m) { const int r = 4 * (16 * m + fr) + wr; const bool ok = (m < mcnt) && (16 * m + fr < DRW) && (r < nv); dstv[m] = ok ? slot_dst[slot0 + r] : -1; wv[m] = ok ? slot_w[slot0 + r] : 0.f; }
    asm volatile("s_waitcnt vmcnt(0)" : "+v"(dstv[0]), "+v"(dstv[1]), "+v"(dstv[2]), "+v"(dstv[3]), "+v"(dstv[4]), "+v"(wv[0]), "+v"(wv[1]), "+v"(wv[2]), "+v"(wv[3]), "+v"(wv[4]) :: "memory");
#define MD_SA(b) (lds + (b) * DABYTES)
#define MD_SB(b) (lds + 2 * DABYTES + (b) * BBYTES)
#define MD_GLDS_A(buf, tau) do { _Pragma("unroll") for (int i = 0; i < 5; ++i) if (amask & (1u << i)) \
        __builtin_amdgcn_global_load_lds((const unsigned*)((const char*)HIDp + aoff[i] + (size_t)((tau) & 7) * 128), (PG8_LAS unsigned*)(MD_SA(buf) + wid * 1024 + i * 8192), 16, 0, 0); } while (0)
#define MD_B_ISSUE(sb, tau) do { const char* kb_ = Bb + (size_t)((tau) >> 3) * 512 + (size_t)((tau) & 7) * (64 * (size_t)RB); _Pragma("unroll") for (int j = 0; j < 8; ++j) { const char* p_ = kb_ + (size_t)j * RB; \
        asm volatile("global_load_dwordx2 %0, %1, off" : "=&v"(sb[j]) : "v"(p_) : "memory"); } } while (0)
#define MD_B_WAIT(sb, N) asm volatile("s_waitcnt vmcnt(%8)" : "+v"(sb[0]), "+v"(sb[1]), "+v"(sb[2]), "+v"(sb[3]), "+v"(sb[4]), "+v"(sb[5]), "+v"(sb[6]), "+v"(sb[7]) : "n"(N) : "memory")
#define MD_B_WRITE(sb, buf) do { u32x4 w0_, w1_; w0_.x = cvtpk(sb[0].x, sb[1].x); w0_.y = cvtpk(sb[2].x, sb[3].x); w0_.z = cvtpk(sb[4].x, sb[5].x); w0_.w = cvtpk(sb[6].x, sb[7].x); \
        w1_.x = cvtpk(sb[0].y, sb[1].y); w1_.y = cvtpk(sb[2].y, sb[3].y); w1_.z = cvtpk(sb[4].y, sb[5].y); w1_.w = cvtpk(sb[6].y, sb[7].y); \
        *(PG8_LAS u32x4*)(MD_SB(buf) + bw0) = w0_; *(PG8_LAS u32x4*)(MD_SB(buf) + bw1) = w1_; } while (0)
#define MD_RDA(buf, ks, m) (*(const PG8_LAS bf16x8*)(MD_SA(buf) + lds_byte(DRW * wr + 16 * (m) + fr, 32 * (ks) + 8 * fq)))
#define MD_RDB(buf, ks, n) (*(const PG8_LAS bf16x8*)(MD_SB(buf) + (64 * wc + 16 * (n) + fr) * 128 + (((4 * (ks) + fq) ^ (((64 * wc + 16 * (n) + fr) >> 1) & 7)) * 16)))
#define MD_COMPUTE(buf) do { bf16x8 At[DNM], Bf[4]; \
        _Pragma("unroll") for (int n = 0; n < 4; ++n) Bf[n] = MD_RDB(buf, 0, n); \
        _Pragma("unroll") for (int m = 0; m < DNM; ++m) At[m] = MD_RDA(buf, 0, m); \
        _Pragma("unroll") for (int m = 0; m < DNM; ++m) { _Pragma("unroll") for (int n = 0; n < 4; ++n) acc[m][n] = __builtin_amdgcn_mfma_f32_16x16x32_bf16(Bf[n], At[m], acc[m][n], 0, 0, 0); \
            At[m] = MD_RDA(buf, 1, m); } \
        __builtin_amdgcn_sched_barrier(0); \
        _Pragma("unroll") for (int n = 0; n < 4; ++n) Bf[n] = MD_RDB(buf, 1, n); \
        _Pragma("unroll") for (int m = 0; m < DNM; ++m) { _Pragma("unroll") for (int n = 0; n < 4; ++n) acc[m][n] = __builtin_amdgcn_mfma_f32_16x16x32_bf16(Bf[n], At[m], acc[m][n], 0, 0, 0); } \
        __builtin_amdgcn_sched_barrier(0); } while (0)
#define MD_END(last) do { if (last) asm volatile("s_waitcnt vmcnt(0)" ::: "memory"); else asm volatile("s_waitcnt vmcnt(8)" ::: "memory"); \
        asm volatile("s_waitcnt lgkmcnt(0)" ::: "memory"); __builtin_amdgcn_s_barrier(); asm volatile("" ::: "memory"); } while (0)
    f32x4 acc[DNM][4];
#pragma unroll
    for (int m = 0; m < DNM; ++m)
#pragma unroll
        for (int n = 0; n < 4; ++n) acc[m][n] = (f32x4){0.f, 0.f, 0.f, 0.f};
    f32x2 s0[8], s1[8];
    MD_GLDS_A(0, 0); MD_B_ISSUE(s0, 0); MD_B_ISSUE(s1, 1);
    MD_B_WAIT(s0, 8); MD_B_WRITE(s0, 0); __builtin_amdgcn_sched_barrier(0); MD_B_ISSUE(s0, 2);
    asm volatile("s_waitcnt vmcnt(16)" ::: "memory");
    asm volatile("s_waitcnt lgkmcnt(0)" ::: "memory"); __builtin_amdgcn_s_barrier(); asm volatile("" ::: "memory");
#pragma unroll 1
    for (int t = 0; t < NT; t += 2) {
        if (t + 2 < NT) MD_B_WAIT(s1, 8); else MD_B_WAIT(s1, 0);
        MD_B_WRITE(s1, 1); __builtin_amdgcn_sched_barrier(0); MD_GLDS_A(1, t + 1); __builtin_amdgcn_sched_barrier(0);
        if (t + 3 < NT) MD_B_ISSUE(s1, t + 3);
        MD_COMPUTE(0);
        MD_END(t + 3 >= NT);
        if (t + 2 < NT) { MD_B_WAIT(s0, 8); MD_B_WRITE(s0, 0); __builtin_amdgcn_sched_barrier(0); MD_GLDS_A(0, t + 2); __builtin_amdgcn_sched_barrier(0); }
        if (t + 4 < NT) MD_B_ISSUE(s0, t + 4);
        MD_COMPUTE(1);
        MD_END(t + 4 >= NT);
        if (((t + 1) & 7) == 7) {
            const int cb = cb0 + ((t + 1) >> 3);
#pragma unroll
            for (int m = 0; m < DNM; ++m) { if (dstv[m] >= 0) {
#pragma unroll
                    for (int n = 0; n < 4; ++n) { const f32x4 v = acc[m][n] * wv[m]; u32x2 w; w.x = cvtpk(v[0], v[1]); w.y = cvtpk(v[2], v[3]); *(u32x2*)(Y + (size_t)dstv[m] * D + 128 * cb + 64 * wc + 16 * n + 4 * fq) = w; } }
#pragma unroll
                for (int n = 0; n < 4; ++n) acc[m][n] = (f32x4){0.f, 0.f, 0.f, 0.f}; } }
    }
#undef MD_SA
#undef MD_SB
#undef MD_GLDS_A
#undef MD_B_ISSUE
#undef MD_B_WAIT
#undef MD_B_WRITE
#undef MD_COMPUTE
#undef MD_RDA
#undef MD_RDB
#undef MD_END
}
}

constexpr int NWAVES = 8, NTHREADS = 512;
constexpr int N_PHASES = 11;
constexpr int MOE_TAB_OFF = 132096;
struct Args { const void* in[18]; float* out; unsigned char* ws; int ph_lo, ph_hi; };

struct Frame {
    LAS unsigned char* lds;
    int tid, lane, wave, G, bid;
    unsigned char* ws;
    const float *x, *g_mix, *w_in, *w2, *gb, *g_gla, *sinks, *w_out, *g_ffn, *rg_w, *rg_b, *re_w, *re_b, *wg, *wu, *wd, *g_fin;
    const int* pos;
    float* out;
};

template <int MODE>
__device__ __forceinline__ int dest_row(int n, int row_off) {
    if (MODE == 0) return row_off + n;
    if (MODE == 1) return n < 6144 ? n : (n < 6160 ? C_GA + (n - 6144) : n - 16);
    if (MODE == 2) return row_off + 256 * (n >> 7) + (n & 127);
    return row_off + 256 * (n >> 7) + 128 + (n & 127);
}
template <int MODE>
__device__ __forceinline__ void transpose_item(const float* W, int K, int N, bf16_t* WT, int row_off, LAS float* scr, int item, int lane) {
    const int nblk = (N + 31) / 32, nb = (item >> 3) % nblk, kb = (item & 7) + 8 * (item / (8 * nblk)), k0 = 64 * kb, n0 = 32 * nb;
    const bool nok = (n0 + (lane & 31)) < N;
    float tv[32];
#pragma unroll
    for (int i = 0; i < 32; ++i) { const int kk = 2 * i + (lane >> 5); tv[i] = nok ? W[(size_t)(k0 + kk) * N + n0 + (lane & 31)] : 0.f; }
#pragma unroll
    for (int i = 0; i < 32; ++i) { const int kk = 2 * i + (lane >> 5); scr[kk * 33 + (lane & 31)] = tv[i]; }
    LDS_WAIT(); asm volatile("" ::: "memory");
    const int c = lane & 7;
#pragma unroll
    for (int j = 0; j < 4; ++j) { const int n = (lane >> 3) + 8 * j; const LAS float* s = scr + (8 * c) * 33 + n;
        u32x4 o; o.x = pk2(s[0 * 33], s[1 * 33]); o.y = pk2(s[2 * 33], s[3 * 33]); o.z = pk2(s[4 * 33], s[5 * 33]); o.w = pk2(s[6 * 33], s[7 * 33]);
        if (n0 + n < N) *(u32x4*)(WT + (size_t)dest_row<MODE>(n0 + n, row_off) * K + k0 + 8 * c) = o; }
    LDS_WAIT(); asm volatile("" ::: "memory");
}
__device__ __forceinline__ void rms_row_to_bf16(int lane, const float* xrow, const float* g, bf16_t* orow) {
    const f32x4* xr = (const f32x4*)xrow + lane; const f32x4* gr = (const f32x4*)g + lane;
    f32x4 v[16]; float s = 0.f;
#pragma unroll
    for (int j = 0; j < 16; ++j) { v[j] = xr[64 * j]; s += (v[j].x * v[j].x + v[j].y * v[j].y) + (v[j].z * v[j].z + v[j].w * v[j].w); }
    const float rstd = 1.0f / sqrtf(wave_sum(s) * (1.f / D) + RMS_EPS);
    u32x2* o8 = (u32x2*)orow + lane;
#pragma unroll
    for (int j = 0; j < 16; ++j) { const f32x4 gg = gr[64 * j]; u32x2 w; w.x = pk2(v[j].x * rstd * gg.x, v[j].y * rstd * gg.y); w.y = pk2(v[j].z * rstd * gg.z, v[j].w * rstd * gg.w); o8[64 * j] = w; }
}

__device__ __forceinline__ void p0_prologue(Frame& F) {
    LAS float* scr = (LAS float*)(F.lds + F.wave * 16384);
    const int gw = F.bid * NWAVES + F.wave, NGW = F.G * NWAVES;
    bf16_t* WIN = (bf16_t*)(F.ws + WS_WIN); bf16_t* WOUT = (bf16_t*)(F.ws + WS_WOUT); bf16_t* WGU = (bf16_t*)(F.ws + WS_WGU); bf16_t* WD = (bf16_t*)(F.ws + WS_WD);
    constexpr int I_IN = 64 * 273, I_OUT = 64 * 128, I_G = 64 * 16, I_DN = 8 * 128;
    for (int it = gw; it < I_IN; it += NGW) transpose_item<1>(F.w_in, D, IN_COLS, WIN, 0, scr, it, F.lane);
    for (int it = gw; it < I_OUT; it += NGW) transpose_item<0>(F.w_out, D, D, WOUT, 0, scr, it, F.lane);

    { u32x4* z = (u32x4*)(WIN + (size_t)IN_COLS * D); const size_t n16 = (size_t)(LDP - IN_COLS) * D * 2 / 16;
      for (size_t i = (size_t)F.bid * NTHREADS + F.tid; i < n16; i += (size_t)F.G * NTHREADS) z[i] = (u32x4){0u, 0u, 0u, 0u}; }
    { bf16_t* RBH = (bf16_t*)(F.ws + WS_RB); bf16_t* RBL = RBH + 80 * D;
      for (int i = F.bid * NTHREADS + F.tid; i < 80 * D; i += F.G * NTHREADS) { const int c = i / D, k = i % D;
          float v = 0.f; if (c < 8) v = F.rg_w[k * 8 + c]; else if (c < 72) { const int g = (c - 8) >> 3, j = (c - 8) & 7; v = F.re_w[((size_t)g * D + k) * 8 + j]; }
          const unsigned h = f2bf(v); const float hf = __builtin_bit_cast(float, h << 16); RBH[i] = (bf16_t)h; RBL[i] = (bf16_t)f2bf(v - hf); } }
    { float* RC = (float*)(F.ws + WS_ROPE); float* RS = RC + M * 32;
      for (int i = F.bid * NTHREADS + F.tid; i < M * 32; i += F.G * NTHREADS) { const int m = i >> 5, j = i & 31;
          const float inv = exp2f(-(float)j * (13.287712379549449f / 32.0f));
          const float angf = (float)F.pos[m] * inv;
          const double a = (double)angf; const double tr = a * 0.15915494309189535; const double fr = tr - __builtin_rint(tr);
          const float r = (float)(fr * 6.283185307179586);
          RC[i] = cosf(r); RS[i] = sinf(r); } }
    { bf16_t* U = (bf16_t*)(F.ws + WS_U);
      for (int m = gw; m < M; m += NGW) rms_row_to_bf16(F.lane, F.x + (size_t)m * D, F.g_mix, U + (size_t)m * D); }
}

__device__ __forceinline__ int crow(int r, int hi) { return (r & 3) + 8 * (r >> 2) + 4 * hi; }
constexpr int SWA_KROW = 144;
__device__ __forceinline__ void rot8(const u32x4 x1, const u32x4 x2, const f32x4 c0, const f32x4 c1, const f32x4 s0, const f32x4 s1, float sc, u32x4& o1, u32x4& o2) {
    const unsigned a[4] = {x1.x, x1.y, x1.z, x1.w}, b[4] = {x2.x, x2.y, x2.z, x2.w};
    const float c[8] = {c0.x, c0.y, c0.z, c0.w, c1.x, c1.y, c1.z, c1.w}, s[8] = {s0.x, s0.y, s0.z, s0.w, s1.x, s1.y, s1.z, s1.w};
    unsigned r1[4], r2[4];
#pragma unroll
    for (int j = 0; j < 4; ++j) { const float a0 = bflo(a[j]), a1 = bfhi(a[j]), b0 = bflo(b[j]), b1 = bfhi(b[j]);
        r1[j] = cvtpk((a0 * c[2 * j] - b0 * s[2 * j]) * sc, (a1 * c[2 * j + 1] - b1 * s[2 * j + 1]) * sc);
        r2[j] = cvtpk((b0 * c[2 * j] + a0 * s[2 * j]) * sc, (b1 * c[2 * j + 1] + a1 * s[2 * j + 1]) * sc); }
    o1 = (u32x4){r1[0], r1[1], r1[2], r1[3]}; o2 = (u32x4){r2[0], r2[1], r2[2], r2[3]};
}
__device__ __forceinline__ void swa_unit(Frame& F, int b, int kvh, int qb) {
    const bf16_t* PROJ = (const bf16_t*)(F.ws + WS_PROJ); bf16_t* MIX = (bf16_t*)(F.ws + WS_MIX);
    const float* RC = (const float*)(F.ws + WS_ROPE); const float* RS = RC + M * 32;
    LAS unsigned char* Kl = F.lds; LAS unsigned char* Vl = F.lds + 192 * SWA_KROW;
    LAS float* wsf = (LAS float*)(F.lds + 2 * 192 * SWA_KROW) + F.wave * 64;
    LAS bf16_t* stg = (LAS bf16_t*)(F.lds + 2 * 192 * SWA_KROW + 2048) + F.wave * 2048;
    const int tid = F.tid, lane = F.lane, r32 = lane & 31, hi = lane >> 5;
    const int K0 = 64 * (qb - 2);
    const size_t rowb = (size_t)b * SEQ;
    for (int task = tid; task < 768; task += NTHREADS) { const int key = task >> 2, c = task & 3, kg = K0 + key;
        u32x4 o1 = (u32x4){0u, 0u, 0u, 0u}, o2 = o1;
        if (kg >= 0) { const bf16_t* src = PROJ + (rowb + kg) * LDP + C_SK + kvh * 64; const u32x4 x1 = *(const u32x4*)(src + 8 * c), x2 = *(const u32x4*)(src + 32 + 8 * c);
            const float* cs = RC + (rowb + kg) * 32 + 8 * c; const float* sn = RS + (rowb + kg) * 32 + 8 * c;
            rot8(x1, x2, *(const f32x4*)cs, *(const f32x4*)(cs + 4), *(const f32x4*)sn, *(const f32x4*)(sn + 4), 1.0f, o1, o2); }
        *(LAS u32x4*)(Kl + key * SWA_KROW + 16 * c) = o1; *(LAS u32x4*)(Kl + key * SWA_KROW + 64 + 16 * c) = o2; }
    for (int task = tid; task < 1536; task += NTHREADS) { const int key = task >> 3, c = task & 7, kg = K0 + key;
        u32x4 v = (u32x4){0u, 0u, 0u, 0u};
        if (kg >= 0) v = *(const u32x4*)(PROJ + (rowb + kg) * LDP + C_SV + kvh * 64 + 8 * c);
        *(LAS u32x4*)(Vl + key * SWA_KROW + 16 * c) = v; }
    __syncthreads();
    const int qh = kvh * 8 + F.wave;
    const float sink2 = F.sinks[qh] * 1.4426950408889634f;
#pragma unroll 1
    for (int sub = 0; sub < 2; ++sub) {
        const int qg = 64 * qb + 32 * sub + r32;
        bf16x8 qr[4];
        { const bf16_t* qsrc = PROJ + (rowb + qg) * LDP + C_SQ + qh * 64 + 8 * hi;
          const u32x4 x0 = *(const u32x4*)(qsrc), x1 = *(const u32x4*)(qsrc + 16), x2 = *(const u32x4*)(qsrc + 32), x3 = *(const u32x4*)(qsrc + 48);
          const float* cs = RC + (rowb + qg) * 32 + 8 * hi; const float* sn = RS + (rowb + qg) * 32 + 8 * hi;
          u32x4 o0, o1, o2, o3; const float sc = 0.125f * 1.4426950408889634f;
          rot8(x0, x2, *(const f32x4*)cs, *(const f32x4*)(cs + 4), *(const f32x4*)sn, *(const f32x4*)(sn + 4), sc, o0, o2);
          rot8(x1, x3, *(const f32x4*)(cs + 16), *(const f32x4*)(cs + 20), *(const f32x4*)(sn + 16), *(const f32x4*)(sn + 20), sc, o1, o3);
          qr[0] = __builtin_bit_cast(bf16x8, o0); qr[1] = __builtin_bit_cast(bf16x8, o1); qr[2] = __builtin_bit_cast(bf16x8, o2); qr[3] = __builtin_bit_cast(bf16x8, o3); }
        f32x16 p[5];
#pragma unroll
        for (int j = 0; j < 5; ++j) {
#pragma unroll
            for (int r = 0; r < 16; ++r) p[j][r] = 0.f;
#pragma unroll
            for (int d0 = 0; d0 < 4; ++d0) { const bf16x8 kf = *(const LAS bf16x8*)(Kl + (32 * sub + 32 * j + r32) * SWA_KROW + (16 * d0 + 8 * hi) * 2);
                p[j] = __builtin_amdgcn_mfma_f32_32x32x16_bf16(kf, qr[d0], p[j], 0, 0, 0); } }
        const int kneg = -(K0 + 32 * sub);
        const float NEG = -INFINITY;
#pragma unroll
        for (int j = 0; j < 5; ++j)
#pragma unroll
            for (int r = 0; r < 16; ++r) { const int c = crow(r, hi); bool ok = (32 * j >= kneg);
                if (j == 0) ok = ok && (c > r32); if (j == 4) ok = ok && (c <= r32);
                p[j][r] = ok ? p[j][r] : NEG; }
        float mx = sink2;
#pragma unroll
        for (int j = 0; j < 5; ++j)
#pragma unroll
            for (int r = 0; r < 16; ++r) mx = fmaxf(mx, p[j][r]);
        mx = fmaxf(mx, __shfl_xor(mx, 32));
        float sum = 0.f;
#pragma unroll
        for (int j = 0; j < 5; ++j)
#pragma unroll
            for (int r = 0; r < 16; ++r) { p[j][r] = __builtin_amdgcn_exp2f(p[j][r] - mx); sum += p[j][r]; }
        sum += __shfl_xor(sum, 32);
        sum += __builtin_amdgcn_exp2f(sink2 - mx);
        f32x16 o[2];
#pragma unroll
        for (int r = 0; r < 16; ++r) { o[0][r] = 0.f; o[1][r] = 0.f; }
        const int vrow0 = 32 * sub + 4 * hi + ((lane & 15) >> 2), vcol = ((lane >> 4) & 1) * 32 + (lane & 3) * 8;
#pragma unroll
        for (int j = 0; j < 5; ++j)
#pragma unroll
            for (int s = 0; s < 2; ++s) {
                u32x4 pw; pw.x = cvtpk(p[j][8 * s], p[j][8 * s + 1]); pw.y = cvtpk(p[j][8 * s + 2], p[j][8 * s + 3]); pw.z = cvtpk(p[j][8 * s + 4], p[j][8 * s + 5]); pw.w = cvtpk(p[j][8 * s + 6], p[j][8 * s + 7]);
                const bf16x8 pa = __builtin_bit_cast(bf16x8, pw);
#pragma unroll
                for (int d0 = 0; d0 < 2; ++d0) { const LAS unsigned char* vp = Vl + (vrow0 + 32 * j + 16 * s) * SWA_KROW + d0 * 64 + vcol;
                    const s16x4 lo = __builtin_bit_cast(s16x4, __builtin_amdgcn_ds_read_tr16_b64_v4i16((LAS s16x4*)vp));
                    const s16x4 hh = __builtin_bit_cast(s16x4, __builtin_amdgcn_ds_read_tr16_b64_v4i16((LAS s16x4*)(vp + 8 * SWA_KROW)));
                    const bf16x8 vf = (bf16x8){lo[0], lo[1], lo[2], lo[3], hh[0], hh[1], hh[2], hh[3]};
                    o[d0] = __builtin_amdgcn_mfma_f32_32x32x16_bf16(pa, vf, o[d0], 0, 0, 0); } }
        if (hi == 0) wsf[r32] = 1.0f / sum;
        LDS_WAIT();
#pragma unroll
        for (int r = 0; r < 16; ++r) { const int orow = crow(r, hi); const float rl = wsf[orow];
#pragma unroll
            for (int d0 = 0; d0 < 2; ++d0) stg[orow * 64 + d0 * 32 + r32] = (bf16_t)f2bf(o[d0][r] * rl); }
        LDS_WAIT();
#pragma unroll
        for (int i = 0; i < 4; ++i) { const int row = i * 8 + (lane >> 3), ch = lane & 7; const u32x4 v = *(const LAS u32x4*)(stg + row * 64 + ch * 8);
            *(u32x4*)(MIX + (rowb + 64 * qb + 32 * sub + row) * D + 2048 + qh * 64 + ch * 8) = v; }
        LDS_WAIT();
    }
    __syncthreads();
}

constexpr int GP_ROW = 136;
__device__ __forceinline__ void gla_prep_unit(Frame& F, int unit) {
    const int bh = unit >> 7, n = unit & 127, b = bh >> 3, h = bh & 7, tid = F.tid, lane = F.lane;
    const bf16_t* PROJ = (const bf16_t*)(F.ws + WS_PROJ);
    bf16_t* QIN = (bf16_t*)(F.ws + WS_QIN) + (size_t)unit * 64 * 128; bf16_t* KDT = (bf16_t*)(F.ws + WS_KDT) + (size_t)unit * 128 * 64;
    bf16_t* AM = (bf16_t*)(F.ws + WS_AM) + (size_t)unit * 64 * 64; float* DEC = (float*)(F.ws + WS_DEC) + (size_t)unit * 128;
    LAS float* gaS = (LAS float*)F.lds; LAS float* tot = gaS + 1024; LAS bf16_t* qinS = (LAS bf16_t*)(F.lds + 8192); LAS bf16_t* kinS = qinS + 64 * GP_ROW;
    const size_t m0 = (size_t)b * SEQ + 64 * n;
    const int d = tid & 127, cg = tid >> 7;
    bf16_t qv[16], kv[16];
#pragma unroll
    for (int i = 0; i < 16; ++i) { const bf16_t* pr = PROJ + (m0 + cg * 16 + i) * LDP + h * 128 + d; qv[i] = pr[C_GQ]; kv[i] = pr[C_GK]; }
    { const int c = tid >> 3, r2 = (tid & 7) * 2; const unsigned w = *(const unsigned*)(PROJ + (m0 + c) * LDP + C_GA + r2); gaS[c * 16 + r2] = bflo(w); gaS[c * 16 + r2 + 1] = bfhi(w); }
    float w2r[16];
#pragma unroll
    for (int r = 0; r < 16; ++r) w2r[r] = F.w2[r * 1024 + h * 128 + d];
    const float bias = F.gb[h * 128 + d];
    __syncthreads();
    float bl[16]; float run = 0.f;
#pragma unroll
    for (int i = 0; i < 16; ++i) { const int c = cg * 16 + i; float z = bias;
#pragma unroll
        for (int r4 = 0; r4 < 4; ++r4) { const f32x4 g4 = *(const LAS f32x4*)(gaS + c * 16 + 4 * r4); z += g4.x * w2r[4 * r4] + g4.y * w2r[4 * r4 + 1] + g4.z * w2r[4 * r4 + 2] + g4.w * w2r[4 * r4 + 3]; }
        const float ls = fminf(z, 0.f) - __logf(1.0f + __expf(-fabsf(z)));
        run += ls * (1.f / 16.f); bl[i] = run; }
    tot[cg * 128 + d] = run;
    __syncthreads();
    float offs = 0.f, blast = 0.f;
#pragma unroll
    for (int g = 0; g < 4; ++g) { const float t = tot[g * 128 + d]; blast += t; if (g < cg) offs += t; }
    const float eblast = __expf(blast);
    unsigned kd[8];
#pragma unroll
    for (int i = 0; i < 16; i += 2) { float kdv[2];
#pragma unroll
        for (int u = 0; u < 2; ++u) { const int c = cg * 16 + i + u; const float bb = bl[i + u] + offs;
            const float q = bf2f(qv[i + u]) * 0.08838834764831845f, k = bf2f(kv[i + u]);
            const float eb = __expf(bb), einv = __builtin_amdgcn_rcpf(eb);
            const float qin = q * eb, kin = k * einv; kdv[u] = kin * eblast;
            const bf16_t qb16 = (bf16_t)f2bf(qin); qinS[c * GP_ROW + d] = qb16; kinS[c * GP_ROW + d] = (bf16_t)f2bf(kin); QIN[c * 128 + d] = qb16; }
        kd[i >> 1] = pk2(kdv[0], kdv[1]); }
    *(u32x4*)(KDT + d * 64 + cg * 16) = (u32x4){kd[0], kd[1], kd[2], kd[3]}; *(u32x4*)(KDT + d * 64 + cg * 16 + 8) = (u32x4){kd[4], kd[5], kd[6], kd[7]};
    if (cg == 0) DEC[d] = eblast;
    __syncthreads();
    { const int mi = F.wave >> 1, fr = lane & 15, fq = lane >> 4;
#pragma unroll
      for (int t = 0; t < 2; ++t) { const int ni = 2 * (F.wave & 1) + t; f32x4 acc = (f32x4){0.f, 0.f, 0.f, 0.f};
          if (ni <= mi) {
#pragma unroll
              for (int ks = 0; ks < 4; ++ks) { const bf16x8 kf = *(const LAS bf16x8*)(kinS + (16 * ni + fr) * GP_ROW + 32 * ks + 8 * fq), qf = *(const LAS bf16x8*)(qinS + (16 * mi + fr) * GP_ROW + 32 * ks + 8 * fq);
                  acc = __builtin_amdgcn_mfma_f32_16x16x32_bf16(kf, qf, acc, 0, 0, 0); } }
          const int c = 16 * mi + fr, j0 = 16 * ni + 4 * fq; float v[4];
#pragma unroll
          for (int i = 0; i < 4; ++i) v[i] = (j0 + i <= c) ? acc[i] : 0.f;
          u32x2 w; w.x = pk2(v[0], v[1]); w.y = pk2(v[2], v[3]); *(u32x2*)(AM + c * 64 + j0) = w; } }
    __syncthreads();
}

constexpr int GS_AM = 0, GS_QIN = 8192, GS_KDT = 24576, GS_V = 40960, GS_DEC = 43008, GS_SLOT = 44032;
constexpr int GS_SB = 3 * GS_SLOT, GS_SBROW = 272, GS_SBBUF = 16 * GS_SBROW;
__device__ __forceinline__ void gs_load(Frame& F, int bh, int et, int n, int slot) {
    const int lane = F.lane, unit = bh * 128 + n, b = bh >> 3, h = bh & 7, wave = F.wave;
    LAS unsigned char* base = F.lds + slot * GS_SLOT;
    if (wave >= 1 && wave <= 4) { const int m = wave - 1;
        const char* am = (const char*)(F.ws + WS_AM) + (size_t)unit * 8192; const char* qin = (const char*)(F.ws + WS_QIN) + (size_t)unit * 16384;
#pragma unroll
        for (int i = 0; i < 2; ++i) { const int r = 16 * m + i * 8 + (lane >> 3), ch = (lane & 7) ^ (r & 7);
            __builtin_amdgcn_global_load_lds((const unsigned*)(am + r * 128 + ch * 16), (LAS unsigned*)(base + GS_AM + (2 * m + i) * 1024), 16, 0, 0); }
#pragma unroll
        for (int i = 0; i < 4; ++i) { const int r = 16 * m + i * 4 + (lane >> 4), ch = (lane & 15) ^ (r & 15);
            __builtin_amdgcn_global_load_lds((const unsigned*)(qin + r * 256 + ch * 16), (LAS unsigned*)(base + GS_QIN + (4 * m + i) * 1024), 16, 0, 0); }
    } else if (wave == 5 || wave == 6) { const char* kdt = (const char*)(F.ws + WS_KDT) + (size_t)unit * 16384; const int i0 = (wave - 5) * 8;
#pragma unroll
        for (int i = 0; i < 8; ++i) { const int r = (i0 + i) * 8 + (lane >> 3), ch = (lane & 7) ^ (r & 7);
            __builtin_amdgcn_global_load_lds((const unsigned*)(kdt + r * 128 + ch * 16), (LAS unsigned*)(base + GS_KDT + (i0 + i) * 1024), 16, 0, 0); }
    } else if (wave == 7) { const char* dec = (const char*)(F.ws + WS_DEC) + (size_t)unit * 512;
        const char* v = (const char*)((const bf16_t*)(F.ws + WS_PROJ) + ((size_t)b * SEQ + 64 * n) * LDP + C_GV + h * 256 + et * 16);
#pragma unroll
        for (int i = 0; i < 2; ++i) { const int r = i * 32 + (lane >> 1);
            __builtin_amdgcn_global_load_lds((const unsigned*)(v + (size_t)r * LDP * 2 + (lane & 1) * 16), (LAS unsigned*)(base + GS_V + i * 1024), 16, 0, 0); }
        __builtin_amdgcn_global_load_lds((const unsigned*)(dec + (lane & 31) * 16), (LAS unsigned*)(base + GS_DEC), 16, 0, 0);
    }
}
__device__ __forceinline__ void gs_vfrag(const LAS unsigned char* vbase, int lane, bf16x8 (&vf)[2]) {
    const unsigned a = (unsigned)(uintptr_t)(vbase + (8 * (lane >> 4) + ((lane & 15) >> 2)) * 32 + (lane & 3) * 8);
    s16x4 r0, r1, r2, r3;
    asm volatile("ds_read_b64_tr_b16 %0, %4\n\tds_read_b64_tr_b16 %1, %4 offset:128\n\tds_read_b64_tr_b16 %2, %4 offset:1024\n\tds_read_b64_tr_b16 %3, %4 offset:1152\n\ts_waitcnt lgkmcnt(0)"
                 : "=&v"(r0), "=&v"(r1), "=&v"(r2), "=&v"(r3) : "v"(a) : "memory");
    vf[0] = (bf16x8){r0[0], r0[1], r0[2], r0[3], r1[0], r1[1], r1[2], r1[3]}; vf[1] = (bf16x8){r2[0], r2[1], r2[2], r2[3], r3[0], r3[1], r3[2], r3[3]};
}
__device__ __forceinline__ void gs_wait_older(int wave, bool first) {
    if (wave >= 1 && wave <= 4) { if (first) asm volatile("s_waitcnt vmcnt(6)" ::: "memory"); else asm volatile("s_waitcnt vmcnt(14)" ::: "memory"); }
    else if (wave == 5 || wave == 6) asm volatile("s_waitcnt vmcnt(8)" ::: "memory");
    else if (wave == 7) asm volatile("s_waitcnt vmcnt(3)" ::: "memory");
}
__device__ __forceinline__ void gla_scan_chain(Frame& F, int chain) {
    const int bh = chain >> 4, et = chain & 15, b = bh >> 3, h = bh & 7, lane = F.lane, fr = lane & 15, fq = lane >> 4, wave = F.wave;
    bf16_t* ORAW = (bf16_t*)(F.ws + WS_ORAW);
    f32x4 S[8];
#pragma unroll
    for (int i = 0; i < 8; ++i) S[i] = (f32x4){0.f, 0.f, 0.f, 0.f};
    if (wave >= 1) { gs_load(F, bh, et, 0, 0); gs_load(F, bh, et, 1, 1); gs_wait_older(wave, true); }
    if (wave == 0) { for (int i = lane; i < GS_SBBUF / 16; i += 64) *(LAS u32x4*)(F.lds + GS_SB + i * 16) = (u32x4){0u, 0u, 0u, 0u}; }
    asm volatile("s_waitcnt lgkmcnt(0)" ::: "memory"); __builtin_amdgcn_s_barrier(); asm volatile("" ::: "memory");
#pragma unroll 1
    for (int n = 0; n < 128; ++n) {
        const LAS unsigned char* base = F.lds + (n % 3) * GS_SLOT;
        if (wave >= 1 && n + 2 < 128) gs_load(F, bh, et, n + 2, (n + 2) % 3);
        if (wave == 0) {
            bf16x8 vf[2]; gs_vfrag(base + GS_V, lane, vf);
            bf16x8 kf[8][2]; f32x4 dc[8];
#pragma unroll
            for (int mt = 0; mt < 8; ++mt) { const int r = 16 * mt + fr; dc[mt] = *(const LAS f32x4*)(base + GS_DEC + (16 * mt + 4 * fq) * 4);
#pragma unroll
                for (int ks = 0; ks < 2; ++ks) kf[mt][ks] = *(const LAS bf16x8*)(base + GS_KDT + r * 128 + (((4 * ks + fq) ^ (r & 7)) * 16)); }
            __builtin_amdgcn_sched_barrier(0);
            LAS unsigned char* sb = F.lds + GS_SB + ((n + 1) & 1) * GS_SBBUF + fr * GS_SBROW + 8 * fq;
#pragma unroll
            for (int mt = 0; mt < 8; ++mt) { f32x4 s = S[mt] * dc[mt];
                s = __builtin_amdgcn_mfma_f32_16x16x32_bf16(kf[mt][0], vf[0], s, 0, 0, 0); s = __builtin_amdgcn_mfma_f32_16x16x32_bf16(kf[mt][1], vf[1], s, 0, 0, 0); S[mt] = s; }
#pragma unroll
            for (int mt = 0; mt < 8; ++mt) { u32x2 w; w.x = cvtpk(S[mt][0], S[mt][1]); w.y = cvtpk(S[mt][2], S[mt][3]); *(LAS u32x2*)(sb + 32 * mt) = w; }
        } else if (wave <= 4) {
            const int m = wave - 1, r = 16 * m + fr;
            bf16x8 vf[2]; gs_vfrag(base + GS_V, lane, vf);
            const LAS unsigned char* sb = F.lds + GS_SB + (n & 1) * GS_SBBUF + fr * GS_SBROW + 16 * fq;
            bf16x8 af[2], qf[4], sf[4];
#pragma unroll
            for (int ks = 0; ks < 2; ++ks) af[ks] = *(const LAS bf16x8*)(base + GS_AM + r * 128 + (((4 * ks + fq) ^ (r & 7)) * 16));
#pragma unroll
            for (int ks = 0; ks < 4; ++ks) { qf[ks] = *(const LAS bf16x8*)(base + GS_QIN + r * 256 + (((4 * ks + fq) ^ (r & 15)) * 16)); sf[ks] = *(const LAS bf16x8*)(sb + 64 * ks); }
            __builtin_amdgcn_sched_barrier(0);
            f32x4 acc = (f32x4){0.f, 0.f, 0.f, 0.f};
#pragma unroll
            for (int ks = 0; ks < 2; ++ks) acc = __builtin_amdgcn_mfma_f32_16x16x32_bf16(af[ks], vf[ks], acc, 0, 0, 0);
#pragma unroll
            for (int ks = 0; ks < 4; ++ks) acc = __builtin_amdgcn_mfma_f32_16x16x32_bf16(qf[ks], sf[ks], acc, 0, 0, 0);
            bf16_t* op = ORAW + ((size_t)b * SEQ + 64 * n + 16 * m + 4 * fq) * 2048 + h * 256 + et * 16 + fr;
#pragma unroll
            for (int i = 0; i < 4; ++i) op[(size_t)i * 2048] = (bf16_t)f2bf(acc[i]);
        }
        if (wave >= 1) { if (n + 2 < 128) gs_wait_older(wave, false); else asm volatile("s_waitcnt vmcnt(0)" ::: "memory"); }
        asm volatile("s_waitcnt lgkmcnt(0)" ::: "memory"); __builtin_amdgcn_s_barrier(); asm volatile("" ::: "memory");
    }
    asm volatile("s_waitcnt vmcnt(0) lgkmcnt(0)" ::: "memory");
}
__device__ __forceinline__ void gla_norm(Frame& F) {
    const bf16_t* PROJ = (const bf16_t*)(F.ws + WS_PROJ); const bf16_t* ORAW = (const bf16_t*)(F.ws + WS_ORAW); bf16_t* MIX = (bf16_t*)(F.ws + WS_MIX);
    const int gw = F.bid * NWAVES + F.wave, NGW = F.G * NWAVES, lane = F.lane;
    const int col = 8 * (lane & 31);
    const f32x4 gn0 = *(const f32x4*)(F.g_gla + col), gn1 = *(const f32x4*)(F.g_gla + col + 4);
    const float gn[8] = {gn0.x, gn0.y, gn0.z, gn0.w, gn1.x, gn1.y, gn1.z, gn1.w};
    for (int m = gw; m < M; m += NGW) {
        u32x4 ow[4], gw4[4];
#pragma unroll
        for (int j = 0; j < 4; ++j) { const int hc = (2 * j + (lane >> 5)) * 256 + col; ow[j] = *(const u32x4*)(ORAW + (size_t)m * 2048 + hc); gw4[j] = *(const u32x4*)(PROJ + (size_t)m * LDP + C_GR + hc); }
#pragma unroll
        for (int j = 0; j < 4; ++j) { const unsigned a[4] = {ow[j].x, ow[j].y, ow[j].z, ow[j].w}, g[4] = {gw4[j].x, gw4[j].y, gw4[j].z, gw4[j].w};
            float o[8], ss = 0.f;
#pragma unroll
            for (int i = 0; i < 4; ++i) { o[2 * i] = bflo(a[i]); o[2 * i + 1] = bfhi(a[i]); ss += o[2 * i] * o[2 * i] + o[2 * i + 1] * o[2 * i + 1]; }
#pragma unroll
            for (int s = 1; s < 32; s <<= 1) ss += __shfl_xor(ss, s);
            const float rstd = 1.0f / sqrtf(ss * (1.f / 256.f) + RMS_EPS);
            unsigned w[4];
#pragma unroll
            for (int i = 0; i < 4; ++i) { const float g0 = bflo(g[i]), g1 = bfhi(g[i]);
                w[i] = pk2(o[2 * i] * rstd * gn[2 * i] * (g0 / (1.f + __expf(-g0))), o[2 * i + 1] * rstd * gn[2 * i + 1] * (g1 / (1.f + __expf(-g1)))); }
            *(u32x4*)(MIX + (size_t)m * D + (2 * j + (lane >> 5)) * 256 + col) = (u32x4){w[0], w[1], w[2], w[3]}; }
    }
}

struct RtLoad { u32x4 x[2]; f32x4 g[2]; };
struct RtW { bf16x8 wh[5], wl[5]; };
__device__ __forceinline__ void rt_load(RtLoad& L, const bf16_t* h0, const bf16_t* h1, const float* gp, int ko) {
    L.x[0] = *(const u32x4*)(h0 + ko); L.x[1] = *(const u32x4*)(h1 + ko);
    L.g[0] = *(const f32x4*)(gp + ko); L.g[1] = *(const f32x4*)(gp + ko + 4);
}
__device__ __forceinline__ void rt_step(const RtLoad& L, const bf16_t* bh, const bf16_t* bl, f32x4 (&acc)[2][5], float (&ss)[2], int ko) {
    RtW W;
#pragma unroll
    for (int n = 0; n < 5; ++n) { W.wh[n] = *(const bf16x8*)(bh + (size_t)n * 16 * D + ko); W.wl[n] = *(const bf16x8*)(bl + (size_t)n * 16 * D + ko); }
    bf16x8 ahi[2], alo[2];
#pragma unroll
    for (int mi = 0; mi < 2; ++mi) { const u32x4 xw = L.x[mi]; const f32x4 xa = (f32x4){bflo(xw.x), bfhi(xw.x), bflo(xw.y), bfhi(xw.y)}, xb = (f32x4){bflo(xw.z), bfhi(xw.z), bflo(xw.w), bfhi(xw.w)};
        ss[mi] += (xa.x * xa.x + xa.y * xa.y) + (xa.z * xa.z + xa.w * xa.w) + (xb.x * xb.x + xb.y * xb.y) + (xb.z * xb.z + xb.w * xb.w);
        const float u[8] = {xa.x * L.g[0].x, xa.y * L.g[0].y, xa.z * L.g[0].z, xa.w * L.g[0].w, xb.x * L.g[1].x, xb.y * L.g[1].y, xb.z * L.g[1].z, xb.w * L.g[1].w};
        unsigned hb[8]; float lo[8];
#pragma unroll
        for (int j = 0; j < 8; ++j) { hb[j] = f2bf(u[j]); lo[j] = u[j] - __builtin_bit_cast(float, hb[j] << 16); }
        const u32x4 hw = (u32x4){hb[0] | (hb[1] << 16), hb[2] | (hb[3] << 16), hb[4] | (hb[5] << 16), hb[6] | (hb[7] << 16)};
        const u32x4 lw = (u32x4){pk2(lo[0], lo[1]), pk2(lo[2], lo[3]), pk2(lo[4], lo[5]), pk2(lo[6], lo[7])};
        ahi[mi] = __builtin_bit_cast(bf16x8, hw); alo[mi] = __builtin_bit_cast(bf16x8, lw); }
#pragma unroll
    for (int n = 0; n < 5; ++n)
#pragma unroll
        for (int mi = 0; mi < 2; ++mi) { acc[mi][n] = __builtin_amdgcn_mfma_f32_16x16x32_bf16(ahi[mi], W.wh[n], acc[mi][n], 0, 0, 0);
            acc[mi][n] = __builtin_amdgcn_mfma_f32_16x16x32_bf16(alo[mi], W.wh[n], acc[mi][n], 0, 0, 0);
            acc[mi][n] = __builtin_amdgcn_mfma_f32_16x16x32_bf16(ahi[mi], W.wl[n], acc[mi][n], 0, 0, 0); }
}
__device__ __forceinline__ void p5_router(Frame& F) {
    const bf16_t* H = (const bf16_t*)(F.ws + WS_HB);
    const bf16_t* RBH = (const bf16_t*)(F.ws + WS_RB); const bf16_t* RBL = RBH + 80 * D;
    unsigned* ctl = (unsigned*)(F.ws + WS_CTL);
    LAS float* part = (LAS float*)F.lds;
    LAS float* lg = part + 4 * 64 * 80;
    LAS float* ssp = lg + 64 * 80;
    LAS float* rs = ssp + 256;
    const int lane = F.lane, wave = F.wave;
    for (int tile = F.bid; tile < M / 64; tile += F.G) {
        const int m0 = tile * 64;
        { const int tg = wave & 1, kq = wave >> 1, fr = lane & 15, fq = lane >> 4;
          f32x4 acc[2][5];
#pragma unroll
          for (int a = 0; a < 2; ++a)
#pragma unroll
              for (int n = 0; n < 5; ++n) acc[a][n] = (f32x4){0.f, 0.f, 0.f, 0.f};
          float ss[2] = {0.f, 0.f};
          const size_t roff = (size_t)(m0 + 32 * tg + fr) * D + kq * 1024 + 8 * fq;
          const bf16_t* h0 = H + roff; const bf16_t* h1 = h0 + (size_t)16 * D;
          const float* gp = F.g_ffn + kq * 1024 + 8 * fq;
          const bf16_t* bh = RBH + (size_t)fr * D + kq * 1024 + 8 * fq; const bf16_t* bl = RBL + (size_t)fr * D + kq * 1024 + 8 * fq;
          RtLoad La, Lb; rt_load(La, h0, h1, gp, 0);
#pragma unroll 1
          for (int ks = 0; ks < 32; ks += 2) {
              rt_load(Lb, h0, h1, gp, (ks + 1) * 32); rt_step(La, bh, bl, acc, ss, ks * 32);
              if (ks + 2 < 32) rt_load(La, h0, h1, gp, (ks + 2) * 32);
              rt_step(Lb, bh, bl, acc, ss, (ks + 1) * 32); }
#pragma unroll
          for (int mi = 0; mi < 2; ++mi) { float s = ss[mi]; s += __shfl_xor(s, 16); s += __shfl_xor(s, 32); if (fq == 0) ssp[kq * 64 + 32 * tg + 16 * mi + fr] = s;
#pragma unroll
              for (int n = 0; n < 5; ++n)
#pragma unroll
                  for (int i = 0; i < 4; ++i) part[(kq * 64 + 32 * tg + 16 * mi + 4 * fq + i) * 80 + 16 * n + fr] = acc[mi][n][i]; } }
        __syncthreads();
        if (F.tid < 64) { const float s = (ssp[F.tid] + ssp[64 + F.tid]) + (ssp[128 + F.tid] + ssp[192 + F.tid]); const float r = 1.0f / sqrtf(s * (1.f / D) + RMS_EPS); rs[F.tid] = r; }
        __syncthreads();
        for (int i = F.tid; i < 64 * 80; i += NTHREADS) lg[i] = ((part[i] + part[5120 + i]) + (part[10240 + i] + part[15360 + i])) * rs[i / 80];
        __syncthreads();
        if (F.tid < 64) { const int tk = F.tid, m = m0 + tk; const LAS float* L = lg + tk * 80;
            float gl[8]; int g = 0; float gm;
#pragma unroll
            for (int c = 0; c < 8; ++c) gl[c] = L[c] + F.rg_b[c];
            gm = gl[0];
#pragma unroll
            for (int c = 1; c < 8; ++c) if (gl[c] > gm) { gm = gl[c]; g = c; }
            float gs = 0.f;
#pragma unroll
            for (int c = 0; c < 8; ++c) gs += expf(gl[c] - gm);
            const float gw = 1.0f / gs;
            float el[8];
#pragma unroll
            for (int j = 0; j < 8; ++j) el[j] = L[8 + g * 8 + j] + F.re_b[g * 8 + j];
            int i0 = 0; float e0 = el[0];
#pragma unroll
            for (int j = 1; j < 8; ++j) if (el[j] > e0) { e0 = el[j]; i0 = j; }
            int i1 = -1; float e1 = -3.0e38f;
#pragma unroll
            for (int j = 0; j < 8; ++j) if (j != i0 && el[j] > e1) { e1 = el[j]; i1 = j; }
            const float tt = expf(e1 - e0); const float w0 = 1.0f / (1.0f + tt), w1 = tt / (1.0f + tt);
            const int x0 = g * 8 + i0, x1 = g * 8 + i1;
            const size_t s0 = (size_t)x0 * CAPS + atomicAdd(ctl + CW_CNT + x0, 1u), s1 = (size_t)x1 * CAPS + atomicAdd(ctl + CW_CNT + x1, 1u); const float rr = rs[tk];
            int* t2tok = (int*)(F.ws + WS_T2 + T2_TOK); float* t2w = (float*)(F.ws + WS_T2 + T2_W); int* t2dst = (int*)(F.ws + WS_T2 + T2_DST); float* t2rs = (float*)(F.ws + WS_T2 + T2_RS);
            t2tok[s0] = m; t2w[s0] = gw * w0; t2dst[s0] = 2 * m; t2rs[s0] = rr; t2tok[s1] = m; t2w[s1] = gw * w1; t2dst[s1] = 2 * m + 1; t2rs[s1] = rr; }
        __syncthreads();
    }
}
__device__ __forceinline__ void p6_tables(Frame& F) {
    unsigned* ctl = (unsigned*)(F.ws + WS_CTL);
    const int* tok_e = (const int*)(F.ws + WS_TAB + T_TOKE); const float* tok_w = (const float*)(F.ws + WS_TAB + T_TOKW); const int* tok_r = (const int*)(F.ws + WS_TAB + T_TOKR);
    int* slot_tok = (int*)(F.ws + WS_TAB + T_SLOTTOK); float* slot_w = (float*)(F.ws + WS_TAB + T_SLOTW); int* slot_dst = (int*)(F.ws + WS_TAB + T_SLOTDST); int* tile_e = (int*)(F.ws + WS_TAB + T_TILEE);
    float* slot_rs = (float*)(F.ws + WS_TAB + T_SLOTRS); const float* RSTD = (const float*)(F.ws + WS_TAB + T_RSTD);
    LAS int* off = (LAS int*)F.lds; LAS int* cnt = off + 80;
    if (F.tid < 64) cnt[F.tid] = (int)ctl[CW_CNT + F.tid];
    __syncthreads();
    if (F.tid == 0) { int a = 0; for (int e = 0; e < 64; ++e) { off[e] = a; a += (cnt[e] + 255) & ~255; } off[64] = a; }
    __syncthreads();
    for (int i = F.bid * NTHREADS + F.tid; i < 2 * M; i += F.G * NTHREADS) { const int e = tok_e[i], s = off[e] + tok_r[i]; slot_tok[s] = i >> 1; slot_w[s] = tok_w[i]; slot_dst[s] = i; slot_rs[s] = RSTD[i >> 1]; }
    for (int e = F.bid; e < 64; e += F.G) for (int s = off[e] + cnt[e] + F.tid; s < off[e + 1]; s += NTHREADS) { slot_tok[s] = 0; slot_w[s] = 0.f; slot_dst[s] = -1; slot_rs[s] = 0.f; }
    if (F.bid == 1 % F.G) { int* eoff = (int*)(F.ws + WS_TAB + T_EOFF); if (F.tid < 65) eoff[F.tid] = off[F.tid];
        if (F.tid < 8) { int* ul = (int*)(F.ws + WS_TAB + T_ULUP) + F.tid * UL_UP; int n = 0;
            for (int e = F.tid; e < 64; e += 8) { const int nrb = (cnt[e] + mu::MR - 1) / mu::MR; for (int rb = 0; rb < nrb; ++rb) for (int cb = 0; cb < 8; ++cb) ul[n++] = (e << 16) | (rb << 8) | cb; }
            ctl[CW_NUP + F.tid] = (unsigned)n; }
        else if (F.tid >= 64 && F.tid < 72) { const int x = F.tid - 64; int* ul = (int*)(F.ws + WS_TAB + T_ULDN) + x * UL_DN; int n = 0;
            for (int e = x; e < 64; e += 8) { const int nrb = (cnt[e] + mu::DR - 1) / mu::DR; for (int rb = 0; rb < nrb; ++rb) for (int cq = 0; cq < 4; ++cq) ul[n++] = (e << 16) | (rb << 8) | cq; }
            ctl[CW_NDN + x] = (unsigned)n; } }
    if (F.bid == 0) { if (F.tid < 64) for (int t = off[F.tid] >> 8; t < (off[F.tid + 1] >> 8); ++t) tile_e[t] = F.tid;
        if (F.tid == 0) ctl[CW_NT] = (unsigned)(off[64] >> 8); }
}
__device__ __forceinline__ void p9_row(float* O, const bf16_t* Hb, const bf16_t* Y, const float* g, int m, int mnext, int lane, u32x2 (&v)[16], u32x2 (&vn)[16]) {
    const u32x2* y0 = (const u32x2*)(Y + (size_t)(2 * m) * D) + lane; const u32x2* y1 = (const u32x2*)(Y + (size_t)(2 * m + 1) * D) + lane;
    u32x2 a[16], b[16];
#pragma unroll
    for (int j = 0; j < 16; ++j) { a[j] = y0[64 * j]; b[j] = y1[64 * j]; }
    if (mnext < M) { const u32x2* xn = (const u32x2*)(Hb + (size_t)mnext * D) + lane;
#pragma unroll
        for (int j = 0; j < 16; ++j) vn[j] = xn[64 * j]; }
    f32x4* xr = (f32x4*)(O + (size_t)m * D) + lane; const f32x4* gr = (const f32x4*)g + lane; float s = 0.f;
    f32x4 t[16];
#pragma unroll
    for (int j = 0; j < 16; ++j) { t[j].x = bflo(v[j].x) + (bflo(a[j].x) + bflo(b[j].x)); t[j].y = bfhi(v[j].x) + (bfhi(a[j].x) + bfhi(b[j].x)); t[j].z = bflo(v[j].y) + (bflo(a[j].y) + bflo(b[j].y)); t[j].w = bfhi(v[j].y) + (bfhi(a[j].y) + bfhi(b[j].y));
        s += (t[j].x * t[j].x + t[j].y * t[j].y) + (t[j].z * t[j].z + t[j].w * t[j].w); }
    const float rstd = 1.0f / sqrtf(wave_sum(s) * (1.f / D) + RMS_EPS);
#pragma unroll
    for (int j = 0; j < 16; ++j) { const f32x4 gg = gr[64 * j]; xr[64 * j] = (f32x4){t[j].x * rstd * gg.x, t[j].y * rstd * gg.y, t[j].z * rstd * gg.z, t[j].w * rstd * gg.w}; }
}
__device__ __forceinline__ void p9_final(Frame& F) {
    const bf16_t* Y = (const bf16_t*)(F.ws + WS_Y); const bf16_t* Hb = (const bf16_t*)(F.ws + WS_HB); float* O = F.out;
    const int gw = F.bid * NWAVES + F.wave, NGW = F.G * NWAVES, lane = F.lane;
    u32x2 va[16], vb[16];
    int m = gw;
    if (m < M) { const u32x2* xr = (const u32x2*)(Hb + (size_t)m * D) + lane;
#pragma unroll
        for (int j = 0; j < 16; ++j) va[j] = xr[64 * j]; }
    while (m < M) {
        p9_row(O, Hb, Y, F.g_fin, m, m + NGW, lane, va, vb); m += NGW; if (m >= M) break;
        p9_row(O, Hb, Y, F.g_fin, m, m + NGW, lane, vb, va); m += NGW;
    }
}

__global__ void __launch_bounds__(NTHREADS, 2) hymba_fwd(Args args) {
    extern __shared__ __attribute__((aligned(16))) unsigned char lds[];
    Frame F;
    F.lds = (LAS unsigned char*)lds;
    F.tid = threadIdx.x; F.lane = F.tid & 63; F.wave = __builtin_amdgcn_readfirstlane(F.tid >> 6);
    F.G = gridDim.x; F.bid = blockIdx.x; F.ws = args.ws; F.out = args.out;
    F.x = (const float*)args.in[0]; F.pos = (const int*)args.in[1]; F.g_mix = (const float*)args.in[2]; F.w_in = (const float*)args.in[3]; F.w2 = (const float*)args.in[4];
    F.gb = (const float*)args.in[5]; F.g_gla = (const float*)args.in[6]; F.sinks = (const float*)args.in[7]; F.w_out = (const float*)args.in[8]; F.g_ffn = (const float*)args.in[9];
    F.rg_w = (const float*)args.in[10]; F.rg_b = (const float*)args.in[11]; F.re_w = (const float*)args.in[12]; F.re_b = (const float*)args.in[13];
    F.wg = (const float*)args.in[14]; F.wu = (const float*)args.in[15]; F.wd = (const float*)args.in[16]; F.g_fin = (const float*)args.in[17];
    volatile LAS unsigned* MISC = (volatile LAS unsigned*)(F.lds + MISC_OFF);
    for (int u = F.tid; u < (LDS_BYTES - LDSCTL_OFF) / 4; u += NTHREADS) ((LAS unsigned*)(F.lds + LDSCTL_OFF))[u] = 0u;
    __syncthreads();
    unsigned* ctl = (unsigned*)(F.ws + WS_CTL);
    XcdBarrier bar; bar.bar = ctl + CW_BAR; bar.x = 0; bar.st = nullptr;
    if (MK_N_LAUNCHES == 1) bar = xcd_barrier_post(ctl + CW_BAR, MISC + 8);
    const int lo = args.ph_lo, hi = args.ph_hi;
#define IN(k) (lo <= (k) && (k) < hi)
#define SEAM(k) do { if (IN(k) && IN((k) + 1)) xcd_barrier(bar); } while (0)
    bf16_t* U = (bf16_t*)(F.ws + WS_U); bf16_t* PROJ = (bf16_t*)(F.ws + WS_PROJ); bf16_t* MIX = (bf16_t*)(F.ws + WS_MIX);

    if (IN(0)) REP(0) { p0_prologue(F); } SEAM(0);
    if (IN(1)) REP(1) {
        pg8::DenseSched S; S.init(U, (const bf16_t*)(F.ws + WS_WIN), M, LDP, D, F.G, F.bid);
        pg8::EpiBf16 E{PROJ, LDP};
        pg8::gemm_phase<pg8::EpiBf16, pg8::DenseSched, true>(F.lds, D, S, E);
    } SEAM(1);
    if (IN(2)) {
        REP(20) for (int u = F.bid; u < 2048; u += F.G) gla_prep_unit(F, u);
        REP(21) for (int u = F.bid; u < 1024; u += F.G) swa_unit(F, u >> 9, (u >> 7) & 3, u & 127);
    } SEAM(2);
    if (IN(3)) REP(3) { for (int c = F.bid; c < 256; c += F.G) { const int cc = (F.G == 256) ? (((c & 7) * 2 + (c >> 7)) << 4) | ((c >> 3) & 15) : c; gla_scan_chain(F, cc); } } SEAM(3);
    if (IN(4)) REP(4) { gla_norm(F); } SEAM(4);
    if (IN(5)) REP(5) {
        pg8::DenseSched S; S.init(MIX, (const bf16_t*)(F.ws + WS_WOUT), M, D, D, F.G, F.bid);
        pg8::EpiResBf16 E{F.x, (bf16_t*)(F.ws + WS_HB), D};
        pg8::gemm_phase<pg8::EpiResBf16, pg8::DenseSched, true>(F.lds, D, S, E);
    } SEAM(5);
    if (IN(6)) { p5_router(F); } SEAM(6);
    LAS int* eo = (LAS int*)(F.lds + MOE_TAB_OFF); LAS int* ecnt = eo + 80;
#define MOE_OFFSETS() do { __syncthreads(); if (F.tid < 64) { const int c_ = (int)ctl[CW_CNT + F.tid]; int s_ = c_; _Pragma("unroll") for (int d_ = 1; d_ < 64; d_ <<= 1) { const int t_ = __shfl_up(s_, d_); if (F.lane >= d_) s_ += t_; } \
        eo[F.tid + 1] = s_; ecnt[F.tid] = c_; if (F.tid == 0) eo[0] = 0; } __syncthreads(); } while (0)
#define MOE_UNIT(idx_, x_, RMAX, CBN, e_, rb_, cb_, ok_) do { int b_ = 0; ok_ = false; for (int k_ = 0; k_ < 8; ++k_) { const int ee_ = (x_) + 8 * k_, n_ = ((ecnt[ee_] + (RMAX) - 1) / (RMAX)) * (CBN); \
        if ((idx_) < b_ + n_) { e_ = ee_; rb_ = ((idx_) - b_) / (CBN); cb_ = ((idx_) - b_) % (CBN); ok_ = true; break; } b_ += n_; } } while (0)
    if (IN(8)) REP(8) {
        __syncthreads(); for (int i = F.tid; i < D / 4; i += NTHREADS) ((LAS f32x4*)(F.lds + mu::GAIN_OFF))[i] = ((const f32x4*)F.g_ffn)[i];
        MOE_OFFSETS();
        const int x = F.bid & 7;
        for (int j = F.bid >> 3; ; j += F.G >> 3) { int e = 0, rb = 0, cb = 0; bool ok; MOE_UNIT(j, x, mu::MR, 8, e, rb, cb, ok); if (!ok) break;
            const int n = ecnt[e], nrb = (n + mu::MR - 1) / mu::MR, base = n / nrb, rem = n % nrb, r0 = rb * base + (rb < rem ? rb : rem), nv = base + (rb < rem ? 1 : 0);
            const long adj = (long)e * CAPS - eo[e];
            mu::moe_unit<0>(F.lds, e, cb, eo[e] + r0, nv, (const bf16_t*)(F.ws + WS_HB), (const int*)(F.ws + WS_T2 + T2_TOK) + adj, F.wg, F.wu, (bf16_t*)(F.ws + WS_HID), (const float*)(F.ws + WS_T2 + T2_RS) + adj, nullptr); }
    } SEAM(8);
    if (IN(9)) REP(9) {
        MOE_OFFSETS();
        const int x = F.bid & 7;
        for (int j = F.bid >> 3; ; j += F.G >> 3) { int e = 0, rb = 0, cq = 0; bool ok; MOE_UNIT(j, x, mu::DR, 4, e, rb, cq, ok); if (!ok) break;
            const int n = ecnt[e], nrb = (n + mu::DR - 1) / mu::DR, base = n / nrb, rem = n % nrb, r0 = rb * base + (rb < rem ? rb : rem), nv = base + (rb < rem ? 1 : 0);
            const long adj = (long)e * CAPS - eo[e];
            mu::moe_down_stream(F.lds, e, 8 * cq, eo[e] + r0, nv, (const bf16_t*)(F.ws + WS_HID), F.wd, (bf16_t*)(F.ws + WS_Y), (const float*)(F.ws + WS_T2 + T2_W) + adj, (const int*)(F.ws + WS_T2 + T2_DST) + adj); }
    } SEAM(9);
#undef MOE_OFFSETS
#undef MOE_UNIT
    if (IN(10)) { p9_final(F); }
#undef IN
#undef SEAM
}

extern "C" void kernel_launch(void* const* d_in, const int* in_sizes, int n_in, void* d_out, int out_size, void* d_ws, size_t ws_size, hipStream_t stream) {
    static int grid = 0;
    if (grid == 0) {
        if (n_in != 18 || out_size != M * D || ws_size < WS_END) { fprintf(stderr, "kernel_launch: unexpected shapes (n_in %d, out %d, ws %zu < %zu)\n", n_in, out_size, ws_size, (size_t)WS_END); grid = -1; return; }
        int dev = 0, cus = 0, per_cu = 0;
        if (hipGetDevice(&dev) != hipSuccess || hipDeviceGetAttribute(&cus, hipDeviceAttributeMultiprocessorCount, dev) != hipSuccess) { grid = -1; return; }
        if (hipFuncSetAttribute((const void*)hymba_fwd, hipFuncAttributeMaxDynamicSharedMemorySize, LDS_BYTES) != hipSuccess) { fprintf(stderr, "kernel_launch: hipFuncSetAttribute failed\n"); grid = -1; return; }
        if (hipOccupancyMaxActiveBlocksPerMultiprocessor(&per_cu, (const void*)hymba_fwd, NTHREADS, LDS_BYTES) != hipSuccess || per_cu < 1) { fprintf(stderr, "kernel_launch: occupancy query says %d\n", per_cu); }
        (void)hipGetLastError();
        grid = cus;
    }
    if (grid < 0) return;
    (void)in_sizes;
    if (hipMemsetAsync((char*)d_ws + WS_CTL, 0, CTL_ZERO_BYTES, stream) != hipSuccess) return;
    Args a{};
    for (int i = 0; i < 18; ++i) a.in[i] = d_in[i];
    a.out = (float*)d_out; a.ws = (unsigned char*)d_ws;
    if (MK_N_LAUNCHES == 1) { a.ph_lo = 0; a.ph_hi = N_PHASES; hipLaunchKernelGGL(hymba_fwd, dim3(grid), dim3(NTHREADS), LDS_BYTES, stream, a); }
    else for (int p = 0; p < N_PHASES; ++p) { a.ph_lo = p; a.ph_hi = p + 1; hipLaunchKernelGGL(hymba_fwd, dim3(grid), dim3(NTHREADS), LDS_BYTES, stream, a); }
}
```

```cpp
#include <hip/hip_runtime.h>
#include <cstdio>
#include <cstdint>

#ifndef MK_N_LAUNCHES
#define MK_N_LAUNCHES 1
#endif

#ifndef PROBE_DUP
#define PROBE_DUP -1
#endif
#define REP(k) for (int rep_ = 0; rep_ < ((PROBE_DUP) == (k) ? 2 : 1); ++rep_)
#define GAS __attribute__((address_space(1)))
#define LAS __attribute__((address_space(3)))
#define PG8_LAS __attribute__((address_space(3)))

typedef unsigned short bf16_t;
typedef short bf16x8 __attribute__((ext_vector_type(8)));
typedef float f32x4 __attribute__((ext_vector_type(4)));
typedef float f32x2 __attribute__((ext_vector_type(2)));
typedef unsigned u32x4 __attribute__((ext_vector_type(4)));
typedef unsigned u32x2 __attribute__((ext_vector_type(2)));

constexpr int D = 4096, BATCH = 2, SEQ = 8192, M = BATCH * SEQ;
constexpr int IN_COLS = 8720, LDP = 8960;
constexpr int C_GQ = 0, C_GK = 1024, C_GV = 2048, C_GR = 4096, C_SQ = 6144, C_SK = 8192, C_SV = 8448, C_GA = 8704;
constexpr int NEXP = 64, DFF = 512;
constexpr int MAXSLOT = 49152;
constexpr float RMS_EPS = 1e-6f;

constexpr size_t MiB = 1u << 20;
constexpr size_t WS_CTL = 0, CTL_ZERO_BYTES = 1 * MiB;
constexpr size_t WS_TAB = 1 * MiB;
constexpr size_t WS_ROPE = 8 * MiB;
constexpr size_t WS_RB = 14 * MiB;
constexpr size_t WS_WIN = 32 * MiB;
constexpr size_t WS_WOUT = 102 * MiB;
constexpr size_t WS_U = 134 * MiB;
constexpr size_t WS_MIX = 262 * MiB;
constexpr size_t WS_PROJ = 390 * MiB;
constexpr size_t WS_Y = 390 * MiB;
constexpr size_t WS_HB = 670 * MiB;
constexpr size_t WS_WGU = 670 * MiB;
constexpr size_t WS_T2 = 1182 * MiB;
constexpr size_t T2_TOK = 0, T2_W = 4 * MiB, T2_DST = 8 * MiB, T2_RS = 12 * MiB; constexpr int CAPS = 16384;
constexpr size_t WS_WD = 1182 * MiB;
constexpr size_t WS_HID = 1438 * MiB;
constexpr size_t WS_QIN = 1486 * MiB;
constexpr size_t WS_KDT = 1518 * MiB;
constexpr size_t WS_AM = 1550 * MiB;
constexpr size_t WS_DEC = 1566 * MiB;
constexpr size_t WS_ORAW = 1568 * MiB;
constexpr size_t WS_END = 1632 * MiB;
constexpr size_t T_TOKE = 0;
constexpr size_t T_TOKW = 256 * 1024;
constexpr size_t T_TOKR = 512 * 1024;
constexpr size_t T_SLOTTOK = 768 * 1024;
constexpr size_t T_SLOTW = 1024 * 1024;
constexpr size_t T_SLOTDST = 1280 * 1024;
constexpr size_t T_TILEE = 1536 * 1024;
constexpr int UL_UP = 2048, UL_DN = 8192;
constexpr size_t T_ULUP = 1800 * 1024;
constexpr size_t T_EOFF = 1900 * 1024;
constexpr size_t T_ULDN = 2048 * 1024;
constexpr size_t T_RSTD = 1540 * 1024;
constexpr size_t T_SLOTRS = 1604 * 1024;
constexpr int CW_CNT = 1024;
constexpr int CW_NT = 1100;
constexpr int CW_NUP = 1200, CW_NDN = 1216;
constexpr int CW_BAR = 4096;

constexpr int RING_BYTES = 141312;
constexpr int LDSCTL_OFF = RING_BYTES, MISC_OFF = LDSCTL_OFF + 320;
constexpr int LDS_BYTES = 142336;

#define LDS_WAIT() asm volatile("s_waitcnt lgkmcnt(0)" ::: "memory")
#define VM_WAIT() asm volatile("s_waitcnt vmcnt(0)" ::: "memory")
__device__ __forceinline__ unsigned f2bf(float f) { unsigned u = __builtin_bit_cast(unsigned, f); return (u + 0x7fffu + ((u >> 16) & 1u)) >> 16; }
__device__ __forceinline__ unsigned pk2(float lo, float hi) { return f2bf(lo) | (f2bf(hi) << 16); }
__device__ __forceinline__ float bf2f(unsigned short b) { return __builtin_bit_cast(float, ((unsigned)b) << 16); }
__device__ __forceinline__ float bflo(unsigned w) { return __builtin_bit_cast(float, w << 16); }
__device__ __forceinline__ float bfhi(unsigned w) { return __builtin_bit_cast(float, w & 0xffff0000u); }
__device__ __forceinline__ unsigned cvt_pk_bf16(float lo, float hi) { unsigned r; asm volatile("v_cvt_pk_bf16_f32 %0, %1, %2" : "=v"(r) : "v"(lo), "v"(hi)); return r; }
typedef float f32x16 __attribute__((ext_vector_type(16)));
typedef short s16x4 __attribute__((ext_vector_type(4)));
typedef __bf16 bf16x2_t __attribute__((ext_vector_type(2)));
__device__ __forceinline__ unsigned cvtpk(float lo, float hi) { f32x2 v = {lo, hi}; bf16x2_t b = __builtin_convertvector(v, bf16x2_t); return __builtin_bit_cast(unsigned, b); }
__device__ __forceinline__ float wave_sum(float v) {
#pragma unroll
    for (int o = 1; o < 64; o <<= 1) v += __shfl_xor(v, o);
    return v;
}

#define XB_TMO      128
#define XB_XCNT(j)  (256  + 64 * (j))
#define XB_XSUB(j)  (1280 + 64 * (j))
#define XB_XGEN(j)  (2304 + 64 * (j))
#define XB_TOP      3328
#define XB_TOPGEN   3392
#define XCD_BAR_WORDS 3456
#define XB_SPIN_CAP (1u << 18)

__device__ __forceinline__ unsigned xb_ld(unsigned* p)              { return __hip_atomic_load(p, __ATOMIC_RELAXED, __HIP_MEMORY_SCOPE_AGENT); }
__device__ __forceinline__ unsigned xb_add(unsigned* p, unsigned v) { return __hip_atomic_fetch_add(p, v, __ATOMIC_RELAXED, __HIP_MEMORY_SCOPE_AGENT); }
__device__ __forceinline__ unsigned xb_xcc_id() { return (unsigned)__builtin_amdgcn_s_getreg((3 << 11) | 20) & 0xFu; }
#define XB_SPIN(cond, bar) do { unsigned _sp = 0; while (cond) { __builtin_amdgcn_s_sleep(1); \
    if ((++_sp & 255u) == 0u) { if (xb_ld(&(bar)[XB_TMO])) break; if (_sp > XB_SPIN_CAP) { atomicAdd(&(bar)[XB_TMO], 1u); break; } } } } while (0)

struct XcdBarrier { unsigned* bar; unsigned x; volatile LAS unsigned* st; };

__device__ __forceinline__ XcdBarrier xcd_barrier_post(unsigned* bar, volatile LAS unsigned* st) {
    XcdBarrier b; b.bar = bar; b.x = xb_xcc_id(); b.st = st;
    if (threadIdx.x == 0) (void)xb_add(&bar[XB_XCNT(b.x)], 1u);
    return b;
}
__device__ __forceinline__ void xcd_barrier_complete(unsigned* bar, unsigned x, unsigned& nloc, unsigned& nx) {
    const unsigned G = gridDim.x * gridDim.y * gridDim.z;
    unsigned sum, cnt, mine, sp = 0u;
    for (;;) {
        sum = 0u; cnt = 0u; mine = 0u;
#pragma unroll
        for (unsigned j = 0; j < 16; ++j) { const unsigned c = xb_ld(&bar[XB_XCNT(j)]); sum += c; cnt += (c > 0u) ? 1u : 0u; mine = (j == x) ? c : mine; }
        if (sum == G) break;
        __builtin_amdgcn_s_sleep(1);
        if ((++sp & 255u) == 0u) { if (xb_ld(&bar[XB_TMO])) break; if (sp > XB_SPIN_CAP) { atomicAdd(&bar[XB_TMO], 1u); break; } }
    }
    nloc = mine > 0u ? mine : 1u; nx = cnt > 0u ? cnt : 1u;
}
__device__ __forceinline__ void xcd_barrier(const XcdBarrier& b) {
    asm volatile("s_waitcnt vmcnt(0)" ::: "memory");
    __syncthreads();
    if (threadIdx.x == 0) {
        unsigned* bar = b.bar;
        __builtin_amdgcn_s_waitcnt(0);
        unsigned nloc = b.st[0], nx = b.st[1];
        if (nloc == 0u) { xcd_barrier_complete(bar, b.x, nloc, nx); b.st[0] = nloc; b.st[1] = nx; }
        const unsigned old = xb_add(&bar[XB_XSUB(b.x)], 1u);
        const unsigned gen = old / nloc;
        if (old + 1u == (gen + 1u) * nloc) {
            __builtin_amdgcn_fence(__ATOMIC_RELEASE, "agent");
            asm volatile("s_waitcnt vmcnt(0)" ::: "memory");
            const unsigned og = xb_add(&bar[XB_TOP], 1u);
            const unsigned tg = og / nx;
            if (og + 1u == (tg + 1u) * nx) xb_add(&bar[XB_TOPGEN], 1u);
            else XB_SPIN(xb_ld(&bar[XB_TOPGEN]) == tg, bar);
            __builtin_amdgcn_fence(__ATOMIC_ACQUIRE, "agent");
            xb_add(&bar[XB_XGEN(b.x)], 1u);
            asm volatile("s_waitcnt vmcnt(0)" ::: "memory");
        } else {
            XB_SPIN(xb_ld(&bar[XB_XGEN(b.x)]) == gen, bar);
            __builtin_amdgcn_fence(__ATOMIC_ACQUIRE, "agent");
            asm volatile("s_waitcnt vmcnt(0)" ::: "memory");
        }
    }
    __syncthreads();
}

namespace pg8 {
constexpr int BM = 256, BK = 64, HALF = 128, HTB = HALF * BK * 2, STAGE_BYTES = 8 * HTB, NXCD = 8, WGM = 8;
__host__ __device__ __forceinline__ int lds_byte(int r, int c) { const int st = (r >> 4) * 2 + (c >> 5), rr = r & 15, cc = c & 31, ob = rr * 64 + cc * 2; return st * 1024 + (ob ^ (((ob >> 9) & 1) << 5)); }
__host__ __device__ __forceinline__ void stage_rc(int b, int& R, int& C) { const int st = b / 1024, sb = b % 1024, swz = sb ^ (((sb >> 9) & 1) << 5); R = (st >> 1) * 16 + swz / 64; C = (st & 1) * 32 + (swz % 64) / 2; }
__host__ __device__ __forceinline__ int perm32(int rho) { const int n = rho >> 4, i = rho & 15; return 8 * (i >> 2) + 4 * n + (i & 3); }

struct Unit { int pm, pn, e; };

struct DenseSched {
    static constexpr bool GATHER = false;
    const bf16_t* A; const bf16_t* Bt; int K;
    int nM, nN, nwg, G, c;
    __device__ void init(const bf16_t* A_, const bf16_t* Bt_, int Mr, int N, int K_, int G_, int c_) { A = A_; Bt = Bt_; K = K_; nM = Mr / BM; nN = N / BM; nwg = nM * nN; G = G_; c = c_; }
    __device__ bool next(int i, Unit& u) const {
        const long L = (long)i * G + c; if (L >= nwg) return false;
        int wgid = (int)L; { const int q = nwg / NXCD, r = nwg % NXCD, xcd = wgid % NXCD, off = wgid / NXCD; wgid = (xcd < r ? xcd * (q + 1) : r * (q + 1) + (xcd - r) * q) + off; }
        const int nig = WGM * nN, gid = wgid / nig, fm = gid * WGM, gsz = (nM - fm) < WGM ? (nM - fm) : WGM;
        u.pm = fm + ((wgid % nig) % gsz); u.pn = (wgid % nig) / gsz; u.e = 0; return true;
    }
    __device__ __forceinline__ const char* a_ptr(const Unit& u) const { return (const char*)A + (size_t)u.pm * BM * K * 2; }
    __device__ __forceinline__ const char* b_ptr(const Unit& u) const { return (const char*)Bt + (size_t)u.pn * BM * K * 2; }
    __device__ __forceinline__ unsigned row(const Unit&, int) const { return 0u; }
};
struct MoeUpSched {
    static constexpr bool GATHER = true;
    const bf16_t* A; const bf16_t* Bt; const int* tile_e; const int* slot_tok; int ntiles, G, c;
    __device__ bool next(int i, Unit& u) const {
        if ((G & 7) == 0) { const int x = c & 7, idx = (c >> 3) + (G >> 3) * i; u.pm = 8 * (idx >> 2) + x; u.pn = idx & 3; if (u.pm >= ntiles) return false; }
        else { const int L = i * G + c; if (L >= ntiles * 4) return false; u.pm = L >> 2; u.pn = L & 3; }
        u.e = tile_e[u.pm]; return true;
    }
    __device__ __forceinline__ const char* a_ptr(const Unit&) const { return (const char*)A; }
    __device__ __forceinline__ const char* b_ptr(const Unit& u) const { return (const char*)Bt + ((size_t)u.e * 1024 + (size_t)u.pn * 256) * 4096 * 2; }
    __device__ __forceinline__ unsigned row(const Unit& u, int r) const { return (unsigned)slot_tok[u.pm * 256 + r]; }
};
struct MoeDownSched {
    static constexpr bool GATHER = false;
    const bf16_t* A; const bf16_t* Bt; const int* tile_e; int ntiles, G, c;
    __device__ bool next(int i, Unit& u) const {
        const int L = i * G + c; if (L >= ntiles * 16) return false;
        u.pm = L >> 4; u.pn = L & 15; u.e = tile_e[u.pm]; return true;
    }
    __device__ __forceinline__ const char* a_ptr(const Unit& u) const { return (const char*)A + (size_t)u.pm * 256 * 512 * 2; }
    __device__ __forceinline__ const char* b_ptr(const Unit& u) const { return (const char*)Bt + ((size_t)u.e * 4096 + (size_t)u.pn * 256) * 512 * 2; }
    __device__ __forceinline__ unsigned row(const Unit&, int) const { return 0u; }
};

struct EpiBf16 {
    static constexpr bool PERM = true;
    bf16_t* O; int ldc;
    __device__ __forceinline__ void operator()(const f32x4 (&acc)[2][2][4][2], const Unit& u, int wr, int wc, int fr, int fq) const {
        const int row0 = u.pm * BM + wr * 64 + fr, col0 = u.pn * BM + wc * 32 + 8 * fq;
#pragma unroll
        for (int ai = 0; ai < 2; ++ai)
#pragma unroll
            for (int m = 0; m < 4; ++m) { bf16_t* rowp = O + (size_t)(row0 + ai * HALF + m * 16) * ldc + col0;
#pragma unroll
                for (int bj = 0; bj < 2; ++bj) { const f32x4 v0 = acc[ai][bj][m][0], v1 = acc[ai][bj][m][1];
                    u32x4 w; w.x = cvt_pk_bf16(v0[0], v0[1]); w.y = cvt_pk_bf16(v0[2], v0[3]); w.z = cvt_pk_bf16(v1[0], v1[1]); w.w = cvt_pk_bf16(v1[2], v1[3]);
                    *(u32x4*)(rowp + bj * HALF) = w; } }
    }
};
struct EpiResF32 {
    static constexpr bool PERM = false;
    const float* res; float* out; int ldc;
    __device__ __forceinline__ void operator()(const f32x4 (&acc)[2][2][4][2], const Unit& u, int wr, int wc, int fr, int fq) const {
        const int row0 = u.pm * BM + wr * 64 + fr, col0 = u.pn * BM + wc * 32 + 4 * fq;
#pragma unroll
        for (int ai = 0; ai < 2; ++ai)
#pragma unroll
            for (int m = 0; m < 4; ++m) { const size_t off = (size_t)(row0 + ai * HALF + m * 16) * ldc + col0;
#pragma unroll
                for (int bj = 0; bj < 2; ++bj)
#pragma unroll
                    for (int n = 0; n < 2; ++n) { const f32x4 r = *(const f32x4*)(res + off + bj * HALF + n * 16); *(f32x4*)(out + off + bj * HALF + n * 16) = r + acc[ai][bj][m][n]; }
                if (m & 1) asm volatile("" ::: "memory"); }
    }
};
struct EpiResBf16 {
    static constexpr bool PERM = true;
    const float* res; bf16_t* out; int ldc;
    __device__ __forceinline__ void operator()(const f32x4 (&acc)[2][2][4][2], const Unit& u, int wr, int wc, int fr, int fq) const {
        const int row0 = u.pm * BM + wr * 64 + fr, col0 = u.pn * BM + wc * 32 + 8 * fq;
#pragma unroll
        for (int ai = 0; ai < 2; ++ai)
#pragma unroll
            for (int m = 0; m < 4; ++m) { const size_t off = (size_t)(row0 + ai * HALF + m * 16) * ldc + col0;
#pragma unroll
                for (int bj = 0; bj < 2; ++bj) { const f32x4 v0 = *(const f32x4*)(res + off + bj * HALF) + acc[ai][bj][m][0], v1 = *(const f32x4*)(res + off + bj * HALF + 4) + acc[ai][bj][m][1];
                    u32x4 w; w.x = cvt_pk_bf16(v0[0], v0[1]); w.y = cvt_pk_bf16(v0[2], v0[3]); w.z = cvt_pk_bf16(v1[0], v1[1]); w.w = cvt_pk_bf16(v1[2], v1[3]);
                    *(u32x4*)(out + off + bj * HALF) = w; }
                if (m & 1) asm volatile("" ::: "memory"); }
    }
};
struct EpiSwiGlu {
    static constexpr bool PERM = true;
    bf16_t* HID; const float* slot_rs;
    __device__ __forceinline__ void operator()(const f32x4 (&acc)[2][2][4][2], const Unit& u, int wr, int wc, int fr, int fq) const {
        const int row0 = u.pm * BM + wr * 64 + fr, col0 = u.pn * 128 + wc * 32 + 8 * fq;
#pragma unroll
        for (int ai = 0; ai < 2; ++ai)
#pragma unroll
            for (int m = 0; m < 4; ++m) { bf16_t* rowp = HID + (size_t)(row0 + ai * HALF + m * 16) * DFF + col0; const float rs = slot_rs[row0 + ai * HALF + m * 16];
                float h[8];
#pragma unroll
                for (int n = 0; n < 2; ++n)
#pragma unroll
                    for (int j = 0; j < 4; ++j) { const float g = acc[ai][0][m][n][j] * rs, up = acc[ai][1][m][n][j] * rs; h[n * 4 + j] = g * __builtin_amdgcn_rcpf(1.0f + __expf(-g)) * up; }
                u32x4 w; w.x = cvt_pk_bf16(h[0], h[1]); w.y = cvt_pk_bf16(h[2], h[3]); w.z = cvt_pk_bf16(h[4], h[5]); w.w = cvt_pk_bf16(h[6], h[7]);
                *(u32x4*)rowp = w; }
    }
};
struct EpiDown {
    static constexpr bool PERM = true;
    bf16_t* Y; const int* slot_dst; const float* slot_w;
    __device__ __forceinline__ void operator()(const f32x4 (&acc)[2][2][4][2], const Unit& u, int wr, int wc, int fr, int fq) const {
        const int slot0 = u.pm * BM + wr * 64 + fr, col0 = u.pn * BM + wc * 32 + 8 * fq;
#pragma unroll
        for (int ai = 0; ai < 2; ++ai)
#pragma unroll
            for (int m = 0; m < 4; ++m) { const int slot = slot0 + ai * HALF + m * 16; const int dst = slot_dst[slot]; const float sw = slot_w[slot];
                if (dst >= 0) { bf16_t* rowp = Y + (size_t)dst * D + col0;
#pragma unroll
                    for (int bj = 0; bj < 2; ++bj) { const f32x4 v0 = acc[ai][bj][m][0] * sw, v1 = acc[ai][bj][m][1] * sw;
                        u32x4 w; w.x = cvt_pk_bf16(v0[0], v0[1]); w.y = cvt_pk_bf16(v0[2], v0[3]); w.z = cvt_pk_bf16(v1[0], v1[1]); w.w = cvt_pk_bf16(v1[2], v1[3]);
                        *(u32x4*)(rowp + bj * HALF) = w; } } }
    }
};

template <class Epi, class Sched, bool ALIGN_EPI>
__device__ __forceinline__ void gemm_phase(PG8_LAS unsigned char* lds, const int K, const Sched& S, const Epi& E) {
    const int tid = threadIdx.x, wid = __builtin_amdgcn_readfirstlane(tid >> 6), lane = tid & 63, wr = wid >> 2, wc = wid & 3, fr = lane & 15, fq = lane >> 4;
    const int nt = K / BK;
    unsigned voffA[2], voffB[2]; int RA[2], CA[2];
#pragma unroll
    for (int i = 0; i < 2; ++i) { int R, C; stage_rc(tid * 16 + i * 8192, R, C); const int Rb = Epi::PERM ? ((R & ~31) + perm32(R & 31)) : R;
        voffA[i] = (unsigned)(R * K + C) * 2u; voffB[i] = (unsigned)(Rb * K + C) * 2u; RA[i] = R; CA[i] = C; }
    const size_t kstep = (size_t)(BK * 2);
    const size_t hstep = (size_t)HALF * K * 2;
    const unsigned ldsw = (unsigned)wid * 1024u;
    const int aoff = lds_byte(wr * 64 + fr, fq * 8), boff = lds_byte(wc * 32 + fr, fq * 8);
#define PG8_SA(b, h) (((b) * 2 + (h)) * HTB)
#define PG8_SB(b, h) ((4 + (b) * 2 + (h)) * HTB)
#define PG8_STAGE(bufoff, gbase, voff) do { _Pragma("unroll") for (int _i = 0; _i < 2; ++_i) \
        __builtin_amdgcn_global_load_lds((const unsigned*)((const char*)(gbase) + (voff)[_i]), (PG8_LAS unsigned*)(lds + (bufoff) + ldsw + _i * 8192), 16, 0, 0); } while (0)
#define PG8_STAGE_A(bufoff, gb, vo, h) do { if constexpr (Sched::GATHER) { PG8_STAGE(bufoff, gb, (vo)[h]); } else { PG8_STAGE(bufoff, (gb) + (h) * hstep, voffA); } } while (0)
#define PG8_LDA(dst, b, h) do { _Pragma("unroll") for (int m = 0; m < 4; ++m) _Pragma("unroll") for (int k = 0; k < 2; ++k) dst[m][k] = *(const PG8_LAS bf16x8*)(lds + PG8_SA(b, h) + aoff + m * 2048 + k * 1024); } while (0)
#define PG8_LDB(dst, b, h) do { _Pragma("unroll") for (int n = 0; n < 2; ++n) _Pragma("unroll") for (int k = 0; k < 2; ++k) dst[n][k] = *(const PG8_LAS bf16x8*)(lds + PG8_SB(b, h) + boff + n * 2048 + k * 1024); } while (0)
#define PG8_MMA(ai, bj, At, Bt) do { __builtin_amdgcn_s_setprio(1); _Pragma("unroll") for (int m = 0; m < 4; ++m) _Pragma("unroll") for (int n = 0; n < 2; ++n) _Pragma("unroll") for (int k = 0; k < 2; ++k) \
        acc[ai][bj][m][n] = __builtin_amdgcn_mfma_f32_16x16x32_bf16(Bt[n][k], At[m][k], acc[ai][bj][m][n], 0, 0, 0); __builtin_amdgcn_s_setprio(0); } while (0)
#define PG8_WAIT_V(n) asm volatile("s_waitcnt vmcnt(" #n ")" ::: "memory")
#define PG8_WAIT_L(n) asm volatile("s_waitcnt lgkmcnt(" #n ")" ::: "memory")
#define PG8_BAR __builtin_amdgcn_s_barrier()
#define PG8_SCHED __builtin_amdgcn_sched_barrier(0)
    Unit cur, nxt; int ui = 0;
    if (!S.next(0, cur)) return;
    f32x4 acc[2][2][4][2];
#pragma unroll
    for (int a = 0; a < 2; ++a)
#pragma unroll
        for (int b = 0; b < 2; ++b)
#pragma unroll
            for (int m = 0; m < 4; ++m)
#pragma unroll
                for (int n = 0; n < 2; ++n) acc[a][b][m][n] = (f32x4){0.f, 0.f, 0.f, 0.f};
    bf16x8 At[4][2], B0[2][2], B1[2][2];
    unsigned cvo[2][2], nvo[2][2];
#pragma unroll
    for (int h = 0; h < 2; ++h)
#pragma unroll
        for (int i = 0; i < 2; ++i) { cvo[h][i] = Sched::GATHER ? (S.row(cur, h * HALF + RA[i]) * (unsigned)K + (unsigned)CA[i]) * 2u : 0u; nvo[h][i] = cvo[h][i]; }
    const char* cA = S.a_ptr(cur); const char* cB = S.b_ptr(cur);
    PG8_STAGE(PG8_SB(0, 0), cB, voffB); PG8_STAGE(PG8_SB(0, 1), cB + hstep, voffB); PG8_STAGE_A(PG8_SA(0, 0), cA, cvo, 0); PG8_STAGE_A(PG8_SA(0, 1), cA, cvo, 1);
    if (wr == 1) PG8_BAR;
    PG8_WAIT_V(2); PG8_BAR;
    PG8_STAGE(PG8_SB(1, 0), cB + kstep, voffB); PG8_STAGE_A(PG8_SA(1, 0), cA + kstep, cvo, 0); PG8_STAGE(PG8_SB(1, 1), cB + hstep + kstep, voffB);
    PG8_WAIT_V(6); PG8_BAR;
    for (;;) {
        const bool has_next = S.next(ui + 1, nxt);
        const char* nA = has_next ? S.a_ptr(nxt) : cA; const char* nB = has_next ? S.b_ptr(nxt) : cB;
        if constexpr (Sched::GATHER) {
#pragma unroll
            for (int h = 0; h < 2; ++h)
#pragma unroll
                for (int i = 0; i < 2; ++i) nvo[h][i] = has_next ? (S.row(nxt, h * HALF + RA[i]) * (unsigned)K + (unsigned)CA[i]) * 2u : cvo[h][i];
        }
        for (int t = 0; t < nt; t += 2) {
            const bool last = (t == nt - 2);
            const char* a1 = cA + (size_t)(t + 1) * kstep;
            const char* a2 = last ? nA : cA + (size_t)(t + 2) * kstep; const char* b2 = last ? nB : cB + (size_t)(t + 2) * kstep;
            const char* a3 = a2 + kstep; const char* b3 = b2 + kstep;
            unsigned vo2[2][2];
#pragma unroll
            for (int h = 0; h < 2; ++h)
#pragma unroll
                for (int i = 0; i < 2; ++i) vo2[h][i] = last ? nvo[h][i] : cvo[h][i];
            PG8_LDB(B0, 0, 0); PG8_LDB(B1, 0, 1); PG8_SCHED; PG8_LDA(At, 0, 0); PG8_STAGE_A(PG8_SA(1, 1), a1, cvo, 1);
            PG8_WAIT_V(8); PG8_WAIT_L(0); PG8_BAR; PG8_MMA(0, 0, At, B0); PG8_MMA(0, 1, At, B1); PG8_BAR; PG8_SCHED;
            PG8_LDA(At, 0, 1); PG8_STAGE(PG8_SB(0, 0), b2, voffB); PG8_STAGE(PG8_SB(0, 1), b2 + hstep, voffB); PG8_STAGE_A(PG8_SA(0, 0), a2, vo2, 0);
            PG8_WAIT_V(8); PG8_WAIT_L(0); PG8_BAR; PG8_MMA(1, 0, At, B0); PG8_MMA(1, 1, At, B1); PG8_BAR; PG8_SCHED;
            PG8_LDB(B0, 1, 0); PG8_LDB(B1, 1, 1); PG8_SCHED; PG8_LDA(At, 1, 0); PG8_STAGE_A(PG8_SA(0, 1), a2, vo2, 1);
            PG8_WAIT_V(8); PG8_WAIT_L(0); PG8_BAR; PG8_MMA(0, 0, At, B0); PG8_MMA(0, 1, At, B1); PG8_BAR; PG8_SCHED;
            PG8_LDA(At, 1, 1); PG8_STAGE(PG8_SB(1, 0), b3, voffB); PG8_STAGE(PG8_SB(1, 1), b3 + hstep, voffB); PG8_STAGE_A(PG8_SA(1, 0), a3, vo2, 0);
            PG8_WAIT_V(8); PG8_WAIT_L(0); PG8_BAR; PG8_MMA(1, 0, At, B0); PG8_MMA(1, 1, At, B1); PG8_BAR; PG8_SCHED;
        }
        if constexpr (ALIGN_EPI) { if (wr == 0) PG8_BAR; }
        E(acc, cur, wr, wc, fr, fq);
        if (!has_next) break;
#pragma unroll
        for (int a = 0; a < 2; ++a)
#pragma unroll
            for (int b = 0; b < 2; ++b)
#pragma unroll
                for (int m = 0; m < 4; ++m)
#pragma unroll
                    for (int n = 0; n < 2; ++n) acc[a][b][m][n] = (f32x4){0.f, 0.f, 0.f, 0.f};
        cur = nxt; cA = nA; cB = nB; ++ui;
#pragma unroll
        for (int h = 0; h < 2; ++h)
#pragma unroll
            for (int i = 0; i < 2; ++i) cvo[h][i] = nvo[h][i];
        if constexpr (ALIGN_EPI) { if (wr == 1) PG8_BAR; }
    }
    PG8_WAIT_V(0);
    if constexpr (!ALIGN_EPI) { if (wr == 0) PG8_BAR; }
    PG8_BAR;
#undef PG8_SA
#undef PG8_SB
#undef PG8_STAGE
#undef PG8_STAGE_A
#undef PG8_LDA
#undef PG8_LDB
#undef PG8_MMA
#undef PG8_WAIT_V
#undef PG8_WAIT_L
#undef PG8_BAR
#undef PG8_SCHED
}
}

namespace mu {
constexpr int MR = 320, RWU = 80, NMU = 5, ABYTES = MR * 64 * 2, BBYTES = 128 * 64 * 2;
constexpr int GAIN_OFF = 2 * ABYTES + 2 * BBYTES;
__device__ __forceinline__ int lds_byte(int r, int c) { const int st = (r >> 4) * 2 + (c >> 5), ob = (r & 15) * 64 + (c & 31) * 2; return st * 1024 + (ob ^ (((ob >> 9) & 1) << 5)); }
__device__ __forceinline__ void stage_rc(int b, int& R, int& C) { const int st = b >> 10, sb = b & 1023, swz = sb ^ (((sb >> 9) & 1) << 5); R = (st >> 1) * 16 + swz / 64; C = (st & 1) * 32 + (swz % 64) / 2; }
template <int MODE>
__device__ __forceinline__ void moe_unit(PG8_LAS unsigned char* lds, int e, int cb, int slot0  , int nv  , const bf16_t* A, const int* slot_tok,
                                         const float* W0, const float* W1, bf16_t* OUT, const float* slot_rs  , const int* slot_dst) {
    constexpr int K = MODE == 0 ? 4096 : 512, nt = K / 64, LDB = MODE == 0 ? 512 : 4096, RB = LDB * 4  ;
    const int tid = threadIdx.x, wid = __builtin_amdgcn_readfirstlane(tid >> 6), lane = tid & 63, wr = wid >> 1, wc = wid & 1, fr = lane & 15, fq = lane >> 4;
    unsigned aoff[NMU];
#pragma unroll
    for (int i = 0; i < NMU; ++i) { int R, C; stage_rc(wid * 1024 + i * 8192 + lane * 16, R, C); const int w4 = R / RWU, r = 4 * (R - RWU * w4) + w4;
        const unsigned row = r < nv ? (MODE == 0 ? (unsigned)slot_tok[slot0 + r] : (unsigned)(slot0 + r)) : (MODE == 0 ? 0u : (unsigned)slot0); aoff[i] = (row * (unsigned)K + (unsigned)C) * 2u; }
    const int jj0 = 2 * (lane & 31), typ = lane >> 5;
    const int R0 = MODE == 0 ? 64 * (jj0 >> 5) + 32 * typ + 16 * ((jj0 >> 2) & 1) + 4 * ((jj0 >> 3) & 3) + (jj0 & 3) : 2 * lane;
    const char* Bb = MODE == 0 ? (const char*)((typ ? W1 : W0) + (size_t)e * K * LDB + 64 * cb + jj0) + (size_t)(8 * wid) * RB
                               : (const char*)(W0 + (size_t)e * K * LDB + 128 * cb + 2 * lane) + (size_t)(8 * wid) * RB;
    const unsigned bw0 = (unsigned)(R0 * 128 + ((wid ^ ((R0 >> 1) & 7)) * 16)), bw1 = bw0 + 128u;
    const int nvw = (nv - wr + 3) >> 2, mcnt = nvw <= 0 ? 0 : (((nvw + 15) >> 4) > NMU ? NMU : ((nvw + 15) >> 4));
#define MU_SA(b) (lds + (b) * ABYTES)
#define MU_SB(b) (lds + 2 * ABYTES + (b) * BBYTES)
#define MU_GLDS_A(buf, kt) do { _Pragma("unroll") for (int i = 0; i < NMU; ++i) \
        __builtin_amdgcn_global_load_lds((const unsigned*)((const char*)A + aoff[i] + (size_t)(kt) * 128), (PG8_LAS unsigned*)(MU_SA(buf) + wid * 1024 + i * 8192), 16, 0, 0); } while (0)
#define MU_B_ISSUE(sb, kt) do { const char* kb_ = Bb + (size_t)(kt) * (64 * (size_t)RB); _Pragma("unroll") for (int j = 0; j < 8; ++j) { const char* p_ = kb_ + (size_t)j * RB; \
        asm volatile("global_load_dwordx2 %0, %1, off" : "=&v"(sb[j]) : "v"(p_) : "memory"); } } while (0)
#define MU_B_WAIT(sb, N) asm volatile("s_waitcnt vmcnt(%8)" : "+v"(sb[0]), "+v"(sb[1]), "+v"(sb[2]), "+v"(sb[3]), "+v"(sb[4]), "+v"(sb[5]), "+v"(sb[6]), "+v"(sb[7]) : "n"(N) : "memory")
#define MU_G_LOAD(ga, kt) do { const PG8_LAS f32x4* gk_ = (const PG8_LAS f32x4*)(lds + GAIN_OFF) + 16 * (kt) + 2 * wid; const f32x4 ga_ = gk_[0], gb_ = gk_[1]; \
        ga[0] = ga_[0]; ga[1] = ga_[1]; ga[2] = ga_[2]; ga[3] = ga_[3]; ga[4] = gb_[0]; ga[5] = gb_[1]; ga[6] = gb_[2]; ga[7] = gb_[3]; } while (0)
#define MU_B_WRITE(sb, buf, ga) do { u32x4 w0_, w1_; w0_.x = cvtpk(sb[0].x * ga[0], sb[1].x * ga[1]); w0_.y = cvtpk(sb[2].x * ga[2], sb[3].x * ga[3]); w0_.z = cvtpk(sb[4].x * ga[4], sb[5].x * ga[5]); w0_.w = cvtpk(sb[6].x * ga[6], sb[7].x * ga[7]); \
        w1_.x = cvtpk(sb[0].y * ga[0], sb[1].y * ga[1]); w1_.y = cvtpk(sb[2].y * ga[2], sb[3].y * ga[3]); w1_.z = cvtpk(sb[4].y * ga[4], sb[5].y * ga[5]); w1_.w = cvtpk(sb[6].y * ga[6], sb[7].y * ga[7]); \
        *(PG8_LAS u32x4*)(MU_SB(buf) + bw0) = w0_; *(PG8_LAS u32x4*)(MU_SB(buf) + bw1) = w1_; } while (0)
#define MU_RDA(buf, ks, m) (*(const PG8_LAS bf16x8*)(MU_SA(buf) + lds_byte(RWU * wr + 16 * (m) + fr, 32 * (ks) + 8 * fq)))
#define MU_RDB(buf, ks, n) (*(const PG8_LAS bf16x8*)(MU_SB(buf) + (64 * wc + 16 * (n) + fr) * 128 + (((4 * (ks) + fq) ^ (((64 * wc + 16 * (n) + fr) >> 1) & 7)) * 16)))
#define MU_COMPUTE_N(buf, MC) do { bf16x8 At[MC], Bf0[4], Bf1[4]; \
        _Pragma("unroll") for (int n = 0; n < 4; ++n) Bf0[n] = MU_RDB(buf, 0, n); \
        _Pragma("unroll") for (int m = 0; m < (MC); ++m) At[m] = MU_RDA(buf, 0, m); \
        _Pragma("unroll") for (int m = 0; m < (MC); ++m) { _Pragma("unroll") for (int n = 0; n < 4; ++n) acc[m][n] = __builtin_amdgcn_mfma_f32_16x16x32_bf16(Bf0[n], At[m], acc[m][n], 0, 0, 0); \
            At[m] = MU_RDA(buf, 1, m); if (m < 4) Bf1[m] = MU_RDB(buf, 1, m); } \
        _Pragma("unroll") for (int m = 0; m < (MC); ++m) { _Pragma("unroll") for (int n = 0; n < 4; ++n) acc[m][n] = __builtin_amdgcn_mfma_f32_16x16x32_bf16(Bf1[n], At[m], acc[m][n], 0, 0, 0); } \
        __builtin_amdgcn_sched_group_barrier(0x100, 4 + (MC), 0); \
        _Pragma("unroll") for (int m = 0; m < (MC); ++m) { __builtin_amdgcn_sched_group_barrier(0x008, 4, 0); __builtin_amdgcn_sched_group_barrier(0x100, 1, 0); if (m < 4) __builtin_amdgcn_sched_group_barrier(0x100, 1, 0); } \
        __builtin_amdgcn_sched_group_barrier(0x008, 4 * (MC), 0); \
        __builtin_amdgcn_sched_barrier(0); } while (0)
#define MU_COMPUTE(buf) MU_COMPUTE_N(buf, NMU)
#define MU_END(last) do { if (last) asm volatile("s_waitcnt vmcnt(0)" ::: "memory"); else asm volatile("s_waitcnt vmcnt(8)" ::: "memory"); \
        asm volatile("s_waitcnt lgkmcnt(0)" ::: "memory"); __builtin_amdgcn_s_barrier(); asm volatile("" ::: "memory"); } while (0)
    f32x4 acc[NMU][4];
#pragma unroll
    for (int m = 0; m < NMU; ++m)
#pragma unroll
        for (int n = 0; n < 4; ++n) acc[m][n] = (f32x4){0.f, 0.f, 0.f, 0.f};
    f32x2 s0[8], s1[8];
    float g0[8];
    MU_GLDS_A(0, 0); MU_B_ISSUE(s0, 0); MU_G_LOAD(g0, 0); MU_B_ISSUE(s1, 1);
    MU_B_WAIT(s0, 8); MU_B_WRITE(s0, 0, g0); __builtin_amdgcn_sched_barrier(0); MU_B_ISSUE(s0, 2);
    asm volatile("s_waitcnt vmcnt(16)" ::: "memory");
    asm volatile("s_waitcnt lgkmcnt(0)" ::: "memory"); __builtin_amdgcn_s_barrier(); asm volatile("" ::: "memory");
#pragma unroll 1
    for (int t = 0; t < nt; t += 2) {
        if (t + 2 < nt) MU_B_WAIT(s1, 8); else MU_B_WAIT(s1, 0);
        MU_G_LOAD(g0, t + 1); MU_B_WRITE(s1, 1, g0); __builtin_amdgcn_sched_barrier(0); MU_GLDS_A(1, t + 1); __builtin_amdgcn_sched_barrier(0);
        if (t + 3 < nt) { MU_B_ISSUE(s1, t + 3); }
        MU_COMPUTE(0);
        MU_END(t + 3 >= nt);
        if (t + 2 < nt) { MU_B_WAIT(s0, 8); MU_G_LOAD(g0, t + 2); MU_B_WRITE(s0, 0, g0); __builtin_amdgcn_sched_barrier(0); MU_GLDS_A(0, t + 2); __builtin_amdgcn_sched_barrier(0); }
        if (t + 4 < nt) { MU_B_ISSUE(s0, t + 4); }
        MU_COMPUTE(1);
        MU_END(t + 4 >= nt);
    }
#pragma unroll
    for (int m = 0; m < NMU; ++m) if (m < mcnt) { const int r = 4 * (16 * m + fr) + wr;
        if (r < nv) { const int slot = slot0 + r; const float rs = slot_rs[slot];
            if (MODE == 0) {
                float h[8];
#pragma unroll
                for (int n = 0; n < 2; ++n)
#pragma unroll
                    for (int i = 0; i < 4; ++i) { const float g = acc[m][n][i] * rs, up = acc[m][n + 2][i] * rs; h[4 * n + i] = g * __builtin_amdgcn_rcpf(1.0f + __expf(-g)) * up; }
                { u32x4 w; w.x = cvtpk(h[0], h[1]); w.y = cvtpk(h[2], h[3]); w.z = cvtpk(h[4], h[5]); w.w = cvtpk(h[6], h[7]); *(u32x4*)(OUT + (size_t)slot * DFF + 64 * cb + 32 * wc + 8 * fq) = w; }
            } else { const int dst = slot_dst[slot];
#pragma unroll
                for (int n = 0; n < 4; ++n) { const f32x4 v = acc[m][n] * rs; u32x2 w; w.x = cvtpk(v[0], v[1]); w.y = cvtpk(v[2], v[3]); *(u32x2*)(OUT + (size_t)dst * D + 128 * cb + 64 * wc + 16 * n + 4 * fq) = w; } } } }
#undef MU_SA
#undef MU_SB
#undef MU_GLDS_A
#undef MU_B_ISSUE
#undef MU_B_WAIT
#undef MU_B_WRITE
#undef MU_G_LOAD
#undef MU_COMPUTE
#undef MU_COMPUTE_N
#undef MU_RDA
#undef MU_RDB
#undef MU_END
}

constexpr int DR = 320, DRW = 80, DNM = 5, DABYTES = DR * 64 * 2;
__device__ __forceinline__ void moe_down_stream(PG8_LAS unsigned char* lds, int e, int cb0, int slot0, int nv, const bf16_t* HIDp, const float* Wd, bf16_t* Y, const float* slot_w, const int* slot_dst) {
    constexpr int K = 512, NT = 64, RB = 4096 * 4;
    const int tid = threadIdx.x, wid = __builtin_amdgcn_readfirstlane(tid >> 6), lane = tid & 63, wr = wid >> 1, wc = wid & 1, fr = lane & 15, fq = lane >> 4;
    unsigned aoff[5];
#pragma unroll
    for (int i = 0; i < 5; ++i) { int R, C; stage_rc(wid * 1024 + i * 8192 + lane * 16, R, C); const int w4 = R / DRW; int r = 4 * (R - DRW * w4) + w4; r = r < nv ? r : r % nv;
        aoff[i] = ((unsigned)(slot0 + r) * (unsigned)K + (unsigned)C) * 2u; }
    const int c0_ = 2 * lane, R0 = 64 * (c0_ >> 6) + 16 * (2 * ((c0_ >> 5) & 1) + ((c0_ >> 2) & 1)) + 4 * ((c0_ >> 3) & 3) + (c0_ & 3);
    const char* Bb = (const char*)(Wd + (size_t)e * K * 4096 + 128 * cb0 + 2 * lane) + (size_t)(8 * wid) * RB;
    const unsigned bw0 = (unsigned)(R0 * 128 + ((wid ^ ((R0 >> 1) & 7)) * 16)), bw1 = bw0 + 128u;
    const int nvw = (nv - wr + 3) >> 2, mcnt = nvw <= 0 ? 0 : (((nvw + 15) >> 4) > DNM ? DNM : ((nvw + 15) >> 4));
    unsigned amask = 0u;
#pragma unroll
    for (int i = 0; i < 5; ++i) { const int grp = 4 * i + (wid >> 1), w4 = grp / DNM, mf = grp % DNM, nv4 = (nv - w4 + 3) >> 2, mc4 = nv4 <= 0 ? 0 : ((nv4 + 15) >> 4); if (mf < mc4) amask |= 1u << i; }
    int dstv[DNM]; float wv[DNM];
#pragma unroll
    for (int m = 0; m < DNM; ++m) { const int r = 4 * (16 * m + fr) + wr; const bool ok = (m < mcnt) && (16 * m + fr < DRW) && (r < nv); dstv[m] = ok ? slot_dst[slot0 + r] : -1; wv[m] = ok ? slot_w[slot0 + r] : 0.f; }
    asm volatile("s_waitcnt vmcnt(0)" : "+v"(dstv[0]), "+v"(dstv[1]), "+v"(dstv[2]), "+v"(dstv[3]), "+v"(dstv[4]), "+v"(wv[0]), "+v"(wv[1]), "+v"(wv[2]), "+v"(wv[3]), "+v"(wv[4]) :: "memory");
#define MD_SA(b) (lds + (b) * DABYTES)
#define MD_SB(b) (lds + 2 * DABYTES + (b) * BBYTES)
#define MD_GLDS_A(buf, tau) do { _Pragma("unroll") for (int i = 0; i < 5; ++i) if (amask & (1u << i)) \
        __builtin_amdgcn_global_load_lds((const unsigned*)((const char*)HIDp + aoff[i] + (size_t)((tau) & 7) * 128), (PG8_LAS unsigned*)(MD_SA(buf) + wid * 1024 + i * 8192), 16, 0, 0); } while (0)
#define MD_B_ISSUE(sb, tau) do { const char* kb_ = Bb + (size_t)((tau) >> 3) * 512 + (size_t)((tau) & 7) * (64 * (size_t)RB); _Pragma("unroll") for (int j = 0; j < 8; ++j) { const char* p_ = kb_ + (size_t)j * RB; \
        asm volatile("global_load_dwordx2 %0, %1, off" : "=&v"(sb[j]) : "v"(p_) : "memory"); } } while (0)
#define MD_B_WAIT(sb, N) asm volatile("s_waitcnt vmcnt(%8)" : "+v"(sb[0]), "+v"(sb[1]), "+v"(sb[2]), "+v"(sb[3]), "+v"(sb[4]), "+v"(sb[5]), "+v"(sb[6]), "+v"(sb[7]) : "n"(N) : "memory")
#define MD_B_WRITE(sb, buf) do { u32x4 w0_, w1_; w0_.x = cvtpk(sb[0].x, sb[1].x); w0_.y = cvtpk(sb[2].x, sb[3].x); w0_.z = cvtpk(sb[4].x, sb[5].x); w0_.w = cvtpk(sb[6].x, sb[7].x); \
        w1_.x = cvtpk(sb[0].y, sb[1].y); w1_.y = cvtpk(sb[2].y, sb[3].y); w1_.z = cvtpk(sb[4].y, sb[5].y); w1_.w = cvtpk(sb[6].y, sb[7].y); \
        *(PG8_LAS u32x4*)(MD_SB(buf) + bw0) = w0_; *(PG8_LAS u32x4*)(MD_SB(buf) + bw1) = w1_; } while (0)
#define MD_RDA(buf, ks, m) (*(const PG8_LAS bf16x8*)(MD_SA(buf) + lds_byte(DRW * wr + 16 * (m) + fr, 32 * (ks) + 8 * fq)))
#define MD_RDB(buf, ks, n) (*(const PG8_LAS bf16x8*)(MD_SB(buf) + (64 * wc + 16 * (n) + fr) * 128 + (((4 * (ks) + fq) ^ (((64 * wc + 16 * (n) + fr) >> 1) & 7)) * 16)))
#define MD_COMPUTE(buf) do { bf16x8 At[DNM], Bf[4]; \
        _Pragma("unroll") for (int n = 0; n < 4; ++n) Bf[n] = MD_RDB(buf, 0, n); \
        _Pragma("unroll") for (int m = 0; m < DNM; ++m) At[m] = MD_RDA(buf, 0, m); \
        _Pragma("unroll") for (int m = 0; m < DNM; ++m) { _Pragma("unroll") for (int n = 0; n < 4; ++n) acc[m][n] = __builtin_amdgcn_mfma_f32_16x16x32_bf16(Bf[n], At[m], acc[m][n], 0, 0, 0); \
            At[m] = MD_RDA(buf, 1, m); } \
        __builtin_amdgcn_sched_barrier(0); \
        _Pragma("unroll") for (int n = 0; n < 4; ++n) Bf[n] = MD_RDB(buf, 1, n); \
        _Pragma("unroll") for (int m = 0; m < DNM; ++m) { _Pragma("unroll") for (int n = 0; n < 4; ++n) acc[m][n] = __builtin_amdgcn_mfma_f32_16x16x32_bf16(Bf[n], At[m], acc[m][n], 0, 0, 0); } \
        __builtin_amdgcn_sched_barrier(0); } while (0)
#define MD_END(last) do { if (last) asm volatile("s_waitcnt vmcnt(0)" ::: "memory"); else asm volatile("s_waitcnt vmcnt(8)" ::: "memory"); \
        asm volatile("s_waitcnt lgkmcnt(0)" ::: "memory"); __builtin_amdgcn_s_barrier(); asm volatile("" ::: "memory"); } while (0)
    f32x4 acc[DNM][4];
#pragma unroll
    for (int m = 0; m < DNM; ++m)
#pragma unroll
        for (int n = 0; n < 4; ++n) acc[m][n] = (f32x4){0.f, 0.f, 0.f, 0.f};
    f32x2 s0[8], s1[8];
    MD_GLDS_A(0, 0); MD_B_ISSUE(s0, 0); MD_B_ISSUE(s1, 1);
    MD_B_WAIT(s0, 8); MD_B_WRITE(s0, 0); __builtin_amdgcn_sched_barrier(0); MD_B_ISSUE(s0, 2);
    asm volatile("s_waitcnt vmcnt(16)" ::: "memory");
    asm volatile("s_waitcnt lgkmcnt(0)" ::: "memory"); __builtin_amdgcn_s_barrier(); asm volatile("" ::: "memory");
#pragma unroll 1
    for (int t = 0; t < NT; t += 2) {
        if (t + 2 < NT) MD_B_WAIT(s1, 8); else MD_B_WAIT(s1, 0);
        MD_B_WRITE(s1, 1); __builtin_amdgcn_sched_barrier(0); MD_GLDS_A(1, t + 1); __builtin_amdgcn_sched_barrier(0);
        if (t + 3 < NT) MD_B_ISSUE(s1, t + 3);
        MD_COMPUTE(0);
        MD_END(t + 3 >= NT);
        if (t + 2 < NT) { MD_B_WAIT(s0, 8); MD_B_WRITE(s0, 0); __builtin_amdgcn_sched_barrier(0); MD_GLDS_A(0, t + 2); __builtin_amdgcn_sched_barrier(0); }
        if (t + 4 < NT) MD_B_ISSUE(s0, t + 4);
        MD_COMPUTE(1);
        MD_END(t + 4 >= NT);
        if (((t + 1) & 7) == 7) {
            const int cb = cb0 + ((t + 1) >> 3);
#pragma unroll
            for (int m = 0; m < DNM; ++m) { if (dstv[m] >= 0) {
#pragma unroll
                    for (int p = 0; p < 2; ++p) { const f32x4 v0 = acc[m][2 * p] * wv[m], v1 = acc[m][2 * p + 1] * wv[m]; u32x4 w; w.x = cvtpk(v0[0], v0[1]); w.y = cvtpk(v0[2], v0[3]); w.z = cvtpk(v1[0], v1[1]); w.w = cvtpk(v1[2], v1[3]);
                        *(u32x4*)(Y + (size_t)dstv[m] * D + 128 * cb + 64 * wc + 32 * p + 8 * fq) = w; } }
#pragma unroll
                for (int n = 0; n < 4; ++n) acc[m][n] = (f32x4){0.f, 0.f, 0.f, 0.f}; } }
    }
#undef MD_SA
#undef MD_SB
#undef MD_GLDS_A
#undef MD_B_ISSUE
#undef MD_B_WAIT
#undef MD_B_WRITE
#undef MD_COMPUTE
#undef MD_RDA
#undef MD_RDB
#undef MD_END
}
}

constexpr int NWAVES = 8, NTHREADS = 512;
constexpr int N_PHASES = 11;
constexpr int MOE_TAB_OFF = 132096;
struct Args { const void* in[18]; float* out; unsigned char* ws; int ph_lo, ph_hi; };

struct Frame {
    LAS unsigned char* lds;
    int tid, lane, wave, G, bid;
    unsigned char* ws;
    const float *x, *g_mix, *w_in, *w2, *gb, *g_gla, *sinks, *w_out, *g_ffn, *rg_w, *rg_b, *re_w, *re_b, *wg, *wu, *wd, *g_fin;
    const int* pos;
    float* out;
};

template <int MODE>
__device__ __forceinline__ int dest_row(int n, int row_off) {
    if (MODE == 0) return row_off + n;
    if (MODE == 1) return n < 6144 ? n : (n < 6160 ? C_GA + (n - 6144) : n - 16);
    if (MODE == 2) return row_off + 256 * (n >> 7) + (n & 127);
    return row_off + 256 * (n >> 7) + 128 + (n & 127);
}
template <int MODE>
__device__ __forceinline__ void transpose_item(const float* W, int K, int N, bf16_t* WT, int row_off, LAS float* scr, int item, int lane) {
    const int nblk = (N + 31) / 32, nb = (item >> 3) % nblk, kb = (item & 7) + 8 * (item / (8 * nblk)), k0 = 64 * kb, n0 = 32 * nb;
    const bool nok = (n0 + (lane & 31)) < N;
    float tv[32];
#pragma unroll
    for (int i = 0; i < 32; ++i) { const int kk = 2 * i + (lane >> 5); tv[i] = nok ? W[(size_t)(k0 + kk) * N + n0 + (lane & 31)] : 0.f; }
#pragma unroll
    for (int i = 0; i < 32; ++i) { const int kk = 2 * i + (lane >> 5); scr[kk * 33 + (lane & 31)] = tv[i]; }
    LDS_WAIT(); asm volatile("" ::: "memory");
    const int c = lane & 7;
#pragma unroll
    for (int j = 0; j < 4; ++j) { const int n = (lane >> 3) + 8 * j; const LAS float* s = scr + (8 * c) * 33 + n;
        u32x4 o; o.x = pk2(s[0 * 33], s[1 * 33]); o.y = pk2(s[2 * 33], s[3 * 33]); o.z = pk2(s[4 * 33], s[5 * 33]); o.w = pk2(s[6 * 33], s[7 * 33]);
        if (n0 + n < N) *(u32x4*)(WT + (size_t)dest_row<MODE>(n0 + n, row_off) * K + k0 + 8 * c) = o; }
    LDS_WAIT(); asm volatile("" ::: "memory");
}
__device__ __forceinline__ void rms_row_to_bf16(int lane, const float* xrow, const float* g, bf16_t* orow) {
    const f32x4* xr = (const f32x4*)xrow + lane; const f32x4* gr = (const f32x4*)g + lane;
    f32x4 v[16]; float s = 0.f;
#pragma unroll
    for (int j = 0; j < 16; ++j) { v[j] = xr[64 * j]; s += (v[j].x * v[j].x + v[j].y * v[j].y) + (v[j].z * v[j].z + v[j].w * v[j].w); }
    const float rstd = 1.0f / sqrtf(wave_sum(s) * (1.f / D) + RMS_EPS);
    u32x2* o8 = (u32x2*)orow + lane;
#pragma unroll
    for (int j = 0; j < 16; ++j) { const f32x4 gg = gr[64 * j]; u32x2 w; w.x = pk2(v[j].x * rstd * gg.x, v[j].y * rstd * gg.y); w.y = pk2(v[j].z * rstd * gg.z, v[j].w * rstd * gg.w); o8[64 * j] = w; }
}

__device__ __forceinline__ void p0_prologue(Frame& F) {
    LAS float* scr = (LAS float*)(F.lds + F.wave * 16384);
    const int gw = F.bid * NWAVES + F.wave, NGW = F.G * NWAVES;
    bf16_t* WIN = (bf16_t*)(F.ws + WS_WIN); bf16_t* WOUT = (bf16_t*)(F.ws + WS_WOUT); bf16_t* WGU = (bf16_t*)(F.ws + WS_WGU); bf16_t* WD = (bf16_t*)(F.ws + WS_WD);
    constexpr int I_IN = 64 * 273, I_OUT = 64 * 128, I_G = 64 * 16, I_DN = 8 * 128;
    for (int it = gw; it < I_IN; it += NGW) transpose_item<1>(F.w_in, D, IN_COLS, WIN, 0, scr, it, F.lane);
    for (int it = gw; it < I_OUT; it += NGW) transpose_item<0>(F.w_out, D, D, WOUT, 0, scr, it, F.lane);

    { u32x4* z = (u32x4*)(WIN + (size_t)IN_COLS * D); const size_t n16 = (size_t)(LDP - IN_COLS) * D * 2 / 16;
      for (size_t i = (size_t)F.bid * NTHREADS + F.tid; i < n16; i += (size_t)F.G * NTHREADS) z[i] = (u32x4){0u, 0u, 0u, 0u}; }
    { bf16_t* RBH = (bf16_t*)(F.ws + WS_RB); bf16_t* RBL = RBH + 80 * D;
      for (int i = F.bid * NTHREADS + F.tid; i < 80 * D; i += F.G * NTHREADS) { const int c = i / D, k = i % D;
          float v = 0.f; if (c < 8) v = F.rg_w[k * 8 + c]; else if (c < 72) { const int g = (c - 8) >> 3, j = (c - 8) & 7; v = F.re_w[((size_t)g * D + k) * 8 + j]; }
          const unsigned h = f2bf(v); const float hf = __builtin_bit_cast(float, h << 16); RBH[i] = (bf16_t)h; RBL[i] = (bf16_t)f2bf(v - hf); } }
    { float* RC = (float*)(F.ws + WS_ROPE); float* RS = RC + M * 32;
      for (int i = F.bid * NTHREADS + F.tid; i < M * 32; i += F.G * NTHREADS) { const int m = i >> 5, j = i & 31;
          const float inv = exp2f(-(float)j * (13.287712379549449f / 32.0f));
          const float angf = (float)F.pos[m] * inv;
          const double a = (double)angf; const double tr = a * 0.15915494309189535; const double fr = tr - __builtin_rint(tr);
          const float r = (float)(fr * 6.283185307179586);
          RC[i] = cosf(r); RS[i] = sinf(r); } }
    { bf16_t* U = (bf16_t*)(F.ws + WS_U);
      for (int m = gw; m < M; m += NGW) rms_row_to_bf16(F.lane, F.x + (size_t)m * D, F.g_mix, U + (size_t)m * D); }
}

__device__ __forceinline__ int crow(int r, int hi) { return (r & 3) + 8 * (r >> 2) + 4 * hi; }
constexpr int SWA_KROW = 144;
__device__ __forceinline__ void rot8(const u32x4 x1, const u32x4 x2, const f32x4 c0, const f32x4 c1, const f32x4 s0, const f32x4 s1, float sc, u32x4& o1, u32x4& o2) {
    const unsigned a[4] = {x1.x, x1.y, x1.z, x1.w}, b[4] = {x2.x, x2.y, x2.z, x2.w};
    const float c[8] = {c0.x, c0.y, c0.z, c0.w, c1.x, c1.y, c1.z, c1.w}, s[8] = {s0.x, s0.y, s0.z, s0.w, s1.x, s1.y, s1.z, s1.w};
    unsigned r1[4], r2[4];
#pragma unroll
    for (int j = 0; j < 4; ++j) { const float a0 = bflo(a[j]), a1 = bfhi(a[j]), b0 = bflo(b[j]), b1 = bfhi(b[j]);
        r1[j] = cvtpk((a0 * c[2 * j] - b0 * s[2 * j]) * sc, (a1 * c[2 * j + 1] - b1 * s[2 * j + 1]) * sc);
        r2[j] = cvtpk((b0 * c[2 * j] + a0 * s[2 * j]) * sc, (b1 * c[2 * j + 1] + a1 * s[2 * j + 1]) * sc); }
    o1 = (u32x4){r1[0], r1[1], r1[2], r1[3]}; o2 = (u32x4){r2[0], r2[1], r2[2], r2[3]};
}
__device__ __forceinline__ void swa_unit(Frame& F, int b, int kvh, int qb) {
    const bf16_t* PROJ = (const bf16_t*)(F.ws + WS_PROJ); bf16_t* MIX = (bf16_t*)(F.ws + WS_MIX);
    const float* RC = (const float*)(F.ws + WS_ROPE); const float* RS = RC + M * 32;
    LAS unsigned char* Kl = F.lds; LAS unsigned char* Vl = F.lds + 192 * SWA_KROW;
    LAS float* wsf = (LAS float*)(F.lds + 2 * 192 * SWA_KROW) + F.wave * 64;
    LAS bf16_t* stg = (LAS bf16_t*)(F.lds + 2 * 192 * SWA_KROW + 2048) + F.wave * 2048;
    const int tid = F.tid, lane = F.lane, r32 = lane & 31, hi = lane >> 5;
    const int K0 = 64 * (qb - 2);
    const size_t rowb = (size_t)b * SEQ;
    for (int task = tid; task < 768; task += NTHREADS) { const int key = task >> 2, c = task & 3, kg = K0 + key;
        u32x4 o1 = (u32x4){0u, 0u, 0u, 0u}, o2 = o1;
        if (kg >= 0) { const bf16_t* src = PROJ + (rowb + kg) * LDP + C_SK + kvh * 64; const u32x4 x1 = *(const u32x4*)(src + 8 * c), x2 = *(const u32x4*)(src + 32 + 8 * c);
            const float* cs = RC + (rowb + kg) * 32 + 8 * c; const float* sn = RS + (rowb + kg) * 32 + 8 * c;
            rot8(x1, x2, *(const f32x4*)cs, *(const f32x4*)(cs + 4), *(const f32x4*)sn, *(const f32x4*)(sn + 4), 1.0f, o1, o2); }
        *(LAS u32x4*)(Kl + key * SWA_KROW + 16 * c) = o1; *(LAS u32x4*)(Kl + key * SWA_KROW + 64 + 16 * c) = o2; }
    for (int task = tid; task < 1536; task += NTHREADS) { const int key = task >> 3, c = task & 7, kg = K0 + key;
        u32x4 v = (u32x4){0u, 0u, 0u, 0u};
        if (kg >= 0) v = *(const u32x4*)(PROJ + (rowb + kg) * LDP + C_SV + kvh * 64 + 8 * c);
        *(LAS u32x4*)(Vl + key * SWA_KROW + 16 * c) = v; }
    __syncthreads();
    const int qh = kvh * 8 + F.wave;
    const float sink2 = F.sinks[qh] * 1.4426950408889634f;
#pragma unroll 1
    for (int sub = 0; sub < 2; ++sub) {
        const int qg = 64 * qb + 32 * sub + r32;
        bf16x8 qr[4];
        { const bf16_t* qsrc = PROJ + (rowb + qg) * LDP + C_SQ + qh * 64 + 8 * hi;
          const u32x4 x0 = *(const u32x4*)(qsrc), x1 = *(const u32x4*)(qsrc + 16), x2 = *(const u32x4*)(qsrc + 32), x3 = *(const u32x4*)(qsrc + 48);
          const float* cs = RC + (rowb + qg) * 32 + 8 * hi; const float* sn = RS + (rowb + qg) * 32 + 8 * hi;
          u32x4 o0, o1, o2, o3; const float sc = 0.125f * 1.4426950408889634f;
          rot8(x0, x2, *(const f32x4*)cs, *(const f32x4*)(cs + 4), *(const f32x4*)sn, *(const f32x4*)(sn + 4), sc, o0, o2);
          rot8(x1, x3, *(const f32x4*)(cs + 16), *(const f32x4*)(cs + 20), *(const f32x4*)(sn + 16), *(const f32x4*)(sn + 20), sc, o1, o3);
          qr[0] = __builtin_bit_cast(bf16x8, o0); qr[1] = __builtin_bit_cast(bf16x8, o1); qr[2] = __builtin_bit_cast(bf16x8, o2); qr[3] = __builtin_bit_cast(bf16x8, o3); }
        f32x16 p[5];
#pragma unroll
        for (int j = 0; j < 5; ++j) {
#pragma unroll
            for (int r = 0; r < 16; ++r) p[j][r] = 0.f;
#pragma unroll
            for (int d0 = 0; d0 < 4; ++d0) { const bf16x8 kf = *(const LAS bf16x8*)(Kl + (32 * sub + 32 * j + r32) * SWA_KROW + (16 * d0 + 8 * hi) * 2);
                p[j] = __builtin_amdgcn_mfma_f32_32x32x16_bf16(kf, qr[d0], p[j], 0, 0, 0); } }
        const int kneg = -(K0 + 32 * sub);
        const float NEG = -INFINITY;
#pragma unroll
        for (int j = 0; j < 5; ++j)
#pragma unroll
            for (int r = 0; r < 16; ++r) { const int c = crow(r, hi); bool ok = (32 * j >= kneg);
                if (j == 0) ok = ok && (c > r32); if (j == 4) ok = ok && (c <= r32);
                p[j][r] = ok ? p[j][r] : NEG; }
        float mx = sink2;
#pragma unroll
        for (int j = 0; j < 5; ++j)
#pragma unroll
            for (int r = 0; r < 16; ++r) mx = fmaxf(mx, p[j][r]);
        mx = fmaxf(mx, __shfl_xor(mx, 32));
        float sum = 0.f;
#pragma unroll
        for (int j = 0; j < 5; ++j)
#pragma unroll
            for (int r = 0; r < 16; ++r) { p[j][r] = __builtin_amdgcn_exp2f(p[j][r] - mx); sum += p[j][r]; }
        sum += __shfl_xor(sum, 32);
        sum += __builtin_amdgcn_exp2f(sink2 - mx);
        f32x16 o[2];
#pragma unroll
        for (int r = 0; r < 16; ++r) { o[0][r] = 0.f; o[1][r] = 0.f; }
        const int vrow0 = 32 * sub + 4 * hi + ((lane & 15) >> 2), vcol = ((lane >> 4) & 1) * 32 + (lane & 3) * 8;
#pragma unroll
        for (int j = 0; j < 5; ++j)
#pragma unroll
            for (int s = 0; s < 2; ++s) {
                u32x4 pw; pw.x = cvtpk(p[j][8 * s], p[j][8 * s + 1]); pw.y = cvtpk(p[j][8 * s + 2], p[j][8 * s + 3]); pw.z = cvtpk(p[j][8 * s + 4], p[j][8 * s + 5]); pw.w = cvtpk(p[j][8 * s + 6], p[j][8 * s + 7]);
                const bf16x8 pa = __builtin_bit_cast(bf16x8, pw);
#pragma unroll
                for (int d0 = 0; d0 < 2; ++d0) { const LAS unsigned char* vp = Vl + (vrow0 + 32 * j + 16 * s) * SWA_KROW + d0 * 64 + vcol;
                    const s16x4 lo = __builtin_bit_cast(s16x4, __builtin_amdgcn_ds_read_tr16_b64_v4i16((LAS s16x4*)vp));
                    const s16x4 hh = __builtin_bit_cast(s16x4, __builtin_amdgcn_ds_read_tr16_b64_v4i16((LAS s16x4*)(vp + 8 * SWA_KROW)));
                    const bf16x8 vf = (bf16x8){lo[0], lo[1], lo[2], lo[3], hh[0], hh[1], hh[2], hh[3]};
                    o[d0] = __builtin_amdgcn_mfma_f32_32x32x16_bf16(pa, vf, o[d0], 0, 0, 0); } }
        if (hi == 0) wsf[r32] = 1.0f / sum;
        LDS_WAIT();
#pragma unroll
        for (int r = 0; r < 16; ++r) { const int orow = crow(r, hi); const float rl = wsf[orow];
#pragma unroll
            for (int d0 = 0; d0 < 2; ++d0) stg[orow * 64 + d0 * 32 + r32] = (bf16_t)f2bf(o[d0][r] * rl); }
        LDS_WAIT();
#pragma unroll
        for (int i = 0; i < 4; ++i) { const int row = i * 8 + (lane >> 3), ch = lane & 7; const u32x4 v = *(const LAS u32x4*)(stg + row * 64 + ch * 8);
            *(u32x4*)(MIX + (rowb + 64 * qb + 32 * sub + row) * D + 2048 + qh * 64 + ch * 8) = v; }
        LDS_WAIT();
    }
    __syncthreads();
}

constexpr int GP_ROW = 136;
__device__ __forceinline__ void gla_prep_unit(Frame& F, int unit) {
    const int bh = unit >> 7, n = unit & 127, b = bh >> 3, h = bh & 7, tid = F.tid, lane = F.lane;
    const bf16_t* PROJ = (const bf16_t*)(F.ws + WS_PROJ);
    bf16_t* QIN = (bf16_t*)(F.ws + WS_QIN) + (size_t)unit * 64 * 128; bf16_t* KDT = (bf16_t*)(F.ws + WS_KDT) + (size_t)unit * 128 * 64;
    bf16_t* AM = (bf16_t*)(F.ws + WS_AM) + (size_t)unit * 64 * 64; float* DEC = (float*)(F.ws + WS_DEC) + (size_t)unit * 128;
    LAS float* gaS = (LAS float*)F.lds; LAS float* tot = gaS + 1024; LAS bf16_t* qinS = (LAS bf16_t*)(F.lds + 8192); LAS bf16_t* kinS = qinS + 64 * GP_ROW;
    const size_t m0 = (size_t)b * SEQ + 64 * n;
    const int d = tid & 127, cg = tid >> 7;
    bf16_t qv[16], kv[16];
#pragma unroll
    for (int i = 0; i < 16; ++i) { const bf16_t* pr = PROJ + (m0 + cg * 16 + i) * LDP + h * 128 + d; qv[i] = pr[C_GQ]; kv[i] = pr[C_GK]; }
    { const int c = tid >> 3, r2 = (tid & 7) * 2; const unsigned w = *(const unsigned*)(PROJ + (m0 + c) * LDP + C_GA + r2); gaS[c * 16 + r2] = bflo(w); gaS[c * 16 + r2 + 1] = bfhi(w); }
    float w2r[16];
#pragma unroll
    for (int r = 0; r < 16; ++r) w2r[r] = F.w2[r * 1024 + h * 128 + d];
    const float bias = F.gb[h * 128 + d];
    __syncthreads();
    float bl[16]; float run = 0.f;
#pragma unroll
    for (int i = 0; i < 16; ++i) { const int c = cg * 16 + i; float z = bias;
#pragma unroll
        for (int r4 = 0; r4 < 4; ++r4) { const f32x4 g4 = *(const LAS f32x4*)(gaS + c * 16 + 4 * r4); z += g4.x * w2r[4 * r4] + g4.y * w2r[4 * r4 + 1] + g4.z * w2r[4 * r4 + 2] + g4.w * w2r[4 * r4 + 3]; }
        const float ls = fminf(z, 0.f) - __logf(1.0f + __expf(-fabsf(z)));
        run += ls * (1.f / 16.f); bl[i] = run; }
    tot[cg * 128 + d] = run;
    __syncthreads();
    float offs = 0.f, blast = 0.f;
#pragma unroll
    for (int g = 0; g < 4; ++g) { const float t = tot[g * 128 + d]; blast += t; if (g < cg) offs += t; }
    const float eblast = __expf(blast);
    unsigned kd[8];
#pragma unroll
    for (int i = 0; i < 16; i += 2) { float kdv[2];
#pragma unroll
        for (int u = 0; u < 2; ++u) { const int c = cg * 16 + i + u; const float bb = bl[i + u] + offs;
            const float q = bf2f(qv[i + u]) * 0.08838834764831845f, k = bf2f(kv[i + u]);
            const float eb = __expf(bb), einv = __builtin_amdgcn_rcpf(eb);
            const float qin = q * eb, kin = k * einv; kdv[u] = kin * eblast;
            const bf16_t qb16 = (bf16_t)f2bf(qin); qinS[c * GP_ROW + d] = qb16; kinS[c * GP_ROW + d] = (bf16_t)f2bf(kin); QIN[c * 128 + d] = qb16; }
        kd[i >> 1] = pk2(kdv[0], kdv[1]); }
    *(u32x4*)(KDT + d * 64 + cg * 16) = (u32x4){kd[0], kd[1], kd[2], kd[3]}; *(u32x4*)(KDT + d * 64 + cg * 16 + 8) = (u32x4){kd[4], kd[5], kd[6], kd[7]};
    if (cg == 0) DEC[d] = eblast;
    __syncthreads();
    { const int mi = F.wave >> 1, fr = lane & 15, fq = lane >> 4;
#pragma unroll
      for (int t = 0; t < 2; ++t) { const int ni = 2 * (F.wave & 1) + t; f32x4 acc = (f32x4){0.f, 0.f, 0.f, 0.f};
          if (ni <= mi) {
#pragma unroll
              for (int ks = 0; ks < 4; ++ks) { const bf16x8 kf = *(const LAS bf16x8*)(kinS + (16 * ni + fr) * GP_ROW + 32 * ks + 8 * fq), qf = *(const LAS bf16x8*)(qinS + (16 * mi + fr) * GP_ROW + 32 * ks + 8 * fq);
                  acc = __builtin_amdgcn_mfma_f32_16x16x32_bf16(kf, qf, acc, 0, 0, 0); } }
          const int c = 16 * mi + fr, j0 = 16 * ni + 4 * fq; float v[4];
#pragma unroll
          for (int i = 0; i < 4; ++i) v[i] = (j0 + i <= c) ? acc[i] : 0.f;
          u32x2 w; w.x = pk2(v[0], v[1]); w.y = pk2(v[2], v[3]); *(u32x2*)(AM + c * 64 + j0) = w; } }
    __syncthreads();
}

constexpr int GS_AM = 0, GS_QIN = 8192, GS_KDT = 24576, GS_V = 40960, GS_DEC = 43008, GS_SLOT = 44032;
constexpr int GS_SB = 3 * GS_SLOT, GS_SBROW = 272, GS_SBBUF = 16 * GS_SBROW;
__device__ __forceinline__ void gs_load(Frame& F, int bh, int et, int n, int slot) {
    const int lane = F.lane, unit = bh * 128 + n, b = bh >> 3, h = bh & 7, wave = F.wave;
    LAS unsigned char* base = F.lds + slot * GS_SLOT;
    if (wave >= 1 && wave <= 4) { const int m = wave - 1;
        const char* am = (const char*)(F.ws + WS_AM) + (size_t)unit * 8192; const char* qin = (const char*)(F.ws + WS_QIN) + (size_t)unit * 16384;
#pragma unroll
        for (int i = 0; i < 2; ++i) { const int r = 16 * m + i * 8 + (lane >> 3), ch = (lane & 7) ^ (r & 7);
            __builtin_amdgcn_global_load_lds((const unsigned*)(am + r * 128 + ch * 16), (LAS unsigned*)(base + GS_AM + (2 * m + i) * 1024), 16, 0, 0); }
#pragma unroll
        for (int i = 0; i < 4; ++i) { const int r = 16 * m + i * 4 + (lane >> 4), ch = (lane & 15) ^ (r & 15);
            __builtin_amdgcn_global_load_lds((const unsigned*)(qin + r * 256 + ch * 16), (LAS unsigned*)(base + GS_QIN + (4 * m + i) * 1024), 16, 0, 0); }
    } else if (wave == 5 || wave == 6) { const char* kdt = (const char*)(F.ws + WS_KDT) + (size_t)unit * 16384; const int i0 = (wave - 5) * 8;
#pragma unroll
        for (int i = 0; i < 8; ++i) { const int r = (i0 + i) * 8 + (lane >> 3), ch = (lane & 7) ^ (r & 7);
            __builtin_amdgcn_global_load_lds((const unsigned*)(kdt + r * 128 + ch * 16), (LAS unsigned*)(base + GS_KDT + (i0 + i) * 1024), 16, 0, 0); }
    } else if (wave == 7) { const char* dec = (const char*)(F.ws + WS_DEC) + (size_t)unit * 512;
        const char* v = (const char*)((const bf16_t*)(F.ws + WS_PROJ) + ((size_t)b * SEQ + 64 * n) * LDP + C_GV + h * 256 + et * 16);
#pragma unroll
        for (int i = 0; i < 2; ++i) { const int r = i * 32 + (lane >> 1);
            __builtin_amdgcn_global_load_lds((const unsigned*)(v + (size_t)r * LDP * 2 + (lane & 1) * 16), (LAS unsigned*)(base + GS_V + i * 1024), 16, 0, 0); }
        __builtin_amdgcn_global_load_lds((const unsigned*)(dec + (lane & 31) * 16), (LAS unsigned*)(base + GS_DEC), 16, 0, 0);
    }
}
__device__ __forceinline__ void gs_vfrag(const LAS unsigned char* vbase, int lane, bf16x8 (&vf)[2]) {
    const unsigned a = (unsigned)(uintptr_t)(vbase + (8 * (lane >> 4) + ((lane & 15) >> 2)) * 32 + (lane & 3) * 8);
    s16x4 r0, r1, r2, r3;
    asm volatile("ds_read_b64_tr_b16 %0, %4\n\tds_read_b64_tr_b16 %1, %4 offset:128\n\tds_read_b64_tr_b16 %2, %4 offset:1024\n\tds_read_b64_tr_b16 %3, %4 offset:1152\n\ts_waitcnt lgkmcnt(0)"
                 : "=&v"(r0), "=&v"(r1), "=&v"(r2), "=&v"(r3) : "v"(a) : "memory");
    vf[0] = (bf16x8){r0[0], r0[1], r0[2], r0[3], r1[0], r1[1], r1[2], r1[3]}; vf[1] = (bf16x8){r2[0], r2[1], r2[2], r2[3], r3[0], r3[1], r3[2], r3[3]};
}
__device__ __forceinline__ void gs_wait_older(int wave, bool first) {
    if (wave >= 1 && wave <= 4) { if (first) asm volatile("s_waitcnt vmcnt(6)" ::: "memory"); else asm volatile("s_waitcnt vmcnt(14)" ::: "memory"); }
    else if (wave == 5 || wave == 6) asm volatile("s_waitcnt vmcnt(8)" ::: "memory");
    else if (wave == 7) asm volatile("s_waitcnt vmcnt(3)" ::: "memory");
}
__device__ __forceinline__ void gla_scan_chain(Frame& F, int chain) {
    const int bh = chain >> 4, et = chain & 15, b = bh >> 3, h = bh & 7, lane = F.lane, fr = lane & 15, fq = lane >> 4, wave = F.wave;
    bf16_t* ORAW = (bf16_t*)(F.ws + WS_ORAW);
    f32x4 S[8];
#pragma unroll
    for (int i = 0; i < 8; ++i) S[i] = (f32x4){0.f, 0.f, 0.f, 0.f};
    if (wave >= 1) { gs_load(F, bh, et, 0, 0); gs_load(F, bh, et, 1, 1); gs_wait_older(wave, true); }
    if (wave == 0) { for (int i = lane; i < GS_SBBUF / 16; i += 64) *(LAS u32x4*)(F.lds + GS_SB + i * 16) = (u32x4){0u, 0u, 0u, 0u}; }
    asm volatile("s_waitcnt lgkmcnt(0)" ::: "memory"); __builtin_amdgcn_s_barrier(); asm volatile("" ::: "memory");
#pragma unroll 1
    for (int n = 0; n < 128; ++n) {
        const LAS unsigned char* base = F.lds + (n % 3) * GS_SLOT;
        if (wave >= 1 && n + 2 < 128) gs_load(F, bh, et, n + 2, (n + 2) % 3);
        if (wave == 0) {
            bf16x8 vf[2]; gs_vfrag(base + GS_V, lane, vf);
            bf16x8 kf[8][2]; f32x4 dc[8];
#pragma unroll
            for (int mt = 0; mt < 8; ++mt) { const int r = 16 * mt + fr; dc[mt] = *(const LAS f32x4*)(base + GS_DEC + (16 * mt + 4 * fq) * 4);
#pragma unroll
                for (int ks = 0; ks < 2; ++ks) kf[mt][ks] = *(const LAS bf16x8*)(base + GS_KDT + r * 128 + (((4 * ks + fq) ^ (r & 7)) * 16)); }
            __builtin_amdgcn_sched_barrier(0);
            LAS unsigned char* sb = F.lds + GS_SB + ((n + 1) & 1) * GS_SBBUF + fr * GS_SBROW + 8 * fq;
#pragma unroll
            for (int mt = 0; mt < 8; ++mt) { f32x4 s = S[mt] * dc[mt];
                s = __builtin_amdgcn_mfma_f32_16x16x32_bf16(kf[mt][0], vf[0], s, 0, 0, 0); s = __builtin_amdgcn_mfma_f32_16x16x32_bf16(kf[mt][1], vf[1], s, 0, 0, 0); S[mt] = s; }
#pragma unroll
            for (int mt = 0; mt < 8; ++mt) { u32x2 w; w.x = cvtpk(S[mt][0], S[mt][1]); w.y = cvtpk(S[mt][2], S[mt][3]); *(LAS u32x2*)(sb + 32 * mt) = w; }
        } else if (wave <= 4) {
            const int m = wave - 1, r = 16 * m + fr;
            bf16x8 vf[2]; gs_vfrag(base + GS_V, lane, vf);
            const LAS unsigned char* sb = F.lds + GS_SB + (n & 1) * GS_SBBUF + fr * GS_SBROW + 16 * fq;
            bf16x8 af[2], qf[4], sf[4];
#pragma unroll
            for (int ks = 0; ks < 2; ++ks) af[ks] = *(const LAS bf16x8*)(base + GS_AM + r * 128 + (((4 * ks + fq) ^ (r & 7)) * 16));
#pragma unroll
            for (int ks = 0; ks < 4; ++ks) { qf[ks] = *(const LAS bf16x8*)(base + GS_QIN + r * 256 + (((4 * ks + fq) ^ (r & 15)) * 16)); sf[ks] = *(const LAS bf16x8*)(sb + 64 * ks); }
            __builtin_amdgcn_sched_barrier(0);
            f32x4 acc = (f32x4){0.f, 0.f, 0.f, 0.f};
#pragma unroll
            for (int ks = 0; ks < 2; ++ks) acc = __builtin_amdgcn_mfma_f32_16x16x32_bf16(af[ks], vf[ks], acc, 0, 0, 0);
#pragma unroll
            for (int ks = 0; ks < 4; ++ks) acc = __builtin_amdgcn_mfma_f32_16x16x32_bf16(qf[ks], sf[ks], acc, 0, 0, 0);
            bf16_t* op = ORAW + ((size_t)b * SEQ + 64 * n + 16 * m + 4 * fq) * 2048 + h * 256 + et * 16 + fr;
#pragma unroll
            for (int i = 0; i < 4; ++i) op[(size_t)i * 2048] = (bf16_t)f2bf(acc[i]);
        }
        if (wave >= 1) { if (n + 2 < 128) gs_wait_older(wave, false); else asm volatile("s_waitcnt vmcnt(0)" ::: "memory"); }
        asm volatile("s_waitcnt lgkmcnt(0)" ::: "memory"); __builtin_amdgcn_s_barrier(); asm volatile("" ::: "memory");
    }
    asm volatile("s_waitcnt vmcnt(0) lgkmcnt(0)" ::: "memory");
}
__device__ __forceinline__ void gla_norm(Frame& F) {
    const bf16_t* PROJ = (const bf16_t*)(F.ws + WS_PROJ); const bf16_t* ORAW = (const bf16_t*)(F.ws + WS_ORAW); bf16_t* MIX = (bf16_t*)(F.ws + WS_MIX);
    const int gw = F.bid * NWAVES + F.wave, NGW = F.G * NWAVES, lane = F.lane;
    const int col = 8 * (lane & 31);
    const f32x4 gn0 = *(const f32x4*)(F.g_gla + col), gn1 = *(const f32x4*)(F.g_gla + col + 4);
    const float gn[8] = {gn0.x, gn0.y, gn0.z, gn0.w, gn1.x, gn1.y, gn1.z, gn1.w};
    for (int m = gw; m < M; m += NGW) {
        u32x4 ow[4], gw4[4];
#pragma unroll
        for (int j = 0; j < 4; ++j) { const int hc = (2 * j + (lane >> 5)) * 256 + col; ow[j] = *(const u32x4*)(ORAW + (size_t)m * 2048 + hc); gw4[j] = *(const u32x4*)(PROJ + (size_t)m * LDP + C_GR + hc); }
#pragma unroll
        for (int j = 0; j < 4; ++j) { const unsigned a[4] = {ow[j].x, ow[j].y, ow[j].z, ow[j].w}, g[4] = {gw4[j].x, gw4[j].y, gw4[j].z, gw4[j].w};
            float o[8], ss = 0.f;
#pragma unroll
            for (int i = 0; i < 4; ++i) { o[2 * i] = bflo(a[i]); o[2 * i + 1] = bfhi(a[i]); ss += o[2 * i] * o[2 * i] + o[2 * i + 1] * o[2 * i + 1]; }
#pragma unroll
            for (int s = 1; s < 32; s <<= 1) ss += __shfl_xor(ss, s);
            const float rstd = 1.0f / sqrtf(ss * (1.f / 256.f) + RMS_EPS);
            unsigned w[4];
#pragma unroll
            for (int i = 0; i < 4; ++i) { const float g0 = bflo(g[i]), g1 = bfhi(g[i]);
                w[i] = pk2(o[2 * i] * rstd * gn[2 * i] * (g0 / (1.f + __expf(-g0))), o[2 * i + 1] * rstd * gn[2 * i + 1] * (g1 / (1.f + __expf(-g1)))); }
            *(u32x4*)(MIX + (size_t)m * D + (2 * j + (lane >> 5)) * 256 + col) = (u32x4){w[0], w[1], w[2], w[3]}; }
    }
}

struct RtLoad { u32x4 x[2]; f32x4 g[2]; };
struct RtW { bf16x8 wh[5], wl[5]; };
__device__ __forceinline__ void rt_load(RtLoad& L, const bf16_t* h0, const bf16_t* h1, const float* gp, int ko) {
    L.x[0] = *(const u32x4*)(h0 + ko); L.x[1] = *(const u32x4*)(h1 + ko);
    L.g[0] = *(const f32x4*)(gp + ko); L.g[1] = *(const f32x4*)(gp + ko + 4);
}
__device__ __forceinline__ void rt_step(const RtLoad& L, const bf16_t* bh, const bf16_t* bl, f32x4 (&acc)[2][5], float (&ss)[2], int ko) {
    RtW W;
#pragma unroll
    for (int n = 0; n < 5; ++n) { W.wh[n] = *(const bf16x8*)(bh + (size_t)n * 16 * D + ko); W.wl[n] = *(const bf16x8*)(bl + (size_t)n * 16 * D + ko); }
    bf16x8 ahi[2], alo[2];
#pragma unroll
    for (int mi = 0; mi < 2; ++mi) { const u32x4 xw = L.x[mi]; const f32x4 xa = (f32x4){bflo(xw.x), bfhi(xw.x), bflo(xw.y), bfhi(xw.y)}, xb = (f32x4){bflo(xw.z), bfhi(xw.z), bflo(xw.w), bfhi(xw.w)};
        ss[mi] += (xa.x * xa.x + xa.y * xa.y) + (xa.z * xa.z + xa.w * xa.w) + (xb.x * xb.x + xb.y * xb.y) + (xb.z * xb.z + xb.w * xb.w);
        const float u[8] = {xa.x * L.g[0].x, xa.y * L.g[0].y, xa.z * L.g[0].z, xa.w * L.g[0].w, xb.x * L.g[1].x, xb.y * L.g[1].y, xb.z * L.g[1].z, xb.w * L.g[1].w};
        unsigned hb[8]; float lo[8];
#pragma unroll
        for (int j = 0; j < 8; ++j) { hb[j] = f2bf(u[j]); lo[j] = u[j] - __builtin_bit_cast(float, hb[j] << 16); }
        const u32x4 hw = (u32x4){hb[0] | (hb[1] << 16), hb[2] | (hb[3] << 16), hb[4] | (hb[5] << 16), hb[6] | (hb[7] << 16)};
        const u32x4 lw = (u32x4){pk2(lo[0], lo[1]), pk2(lo[2], lo[3]), pk2(lo[4], lo[5]), pk2(lo[6], lo[7])};
        ahi[mi] = __builtin_bit_cast(bf16x8, hw); alo[mi] = __builtin_bit_cast(bf16x8, lw); }
#pragma unroll
    for (int n = 0; n < 5; ++n)
#pragma unroll
        for (int mi = 0; mi < 2; ++mi) { acc[mi][n] = __builtin_amdgcn_mfma_f32_16x16x32_bf16(ahi[mi], W.wh[n], acc[mi][n], 0, 0, 0);
            acc[mi][n] = __builtin_amdgcn_mfma_f32_16x16x32_bf16(alo[mi], W.wh[n], acc[mi][n], 0, 0, 0);
            acc[mi][n] = __builtin_amdgcn_mfma_f32_16x16x32_bf16(ahi[mi], W.wl[n], acc[mi][n], 0, 0, 0); }
}
__device__ __forceinline__ void p5_router(Frame& F) {
    const bf16_t* H = (const bf16_t*)(F.ws + WS_HB);
    const bf16_t* RBH = (const bf16_t*)(F.ws + WS_RB); const bf16_t* RBL = RBH + 80 * D;
    unsigned* ctl = (unsigned*)(F.ws + WS_CTL);
    LAS float* part = (LAS float*)F.lds;
    LAS float* lg = part + 4 * 64 * 80;
    LAS float* ssp = lg + 64 * 80;
    LAS float* rs = ssp + 256;
    const int lane = F.lane, wave = F.wave;
    for (int tile = F.bid; tile < M / 64; tile += F.G) {
        const int m0 = tile * 64;
        { const int tg = wave & 1, kq = wave >> 1, fr = lane & 15, fq = lane >> 4;
          f32x4 acc[2][5];
#pragma unroll
          for (int a = 0; a < 2; ++a)
#pragma unroll
              for (int n = 0; n < 5; ++n) acc[a][n] = (f32x4){0.f, 0.f, 0.f, 0.f};
          float ss[2] = {0.f, 0.f};
          const size_t roff = (size_t)(m0 + 32 * tg + fr) * D + kq * 1024 + 8 * fq;
          const bf16_t* h0 = H + roff; const bf16_t* h1 = h0 + (size_t)16 * D;
          const float* gp = F.g_ffn + kq * 1024 + 8 * fq;
          const bf16_t* bh = RBH + (size_t)fr * D + kq * 1024 + 8 * fq; const bf16_t* bl = RBL + (size_t)fr * D + kq * 1024 + 8 * fq;
          RtLoad La, Lb; rt_load(La, h0, h1, gp, 0);
#pragma unroll 1
          for (int ks = 0; ks < 32; ks += 2) {
              rt_load(Lb, h0, h1, gp, (ks + 1) * 32); rt_step(La, bh, bl, acc, ss, ks * 32);
              if (ks + 2 < 32) rt_load(La, h0, h1, gp, (ks + 2) * 32);
              rt_step(Lb, bh, bl, acc, ss, (ks + 1) * 32); }
#pragma unroll
          for (int mi = 0; mi < 2; ++mi) { float s = ss[mi]; s += __shfl_xor(s, 16); s += __shfl_xor(s, 32); if (fq == 0) ssp[kq * 64 + 32 * tg + 16 * mi + fr] = s;
#pragma unroll
              for (int n = 0; n < 5; ++n)
#pragma unroll
                  for (int i = 0; i < 4; ++i) part[(kq * 64 + 32 * tg + 16 * mi + 4 * fq + i) * 80 + 16 * n + fr] = acc[mi][n][i]; } }
        __syncthreads();
        if (F.tid < 64) { const float s = (ssp[F.tid] + ssp[64 + F.tid]) + (ssp[128 + F.tid] + ssp[192 + F.tid]); const float r = 1.0f / sqrtf(s * (1.f / D) + RMS_EPS); rs[F.tid] = r; }
        __syncthreads();
        for (int i = F.tid; i < 64 * 80; i += NTHREADS) lg[i] = ((part[i] + part[5120 + i]) + (part[10240 + i] + part[15360 + i])) * rs[i / 80];
        __syncthreads();
        if (F.tid < 64) { const int tk = F.tid, m = m0 + tk; const LAS float* L = lg + tk * 80;
            float gl[8]; int g = 0; float gm;
#pragma unroll
            for (int c = 0; c < 8; ++c) gl[c] = L[c] + F.rg_b[c];
            gm = gl[0];
#pragma unroll
            for (int c = 1; c < 8; ++c) if (gl[c] > gm) { gm = gl[c]; g = c; }
            float gs = 0.f;
#pragma unroll
            for (int c = 0; c < 8; ++c) gs += expf(gl[c] - gm);
            const float gw = 1.0f / gs;
            float el[8];
#pragma unroll
            for (int j = 0; j < 8; ++j) el[j] = L[8 + g * 8 + j] + F.re_b[g * 8 + j];
            int i0 = 0; float e0 = el[0];
#pragma unroll
            for (int j = 1; j < 8; ++j) if (el[j] > e0) { e0 = el[j]; i0 = j; }
            int i1 = -1; float e1 = -3.0e38f;
#pragma unroll
            for (int j = 0; j < 8; ++j) if (j != i0 && el[j] > e1) { e1 = el[j]; i1 = j; }
            const float tt = expf(e1 - e0); const float w0 = 1.0f / (1.0f + tt), w1 = tt / (1.0f + tt);
            const int x0 = g * 8 + i0, x1 = g * 8 + i1;
            const size_t s0 = (size_t)x0 * CAPS + atomicAdd(ctl + CW_CNT + x0, 1u), s1 = (size_t)x1 * CAPS + atomicAdd(ctl + CW_CNT + x1, 1u); const float rr = rs[tk];
            int* t2tok = (int*)(F.ws + WS_T2 + T2_TOK); float* t2w = (float*)(F.ws + WS_T2 + T2_W); int* t2dst = (int*)(F.ws + WS_T2 + T2_DST); float* t2rs = (float*)(F.ws + WS_T2 + T2_RS);
            t2tok[s0] = m; t2w[s0] = gw * w0; t2dst[s0] = 2 * m; t2rs[s0] = rr; t2tok[s1] = m; t2w[s1] = gw * w1; t2dst[s1] = 2 * m + 1; t2rs[s1] = rr; }
        __syncthreads();
    }
}
__device__ __forceinline__ void p6_tables(Frame& F) {
    unsigned* ctl = (unsigned*)(F.ws + WS_CTL);
    const int* tok_e = (const int*)(F.ws + WS_TAB + T_TOKE); const float* tok_w = (const float*)(F.ws + WS_TAB + T_TOKW); const int* tok_r = (const int*)(F.ws + WS_TAB + T_TOKR);
    int* slot_tok = (int*)(F.ws + WS_TAB + T_SLOTTOK); float* slot_w = (float*)(F.ws + WS_TAB + T_SLOTW); int* slot_dst = (int*)(F.ws + WS_TAB + T_SLOTDST); int* tile_e = (int*)(F.ws + WS_TAB + T_TILEE);
    float* slot_rs = (float*)(F.ws + WS_TAB + T_SLOTRS); const float* RSTD = (const float*)(F.ws + WS_TAB + T_RSTD);
    LAS int* off = (LAS int*)F.lds; LAS int* cnt = off + 80;
    if (F.tid < 64) cnt[F.tid] = (int)ctl[CW_CNT + F.tid];
    __syncthreads();
    if (F.tid == 0) { int a = 0; for (int e = 0; e < 64; ++e) { off[e] = a; a += (cnt[e] + 255) & ~255; } off[64] = a; }
    __syncthreads();
    for (int i = F.bid * NTHREADS + F.tid; i < 2 * M; i += F.G * NTHREADS) { const int e = tok_e[i], s = off[e] + tok_r[i]; slot_tok[s] = i >> 1; slot_w[s] = tok_w[i]; slot_dst[s] = i; slot_rs[s] = RSTD[i >> 1]; }
    for (int e = F.bid; e < 64; e += F.G) for (int s = off[e] + cnt[e] + F.tid; s < off[e + 1]; s += NTHREADS) { slot_tok[s] = 0; slot_w[s] = 0.f; slot_dst[s] = -1; slot_rs[s] = 0.f; }
    if (F.bid == 1 % F.G) { int* eoff = (int*)(F.ws + WS_TAB + T_EOFF); if (F.tid < 65) eoff[F.tid] = off[F.tid];
        if (F.tid < 8) { int* ul = (int*)(F.ws + WS_TAB + T_ULUP) + F.tid * UL_UP; int n = 0;
            for (int e = F.tid; e < 64; e += 8) { const int nrb = (cnt[e] + mu::MR - 1) / mu::MR; for (int rb = 0; rb < nrb; ++rb) for (int cb = 0; cb < 8; ++cb) ul[n++] = (e << 16) | (rb << 8) | cb; }
            ctl[CW_NUP + F.tid] = (unsigned)n; }
        else if (F.tid >= 64 && F.tid < 72) { const int x = F.tid - 64; int* ul = (int*)(F.ws + WS_TAB + T_ULDN) + x * UL_DN; int n = 0;
            for (int e = x; e < 64; e += 8) { const int nrb = (cnt[e] + mu::DR - 1) / mu::DR; for (int rb = 0; rb < nrb; ++rb) for (int cq = 0; cq < 4; ++cq) ul[n++] = (e << 16) | (rb << 8) | cq; }
            ctl[CW_NDN + x] = (unsigned)n; } }
    if (F.bid == 0) { if (F.tid < 64) for (int t = off[F.tid] >> 8; t < (off[F.tid + 1] >> 8); ++t) tile_e[t] = F.tid;
        if (F.tid == 0) ctl[CW_NT] = (unsigned)(off[64] >> 8); }
}
__device__ __forceinline__ void p9_row(float* O, const bf16_t* Hb, const bf16_t* Y, const float* g, int m, int mnext, int lane, u32x2 (&v)[16], u32x2 (&vn)[16]) {
    const u32x2* y0 = (const u32x2*)(Y + (size_t)(2 * m) * D) + lane; const u32x2* y1 = (const u32x2*)(Y + (size_t)(2 * m + 1) * D) + lane;
    u32x2 a[16], b[16];
#pragma unroll
    for (int j = 0; j < 16; ++j) { a[j] = y0[64 * j]; b[j] = y1[64 * j]; }
    if (mnext < M) { const u32x2* xn = (const u32x2*)(Hb + (size_t)mnext * D) + lane;
#pragma unroll
        for (int j = 0; j < 16; ++j) vn[j] = xn[64 * j]; }
    f32x4* xr = (f32x4*)(O + (size_t)m * D) + lane; const f32x4* gr = (const f32x4*)g + lane; float s = 0.f;
    f32x4 t[16];
#pragma unroll
    for (int j = 0; j < 16; ++j) { t[j].x = bflo(v[j].x) + (bflo(a[j].x) + bflo(b[j].x)); t[j].y = bfhi(v[j].x) + (bfhi(a[j].x) + bfhi(b[j].x)); t[j].z = bflo(v[j].y) + (bflo(a[j].y) + bflo(b[j].y)); t[j].w = bfhi(v[j].y) + (bfhi(a[j].y) + bfhi(b[j].y));
        s += (t[j].x * t[j].x + t[j].y * t[j].y) + (t[j].z * t[j].z + t[j].w * t[j].w); }
    const float rstd = 1.0f / sqrtf(wave_sum(s) * (1.f / D) + RMS_EPS);
#pragma unroll
    for (int j = 0; j < 16; ++j) { const f32x4 gg = gr[64 * j]; xr[64 * j] = (f32x4){t[j].x * rstd * gg.x, t[j].y * rstd * gg.y, t[j].z * rstd * gg.z, t[j].w * rstd * gg.w}; }
}
__device__ __forceinline__ void p9_final(Frame& F) {
    const bf16_t* Y = (const bf16_t*)(F.ws + WS_Y); const bf16_t* Hb = (const bf16_t*)(F.ws + WS_HB); float* O = F.out;
    const int gw = F.bid * NWAVES + F.wave, NGW = F.G * NWAVES, lane = F.lane;
    u32x2 va[16], vb[16];
    int m = gw;
    if (m < M) { const u32x2* xr = (const u32x2*)(Hb + (size_t)m * D) + lane;
#pragma unroll
        for (int j = 0; j < 16; ++j) va[j] = xr[64 * j]; }
    while (m < M) {
        p9_row(O, Hb, Y, F.g_fin, m, m + NGW, lane, va, vb); m += NGW; if (m >= M) break;
        p9_row(O, Hb, Y, F.g_fin, m, m + NGW, lane, vb, va); m += NGW;
    }
}

__global__ void __launch_bounds__(NTHREADS, 2) hymba_fwd(Args args) {
    extern __shared__ __attribute__((aligned(16))) unsigned char lds[];
    Frame F;
    F.lds = (LAS unsigned char*)lds;
    F.tid = threadIdx.x; F.lane = F.tid & 63; F.wave = __builtin_amdgcn_readfirstlane(F.tid >> 6);
    F.G = gridDim.x; F.bid = blockIdx.x; F.ws = args.ws; F.out = args.out;
    F.x = (const float*)args.in[0]; F.pos = (const int*)args.in[1]; F.g_mix = (const float*)args.in[2]; F.w_in = (const float*)args.in[3]; F.w2 = (const float*)args.in[4];
    F.gb = (const float*)args.in[5]; F.g_gla = (const float*)args.in[6]; F.sinks = (const float*)args.in[7]; F.w_out = (const float*)args.in[8]; F.g_ffn = (const float*)args.in[9];
    F.rg_w = (const float*)args.in[10]; F.rg_b = (const float*)args.in[11]; F.re_w = (const float*)args.in[12]; F.re_b = (const float*)args.in[13];
    F.wg = (const float*)args.in[14]; F.wu = (const float*)args.in[15]; F.wd = (const float*)args.in[16]; F.g_fin = (const float*)args.in[17];
    volatile LAS unsigned* MISC = (volatile LAS unsigned*)(F.lds + MISC_OFF);
    for (int u = F.tid; u < (LDS_BYTES - LDSCTL_OFF) / 4; u += NTHREADS) ((LAS unsigned*)(F.lds + LDSCTL_OFF))[u] = 0u;
    __syncthreads();
    unsigned* ctl = (unsigned*)(F.ws + WS_CTL);
    XcdBarrier bar; bar.bar = ctl + CW_BAR; bar.x = 0; bar.st = nullptr;
    if (MK_N_LAUNCHES == 1) bar = xcd_barrier_post(ctl + CW_BAR, MISC + 8);
    const int lo = args.ph_lo, hi = args.ph_hi;
#define IN(k) (lo <= (k) && (k) < hi)
#define SEAM(k) do { if (IN(k) && IN((k) + 1)) xcd_barrier(bar); } while (0)
    bf16_t* U = (bf16_t*)(F.ws + WS_U); bf16_t* PROJ = (bf16_t*)(F.ws + WS_PROJ); bf16_t* MIX = (bf16_t*)(F.ws + WS_MIX);

    if (IN(0)) REP(0) { p0_prologue(F); } SEAM(0);
    if (IN(1)) REP(1) {
        pg8::DenseSched S; S.init(U, (const bf16_t*)(F.ws + WS_WIN), M, LDP, D, F.G, F.bid);
        pg8::EpiBf16 E{PROJ, LDP};
        pg8::gemm_phase<pg8::EpiBf16, pg8::DenseSched, true>(F.lds, D, S, E);
    } SEAM(1);
    if (IN(2)) {
        REP(20) for (int u = F.bid; u < 2048; u += F.G) gla_prep_unit(F, u);
        REP(21) for (int u = F.bid; u < 1024; u += F.G) swa_unit(F, u >> 9, (u >> 7) & 3, u & 127);
    } SEAM(2);
    if (IN(3)) REP(3) { for (int c = F.bid; c < 256; c += F.G) { const int cc = (F.G == 256) ? (((c & 7) * 2 + (c >> 7)) << 4) | ((c >> 3) & 15) : c; gla_scan_chain(F, cc); } } SEAM(3);
    if (IN(4)) REP(4) { gla_norm(F); } SEAM(4);
    if (IN(5)) REP(5) {
        pg8::DenseSched S; S.init(MIX, (const bf16_t*)(F.ws + WS_WOUT), M, D, D, F.G, F.bid);
        pg8::EpiResBf16 E{F.x, (bf16_t*)(F.ws + WS_HB), D};
        pg8::gemm_phase<pg8::EpiResBf16, pg8::DenseSched, true>(F.lds, D, S, E);
    } SEAM(5);
    if (IN(6)) { p5_router(F); } SEAM(6);
    LAS int* eo = (LAS int*)(F.lds + MOE_TAB_OFF); LAS int* ecnt = eo + 80;
#define MOE_OFFSETS() do { __syncthreads(); if (F.tid < 64) { const int c_ = (int)ctl[CW_CNT + F.tid]; int s_ = c_; _Pragma("unroll") for (int d_ = 1; d_ < 64; d_ <<= 1) { const int t_ = __shfl_up(s_, d_); if (F.lane >= d_) s_ += t_; } \
        eo[F.tid + 1] = s_; ecnt[F.tid] = c_; if (F.tid == 0) eo[0] = 0; } __syncthreads(); } while (0)
#define MOE_UNIT(idx_, x_, RMAX, CBN, e_, rb_, cb_, ok_) do { int b_ = 0; ok_ = false; for (int k_ = 0; k_ < 8; ++k_) { const int ee_ = (x_) + 8 * k_, n_ = ((ecnt[ee_] + (RMAX) - 1) / (RMAX)) * (CBN); \
        if ((idx_) < b_ + n_) { e_ = ee_; rb_ = ((idx_) - b_) / (CBN); cb_ = ((idx_) - b_) % (CBN); ok_ = true; break; } b_ += n_; } } while (0)
    if (IN(8)) REP(8) {
        __syncthreads(); for (int i = F.tid; i < D / 4; i += NTHREADS) ((LAS f32x4*)(F.lds + mu::GAIN_OFF))[i] = ((const f32x4*)F.g_ffn)[i];
        MOE_OFFSETS();
        const int x = F.bid & 7;
        for (int j = F.bid >> 3; ; j += F.G >> 3) { int e = 0, rb = 0, cb = 0; bool ok; MOE_UNIT(j, x, mu::MR, 8, e, rb, cb, ok); if (!ok) break;
            const int n = ecnt[e], nrb = (n + mu::MR - 1) / mu::MR, base = n / nrb, rem = n % nrb, r0 = rb * base + (rb < rem ? rb : rem), nv = base + (rb < rem ? 1 : 0);
            const long adj = (long)e * CAPS - eo[e];
            mu::moe_unit<0>(F.lds, e, cb, eo[e] + r0, nv, (const bf16_t*)(F.ws + WS_HB), (const int*)(F.ws + WS_T2 + T2_TOK) + adj, F.wg, F.wu, (bf16_t*)(F.ws + WS_HID), (const float*)(F.ws + WS_T2 + T2_RS) + adj, nullptr); }
    } SEAM(8);
    if (IN(9)) REP(9) {
        MOE_OFFSETS();
        const int x = F.bid & 7;
        for (int j = F.bid >> 3; ; j += F.G >> 3) { int e = 0, rb = 0, cq = 0; bool ok; MOE_UNIT(j, x, mu::DR, 4, e, rb, cq, ok); if (!ok) break;
            const int n = ecnt[e], nrb = (n + mu::DR - 1) / mu::DR, base = n / nrb, rem = n % nrb, r0 = rb * base + (rb < rem ? rb : rem), nv = base + (rb < rem ? 1 : 0);
            const long adj = (long)e * CAPS - eo[e];
            mu::moe_down_stream(F.lds, e, 8 * cq, eo[e] + r0, nv, (const bf16_t*)(F.ws + WS_HID), F.wd, (bf16_t*)(F.ws + WS_Y), (const float*)(F.ws + WS_T2 + T2_W) + adj, (const int*)(F.ws + WS_T2 + T2_DST) + adj); }
    } SEAM(9);
#undef MOE_OFFSETS
#undef MOE_UNIT
    if (IN(10)) { p9_final(F); }
#undef IN
#undef SEAM
}

extern "C" void kernel_launch(void* const* d_in, const int* in_sizes, int n_in, void* d_out, int out_size, void* d_ws, size_t ws_size, hipStream_t stream) {
    static int grid = 0;
    if (grid == 0) {
        if (n_in != 18 || out_size != M * D || ws_size < WS_END) { fprintf(stderr, "kernel_launch: unexpected shapes (n_in %d, out %d, ws %zu < %zu)\n", n_in, out_size, ws_size, (size_t)WS_END); grid = -1; return; }
        int dev = 0, cus = 0, per_cu = 0;
        if (hipGetDevice(&dev) != hipSuccess || hipDeviceGetAttribute(&cus, hipDeviceAttributeMultiprocessorCount, dev) != hipSuccess) { grid = -1; return; }
        if (hipFuncSetAttribute((const void*)hymba_fwd, hipFuncAttributeMaxDynamicSharedMemorySize, LDS_BYTES) != hipSuccess) { fprintf(stderr, "kernel_launch: hipFuncSetAttribute failed\n"); grid = -1; return; }
        if (hipOccupancyMaxActiveBlocksPerMultiprocessor(&per_cu, (const void*)hymba_fwd, NTHREADS, LDS_BYTES) != hipSuccess || per_cu < 1) { fprintf(stderr, "kernel_launch: occupancy query says %d\n", per_cu); }
        (void)hipGetLastError();
        grid = cus;
    }
    if (grid < 0) return;
    (void)in_sizes;
    if (hipMemsetAsync((char*)d_ws + WS_CTL, 0, CTL_ZERO_BYTES, stream) != hipSuccess) return;
    Args a{};
    for (int i = 0; i < 18; ++i) a.in[i] = d_in[i];
    a.out = (float*)d_out; a.ws = (unsigned char*)d_ws;
    if (MK_N_LAUNCHES == 1) { a.ph_lo = 0; a.ph_hi = N_PHASES; hipLaunchKernelGGL(hymba_fwd, dim3(grid), dim3(NTHREADS), LDS_BYTES, stream, a); }
    else for (int p = 0; p < N_PHASES; ++p) { a.ph_lo = p; a.ph_hi = p + 1; hipLaunchKernelGGL(hymba_fwd, dim3(grid), dim3(NTHREADS), LDS_BYTES, stream, a); }
}
```

```cpp
#include <hip/hip_runtime.h>
#include <cstdio>
#include <cstdint>

#ifndef MK_N_LAUNCHES
#define MK_N_LAUNCHES 1
#endif

#ifndef PROBE_DUP
#define PROBE_DUP -1
#endif
#define REP(k) for (int rep_ = 0; rep_ < ((PROBE_DUP) == (k) ? 2 : 1); ++rep_)
#define GAS __attribute__((address_space(1)))
#define LAS __attribute__((address_space(3)))
#define PG8_LAS __attribute__((address_space(3)))

typedef unsigned short bf16_t;
typedef short bf16x8 __attribute__((ext_vector_type(8)));
typedef float f32x4 __attribute__((ext_vector_type(4)));
typedef float f32x2 __attribute__((ext_vector_type(2)));
typedef unsigned u32x4 __attribute__((ext_vector_type(4)));
typedef unsigned u32x2 __attribute__((ext_vector_type(2)));

constexpr int D = 4096, BATCH = 2, SEQ = 8192, M = BATCH * SEQ;
constexpr int IN_COLS = 8720, LDP = 8960;
constexpr int C_GQ = 0, C_GK = 1024, C_GV = 2048, C_GR = 4096, C_SQ = 6144, C_SK = 8192, C_SV = 8448, C_GA = 8704;
constexpr int NEXP = 64, DFF = 512;
constexpr int MAXSLOT = 49152;
constexpr float RMS_EPS = 1e-6f;

constexpr size_t MiB = 1u << 20;
constexpr size_t WS_CTL = 0, CTL_ZERO_BYTES = 64 * 1024;
constexpr size_t WS_TAB = 1 * MiB;
constexpr size_t WS_ROPE = 8 * MiB;
constexpr size_t WS_RB = 14 * MiB;
constexpr size_t WS_WIN = 32 * MiB;
constexpr size_t WS_WOUT = 102 * MiB;
constexpr size_t WS_U = 134 * MiB;
constexpr size_t WS_MIX = 262 * MiB;
constexpr size_t WS_PROJ = 390 * MiB;
constexpr size_t WS_Y = 390 * MiB;
constexpr size_t WS_HB = 670 * MiB;
constexpr size_t WS_WGU = 670 * MiB;
constexpr size_t WS_T2 = 1182 * MiB;
constexpr size_t T2_TOK = 0, T2_W = 4 * MiB, T2_DST = 8 * MiB, T2_RS = 12 * MiB; constexpr int CAPS = 16384;
constexpr size_t WS_WD = 1182 * MiB;
constexpr size_t WS_HID = 1438 * MiB;
constexpr size_t WS_QIN = 1486 * MiB;
constexpr size_t WS_KDT = 1518 * MiB;
constexpr size_t WS_AM = 1550 * MiB;
constexpr size_t WS_DEC = 1566 * MiB;
constexpr size_t WS_ORAW = 1568 * MiB;
constexpr size_t WS_END = 1632 * MiB;
constexpr size_t T_TOKE = 0;
constexpr size_t T_TOKW = 256 * 1024;
constexpr size_t T_TOKR = 512 * 1024;
constexpr size_t T_SLOTTOK = 768 * 1024;
constexpr size_t T_SLOTW = 1024 * 1024;
constexpr size_t T_SLOTDST = 1280 * 1024;
constexpr size_t T_TILEE = 1536 * 1024;
constexpr int UL_UP = 2048, UL_DN = 8192;
constexpr size_t T_ULUP = 1800 * 1024;
constexpr size_t T_EOFF = 1900 * 1024;
constexpr size_t T_ULDN = 2048 * 1024;
constexpr size_t T_RSTD = 1540 * 1024;
constexpr size_t T_SLOTRS = 1604 * 1024;
constexpr int CW_CNT = 1024;
constexpr int CW_NT = 1100;
constexpr int CW_NUP = 1200, CW_NDN = 1216;
constexpr int CW_BAR = 4096;

constexpr int RING_BYTES = 141312;
constexpr int LDSCTL_OFF = RING_BYTES, MISC_OFF = LDSCTL_OFF + 320;
constexpr int LDS_BYTES = 142336;

#define LDS_WAIT() asm volatile("s_waitcnt lgkmcnt(0)" ::: "memory")
#define VM_WAIT() asm volatile("s_waitcnt vmcnt(0)" ::: "memory")
__device__ __forceinline__ unsigned f2bf(float f) { unsigned u = __builtin_bit_cast(unsigned, f); return (u + 0x7fffu + ((u >> 16) & 1u)) >> 16; }
__device__ __forceinline__ unsigned pk2(float lo, float hi) { return f2bf(lo) | (f2bf(hi) << 16); }
__device__ __forceinline__ float bf2f(unsigned short b) { return __builtin_bit_cast(float, ((unsigned)b) << 16); }
__device__ __forceinline__ float bflo(unsigned w) { return __builtin_bit_cast(float, w << 16); }
__device__ __forceinline__ float bfhi(unsigned w) { return __builtin_bit_cast(float, w & 0xffff0000u); }
__device__ __forceinline__ unsigned cvt_pk_bf16(float lo, float hi) { unsigned r; asm volatile("v_cvt_pk_bf16_f32 %0, %1, %2" : "=v"(r) : "v"(lo), "v"(hi)); return r; }
typedef float f32x16 __attribute__((ext_vector_type(16)));
typedef short s16x4 __attribute__((ext_vector_type(4)));
typedef __bf16 bf16x2_t __attribute__((ext_vector_type(2)));
__device__ __forceinline__ unsigned cvtpk(float lo, float hi) { f32x2 v = {lo, hi}; bf16x2_t b = __builtin_convertvector(v, bf16x2_t); return __builtin_bit_cast(unsigned, b); }
__device__ __forceinline__ float wave_sum(float v) {
#pragma unroll
    for (int o = 1; o < 64; o <<= 1) v += __shfl_xor(v, o);
    return v;
}

#define XB_TMO      128
#define XB_XCNT(j)  (256  + 64 * (j))
#define XB_XSUB(j)  (1280 + 64 * (j))
#define XB_XGEN(j)  (2304 + 64 * (j))
#define XB_TOP      3328
#define XB_TOPGEN   3392
#define XCD_BAR_WORDS 3456
#define XB_SPIN_CAP (1u << 18)

__device__ __forceinline__ unsigned xb_ld(unsigned* p)              { return __hip_atomic_load(p, __ATOMIC_RELAXED, __HIP_MEMORY_SCOPE_AGENT); }
__device__ __forceinline__ unsigned xb_add(unsigned* p, unsigned v) { return __hip_atomic_fetch_add(p, v, __ATOMIC_RELAXED, __HIP_MEMORY_SCOPE_AGENT); }
__device__ __forceinline__ unsigned xb_xcc_id() { return (unsigned)__builtin_amdgcn_s_getreg((3 << 11) | 20) & 0xFu; }
#define XB_SPIN(cond, bar) do { unsigned _sp = 0; while (cond) { __builtin_amdgcn_s_sleep(1); \
    if ((++_sp & 255u) == 0u) { if (xb_ld(&(bar)[XB_TMO])) break; if (_sp > XB_SPIN_CAP) { atomicAdd(&(bar)[XB_TMO], 1u); break; } } } } while (0)

struct XcdBarrier { unsigned* bar; unsigned x; volatile LAS unsigned* st; };

__device__ __forceinline__ XcdBarrier xcd_barrier_post(unsigned* bar, volatile LAS unsigned* st) {
    XcdBarrier b; b.bar = bar; b.x = xb_xcc_id(); b.st = st;
    if (threadIdx.x == 0) (void)xb_add(&bar[XB_XCNT(b.x)], 1u);
    return b;
}
__device__ __forceinline__ void xcd_barrier_complete(unsigned* bar, unsigned x, unsigned& nloc, unsigned& nx) {
    const unsigned G = gridDim.x * gridDim.y * gridDim.z;
    unsigned sum, cnt, mine, sp = 0u;
    for (;;) {
        sum = 0u; cnt = 0u; mine = 0u;
#pragma unroll
        for (unsigned j = 0; j < 16; ++j) { const unsigned c = xb_ld(&bar[XB_XCNT(j)]); sum += c; cnt += (c > 0u) ? 1u : 0u; mine = (j == x) ? c : mine; }
        if (sum == G) break;
        __builtin_amdgcn_s_sleep(1);
        if ((++sp & 255u) == 0u) { if (xb_ld(&bar[XB_TMO])) break; if (sp > XB_SPIN_CAP) { atomicAdd(&bar[XB_TMO], 1u); break; } }
    }
    nloc = mine > 0u ? mine : 1u; nx = cnt > 0u ? cnt : 1u;
}
__device__ __forceinline__ void xcd_barrier(const XcdBarrier& b) {
    asm volatile("s_waitcnt vmcnt(0)" ::: "memory");
    __syncthreads();
    if (threadIdx.x == 0) {
        unsigned* bar = b.bar;
        __builtin_amdgcn_s_waitcnt(0);
        unsigned nloc = b.st[0], nx = b.st[1];
        if (nloc == 0u) { xcd_barrier_complete(bar, b.x, nloc, nx); b.st[0] = nloc; b.st[1] = nx; }
        const unsigned old = xb_add(&bar[XB_XSUB(b.x)], 1u);
        const unsigned gen = old / nloc;
        if (old + 1u == (gen + 1u) * nloc) {
            __builtin_amdgcn_fence(__ATOMIC_RELEASE, "agent");
            asm volatile("s_waitcnt vmcnt(0)" ::: "memory");
            const unsigned og = xb_add(&bar[XB_TOP], 1u);
            const unsigned tg = og / nx;
            if (og + 1u == (tg + 1u) * nx) xb_add(&bar[XB_TOPGEN], 1u);
            else XB_SPIN(xb_ld(&bar[XB_TOPGEN]) == tg, bar);
            __builtin_amdgcn_fence(__ATOMIC_ACQUIRE, "agent");
            xb_add(&bar[XB_XGEN(b.x)], 1u);
            asm volatile("s_waitcnt vmcnt(0)" ::: "memory");
        } else {
            XB_SPIN(xb_ld(&bar[XB_XGEN(b.x)]) == gen, bar);
            __builtin_amdgcn_fence(__ATOMIC_ACQUIRE, "agent");
            asm volatile("s_waitcnt vmcnt(0)" ::: "memory");
        }
    }
    __syncthreads();
}

namespace pg8 {
constexpr int BM = 256, BK = 64, HALF = 128, HTB = HALF * BK * 2, STAGE_BYTES = 8 * HTB, NXCD = 8, WGM = 8;
__host__ __device__ __forceinline__ int lds_byte(int r, int c) { const int st = (r >> 4) * 2 + (c >> 5), rr = r & 15, cc = c & 31, ob = rr * 64 + cc * 2; return st * 1024 + (ob ^ (((ob >> 9) & 1) << 5)); }
__host__ __device__ __forceinline__ void stage_rc(int b, int& R, int& C) { const int st = b / 1024, sb = b % 1024, swz = sb ^ (((sb >> 9) & 1) << 5); R = (st >> 1) * 16 + swz / 64; C = (st & 1) * 32 + (swz % 64) / 2; }
__host__ __device__ __forceinline__ int perm32(int rho) { const int n = rho >> 4, i = rho & 15; return 8 * (i >> 2) + 4 * n + (i & 3); }

struct Unit { int pm, pn, e; };

struct DenseSched {
    static constexpr bool GATHER = false;
    const bf16_t* A; const bf16_t* Bt; int K;
    int nM, nN, nwg, G, c;
    __device__ void init(const bf16_t* A_, const bf16_t* Bt_, int Mr, int N, int K_, int G_, int c_) { A = A_; Bt = Bt_; K = K_; nM = Mr / BM; nN = N / BM; nwg = nM * nN; G = G_; c = c_; }
    __device__ bool next(int i, Unit& u) const {
        const long L = (long)i * G + c; if (L >= nwg) return false;
        int wgid = (int)L; { const int q = nwg / NXCD, r = nwg % NXCD, xcd = wgid % NXCD, off = wgid / NXCD; wgid = (xcd < r ? xcd * (q + 1) : r * (q + 1) + (xcd - r) * q) + off; }
        const int nig = WGM * nN, gid = wgid / nig, fm = gid * WGM, gsz = (nM - fm) < WGM ? (nM - fm) : WGM;
        u.pm = fm + ((wgid % nig) % gsz); u.pn = (wgid % nig) / gsz; u.e = 0; return true;
    }
    __device__ __forceinline__ const char* a_ptr(const Unit& u) const { return (const char*)A + (size_t)u.pm * BM * K * 2; }
    __device__ __forceinline__ const char* b_ptr(const Unit& u) const { return (const char*)Bt + (size_t)u.pn * BM * K * 2; }
    __device__ __forceinline__ unsigned row(const Unit&, int) const { return 0u; }
};
struct MoeUpSched {
    static constexpr bool GATHER = true;
    const bf16_t* A; const bf16_t* Bt; const int* tile_e; const int* slot_tok; int ntiles, G, c;
    __device__ bool next(int i, Unit& u) const {
        if ((G & 7) == 0) { const int x = c & 7, idx = (c >> 3) + (G >> 3) * i; u.pm = 8 * (idx >> 2) + x; u.pn = idx & 3; if (u.pm >= ntiles) return false; }
        else { const int L = i * G + c; if (L >= ntiles * 4) return false; u.pm = L >> 2; u.pn = L & 3; }
        u.e = tile_e[u.pm]; return true;
    }
    __device__ __forceinline__ const char* a_ptr(const Unit&) const { return (const char*)A; }
    __device__ __forceinline__ const char* b_ptr(const Unit& u) const { return (const char*)Bt + ((size_t)u.e * 1024 + (size_t)u.pn * 256) * 4096 * 2; }
    __device__ __forceinline__ unsigned row(const Unit& u, int r) const { return (unsigned)slot_tok[u.pm * 256 + r]; }
};
struct MoeDownSched {
    static constexpr bool GATHER = false;
    const bf16_t* A; const bf16_t* Bt; const int* tile_e; int ntiles, G, c;
    __device__ bool next(int i, Unit& u) const {
        const int L = i * G + c; if (L >= ntiles * 16) return false;
        u.pm = L >> 4; u.pn = L & 15; u.e = tile_e[u.pm]; return true;
    }
    __device__ __forceinline__ const char* a_ptr(const Unit& u) const { return (const char*)A + (size_t)u.pm * 256 * 512 * 2; }
    __device__ __forceinline__ const char* b_ptr(const Unit& u) const { return (const char*)Bt + ((size_t)u.e * 4096 + (size_t)u.pn * 256) * 512 * 2; }
    __device__ __forceinline__ unsigned row(const Unit&, int) const { return 0u; }
};

struct EpiBf16 {
    static constexpr bool PERM = true;
    bf16_t* O; int ldc;
    __device__ __forceinline__ void operator()(const f32x4 (&acc)[2][2][4][2], const Unit& u, int wr, int wc, int fr, int fq) const {
        const int row0 = u.pm * BM + wr * 64 + fr, col0 = u.pn * BM + wc * 32 + 8 * fq;
#pragma unroll
        for (int ai = 0; ai < 2; ++ai)
#pragma unroll
            for (int m = 0; m < 4; ++m) { bf16_t* rowp = O + (size_t)(row0 + ai * HALF + m * 16) * ldc + col0;
#pragma unroll
                for (int bj = 0; bj < 2; ++bj) { const f32x4 v0 = acc[ai][bj][m][0], v1 = acc[ai][bj][m][1];
                    u32x4 w; w.x = cvt_pk_bf16(v0[0], v0[1]); w.y = cvt_pk_bf16(v0[2], v0[3]); w.z = cvt_pk_bf16(v1[0], v1[1]); w.w = cvt_pk_bf16(v1[2], v1[3]);
                    *(u32x4*)(rowp + bj * HALF) = w; } }
    }
};
struct EpiResF32 {
    static constexpr bool PERM = false;
    const float* res; float* out; int ldc;
    __device__ __forceinline__ void operator()(const f32x4 (&acc)[2][2][4][2], const Unit& u, int wr, int wc, int fr, int fq) const {
        const int row0 = u.pm * BM + wr * 64 + fr, col0 = u.pn * BM + wc * 32 + 4 * fq;
#pragma unroll
        for (int ai = 0; ai < 2; ++ai)
#pragma unroll
            for (int m = 0; m < 4; ++m) { const size_t off = (size_t)(row0 + ai * HALF + m * 16) * ldc + col0;
#pragma unroll
                for (int bj = 0; bj < 2; ++bj)
#pragma unroll
                    for (int n = 0; n < 2; ++n) { const f32x4 r = *(const f32x4*)(res + off + bj * HALF + n * 16); *(f32x4*)(out + off + bj * HALF + n * 16) = r + acc[ai][bj][m][n]; }
                if (m & 1) asm volatile("" ::: "memory"); }
    }
};
struct EpiResBf16 {
    static constexpr bool PERM = true;
    const float* res; bf16_t* out; int ldc;
    __device__ __forceinline__ void operator()(const f32x4 (&acc)[2][2][4][2], const Unit& u, int wr, int wc, int fr, int fq) const {
        const int row0 = u.pm * BM + wr * 64 + fr, col0 = u.pn * BM + wc * 32 + 8 * fq;
#pragma unroll
        for (int ai = 0; ai < 2; ++ai)
#pragma unroll
            for (int m = 0; m < 4; ++m) { const size_t off = (size_t)(row0 + ai * HALF + m * 16) * ldc + col0;
#pragma unroll
                for (int bj = 0; bj < 2; ++bj) { const f32x4 v0 = *(const f32x4*)(res + off + bj * HALF) + acc[ai][bj][m][0], v1 = *(const f32x4*)(res + off + bj * HALF + 4) + acc[ai][bj][m][1];
                    u32x4 w; w.x = cvt_pk_bf16(v0[0], v0[1]); w.y = cvt_pk_bf16(v0[2], v0[3]); w.z = cvt_pk_bf16(v1[0], v1[1]); w.w = cvt_pk_bf16(v1[2], v1[3]);
                    *(u32x4*)(out + off + bj * HALF) = w; }
                if (m & 1) asm volatile("" ::: "memory"); }
    }
};
struct EpiSwiGlu {
    static constexpr bool PERM = true;
    bf16_t* HID; const float* slot_rs;
    __device__ __forceinline__ void operator()(const f32x4 (&acc)[2][2][4][2], const Unit& u, int wr, int wc, int fr, int fq) const {
        const int row0 = u.pm * BM + wr * 64 + fr, col0 = u.pn * 128 + wc * 32 + 8 * fq;
#pragma unroll
        for (int ai = 0; ai < 2; ++ai)
#pragma unroll
            for (int m = 0; m < 4; ++m) { bf16_t* rowp = HID + (size_t)(row0 + ai * HALF + m * 16) * DFF + col0; const float rs = slot_rs[row0 + ai * HALF + m * 16];
                float h[8];
#pragma unroll
                for (int n = 0; n < 2; ++n)
#pragma unroll
                    for (int j = 0; j < 4; ++j) { const float g = acc[ai][0][m][n][j] * rs, up = acc[ai][1][m][n][j] * rs; h[n * 4 + j] = g * __builtin_amdgcn_rcpf(1.0f + __expf(-g)) * up; }
                u32x4 w; w.x = cvt_pk_bf16(h[0], h[1]); w.y = cvt_pk_bf16(h[2], h[3]); w.z = cvt_pk_bf16(h[4], h[5]); w.w = cvt_pk_bf16(h[6], h[7]);
                *(u32x4*)rowp = w; }
    }
};
struct EpiDown {
    static constexpr bool PERM = true;
    bf16_t* Y; const int* slot_dst; const float* slot_w;
    __device__ __forceinline__ void operator()(const f32x4 (&acc)[2][2][4][2], const Unit& u, int wr, int wc, int fr, int fq) const {
        const int slot0 = u.pm * BM + wr * 64 + fr, col0 = u.pn * BM + wc * 32 + 8 * fq;
#pragma unroll
        for (int ai = 0; ai < 2; ++ai)
#pragma unroll
            for (int m = 0; m < 4; ++m) { const int slot = slot0 + ai * HALF + m * 16; const int dst = slot_dst[slot]; const float sw = slot_w[slot];
                if (dst >= 0) { bf16_t* rowp = Y + (size_t)dst * D + col0;
#pragma unroll
                    for (int bj = 0; bj < 2; ++bj) { const f32x4 v0 = acc[ai][bj][m][0] * sw, v1 = acc[ai][bj][m][1] * sw;
                        u32x4 w; w.x = cvt_pk_bf16(v0[0], v0[1]); w.y = cvt_pk_bf16(v0[2], v0[3]); w.z = cvt_pk_bf16(v1[0], v1[1]); w.w = cvt_pk_bf16(v1[2], v1[3]);
                        *(u32x4*)(rowp + bj * HALF) = w; } } }
    }
};

template <class Epi, class Sched, bool ALIGN_EPI>
__device__ __forceinline__ void gemm_phase(PG8_LAS unsigned char* lds, const int K, const Sched& S, const Epi& E) {
    const int tid = threadIdx.x, wid = __builtin_amdgcn_readfirstlane(tid >> 6), lane = tid & 63, wr = wid >> 2, wc = wid & 3, fr = lane & 15, fq = lane >> 4;
    const int nt = K / BK;
    unsigned voffA[2], voffB[2]; int RA[2], CA[2];
#pragma unroll
    for (int i = 0; i < 2; ++i) { int R, C; stage_rc(tid * 16 + i * 8192, R, C); const int Rb = Epi::PERM ? ((R & ~31) + perm32(R & 31)) : R;
        voffA[i] = (unsigned)(R * K + C) * 2u; voffB[i] = (unsigned)(Rb * K + C) * 2u; RA[i] = R; CA[i] = C; }
    const size_t kstep = (size_t)(BK * 2);
    const size_t hstep = (size_t)HALF * K * 2;
    const unsigned ldsw = (unsigned)wid * 1024u;
    const int aoff = lds_byte(wr * 64 + fr, fq * 8), boff = lds_byte(wc * 32 + fr, fq * 8);
#define PG8_SA(b, h) (((b) * 2 + (h)) * HTB)
#define PG8_SB(b, h) ((4 + (b) * 2 + (h)) * HTB)
#define PG8_STAGE(bufoff, gbase, voff) do { _Pragma("unroll") for (int _i = 0; _i < 2; ++_i) \
        __builtin_amdgcn_global_load_lds((const unsigned*)((const char*)(gbase) + (voff)[_i]), (PG8_LAS unsigned*)(lds + (bufoff) + ldsw + _i * 8192), 16, 0, 0); } while (0)
#define PG8_STAGE_A(bufoff, gb, vo, h) do { if constexpr (Sched::GATHER) { PG8_STAGE(bufoff, gb, (vo)[h]); } else { PG8_STAGE(bufoff, (gb) + (h) * hstep, voffA); } } while (0)
#define PG8_LDA(dst, b, h) do { _Pragma("unroll") for (int m = 0; m < 4; ++m) _Pragma("unroll") for (int k = 0; k < 2; ++k) dst[m][k] = *(const PG8_LAS bf16x8*)(lds + PG8_SA(b, h) + aoff + m * 2048 + k * 1024); } while (0)
#define PG8_LDB(dst, b, h) do { _Pragma("unroll") for (int n = 0; n < 2; ++n) _Pragma("unroll") for (int k = 0; k < 2; ++k) dst[n][k] = *(const PG8_LAS bf16x8*)(lds + PG8_SB(b, h) + boff + n * 2048 + k * 1024); } while (0)
#define PG8_MMA(ai, bj, At, Bt) do { __builtin_amdgcn_s_setprio(1); _Pragma("unroll") for (int m = 0; m < 4; ++m) _Pragma("unroll") for (int n = 0; n < 2; ++n) _Pragma("unroll") for (int k = 0; k < 2; ++k) \
        acc[ai][bj][m][n] = __builtin_amdgcn_mfma_f32_16x16x32_bf16(Bt[n][k], At[m][k], acc[ai][bj][m][n], 0, 0, 0); __builtin_amdgcn_s_setprio(0); } while (0)
#define PG8_WAIT_V(n) asm volatile("s_waitcnt vmcnt(" #n ")" ::: "memory")
#define PG8_WAIT_L(n) asm volatile("s_waitcnt lgkmcnt(" #n ")" ::: "memory")
#define PG8_BAR __builtin_amdgcn_s_barrier()
#define PG8_SCHED __builtin_amdgcn_sched_barrier(0)
    Unit cur, nxt; int ui = 0;
    if (!S.next(0, cur)) return;
    f32x4 acc[2][2][4][2];
#pragma unroll
    for (int a = 0; a < 2; ++a)
#pragma unroll
        for (int b = 0; b < 2; ++b)
#pragma unroll
            for (int m = 0; m < 4; ++m)
#pragma unroll
                for (int n = 0; n < 2; ++n) acc[a][b][m][n] = (f32x4){0.f, 0.f, 0.f, 0.f};
    bf16x8 At[4][2], B0[2][2], B1[2][2];
    unsigned cvo[2][2], nvo[2][2];
#pragma unroll
    for (int h = 0; h < 2; ++h)
#pragma unroll
        for (int i = 0; i < 2; ++i) { cvo[h][i] = Sched::GATHER ? (S.row(cur, h * HALF + RA[i]) * (unsigned)K + (unsigned)CA[i]) * 2u : 0u; nvo[h][i] = cvo[h][i]; }
    const char* cA = S.a_ptr(cur); const char* cB = S.b_ptr(cur);
    PG8_STAGE(PG8_SB(0, 0), cB, voffB); PG8_STAGE(PG8_SB(0, 1), cB + hstep, voffB); PG8_STAGE_A(PG8_SA(0, 0), cA, cvo, 0); PG8_STAGE_A(PG8_SA(0, 1), cA, cvo, 1);
    if (wr == 1) PG8_BAR;
    PG8_WAIT_V(2); PG8_BAR;
    PG8_STAGE(PG8_SB(1, 0), cB + kstep, voffB); PG8_STAGE_A(PG8_SA(1, 0), cA + kstep, cvo, 0); PG8_STAGE(PG8_SB(1, 1), cB + hstep + kstep, voffB);
    PG8_WAIT_V(6); PG8_BAR;
    for (;;) {
        const bool has_next = S.next(ui + 1, nxt);
        const char* nA = has_next ? S.a_ptr(nxt) : cA; const char* nB = has_next ? S.b_ptr(nxt) : cB;
        if constexpr (Sched::GATHER) {
#pragma unroll
            for (int h = 0; h < 2; ++h)
#pragma unroll
                for (int i = 0; i < 2; ++i) nvo[h][i] = has_next ? (S.row(nxt, h * HALF + RA[i]) * (unsigned)K + (unsigned)CA[i]) * 2u : cvo[h][i];
        }
        for (int t = 0; t < nt; t += 2) {
            const bool last = (t == nt - 2);
            const char* a1 = cA + (size_t)(t + 1) * kstep;
            const char* a2 = last ? nA : cA + (size_t)(t + 2) * kstep; const char* b2 = last ? nB : cB + (size_t)(t + 2) * kstep;
            const char* a3 = a2 + kstep; const char* b3 = b2 + kstep;
            unsigned vo2[2][2];
#pragma unroll
            for (int h = 0; h < 2; ++h)
#pragma unroll
                for (int i = 0; i < 2; ++i) vo2[h][i] = last ? nvo[h][i] : cvo[h][i];
            PG8_LDB(B0, 0, 0); PG8_LDB(B1, 0, 1); PG8_SCHED; PG8_LDA(At, 0, 0); PG8_STAGE_A(PG8_SA(1, 1), a1, cvo, 1);
            PG8_WAIT_V(8); PG8_WAIT_L(0); PG8_BAR; PG8_MMA(0, 0, At, B0); PG8_MMA(0, 1, At, B1); PG8_BAR; PG8_SCHED;
            PG8_LDA(At, 0, 1); PG8_STAGE(PG8_SB(0, 0), b2, voffB); PG8_STAGE(PG8_SB(0, 1), b2 + hstep, voffB); PG8_STAGE_A(PG8_SA(0, 0), a2, vo2, 0);
            PG8_WAIT_V(8); PG8_WAIT_L(0); PG8_BAR; PG8_MMA(1, 0, At, B0); PG8_MMA(1, 1, At, B1); PG8_BAR; PG8_SCHED;
            PG8_LDB(B0, 1, 0); PG8_LDB(B1, 1, 1); PG8_SCHED; PG8_LDA(At, 1, 0); PG8_STAGE_A(PG8_SA(0, 1), a2, vo2, 1);
            PG8_WAIT_V(8); PG8_WAIT_L(0); PG8_BAR; PG8_MMA(0, 0, At, B0); PG8_MMA(0, 1, At, B1); PG8_BAR; PG8_SCHED;
            PG8_LDA(At, 1, 1); PG8_STAGE(PG8_SB(1, 0), b3, voffB); PG8_STAGE(PG8_SB(1, 1), b3 + hstep, voffB); PG8_STAGE_A(PG8_SA(1, 0), a3, vo2, 0);
            PG8_WAIT_V(8); PG8_WAIT_L(0); PG8_BAR; PG8_MMA(1, 0, At, B0); PG8_MMA(1, 1, At, B1); PG8_BAR; PG8_SCHED;
        }
        if constexpr (ALIGN_EPI) { if (wr == 0) PG8_BAR; }
        E(acc, cur, wr, wc, fr, fq);
        if (!has_next) break;
#pragma unroll
        for (int a = 0; a < 2; ++a)
#pragma unroll
            for (int b = 0; b < 2; ++b)
#pragma unroll
                for (int m = 0; m < 4; ++m)
#pragma unroll
                    for (int n = 0; n < 2; ++n) acc[a][b][m][n] = (f32x4){0.f, 0.f, 0.f, 0.f};
        cur = nxt; cA = nA; cB = nB; ++ui;
#pragma unroll
        for (int h = 0; h < 2; ++h)
#pragma unroll
            for (int i = 0; i < 2; ++i) cvo[h][i] = nvo[h][i];
        if constexpr (ALIGN_EPI) { if (wr == 1) PG8_BAR; }
    }
    PG8_WAIT_V(0);
    if constexpr (!ALIGN_EPI) { if (wr == 0) PG8_BAR; }
    PG8_BAR;
#undef PG8_SA
#undef PG8_SB
#undef PG8_STAGE
#undef PG8_STAGE_A
#undef PG8_LDA
#undef PG8_LDB
#undef PG8_MMA
#undef PG8_WAIT_V
#undef PG8_WAIT_L
#undef PG8_BAR
#undef PG8_SCHED
}
}

namespace mu {
constexpr int MR = 320, RWU = 80, NMU = 5, ABYTES = MR * 64 * 2, BBYTES = 128 * 64 * 2;
constexpr int GAIN_OFF = 2 * ABYTES + 2 * BBYTES;
__device__ __forceinline__ int lds_byte(int r, int c) { const int st = (r >> 4) * 2 + (c >> 5), ob = (r & 15) * 64 + (c & 31) * 2; return st * 1024 + (ob ^ (((ob >> 9) & 1) << 5)); }
__device__ __forceinline__ void stage_rc(int b, int& R, int& C) { const int st = b >> 10, sb = b & 1023, swz = sb ^ (((sb >> 9) & 1) << 5); R = (st >> 1) * 16 + swz / 64; C = (st & 1) * 32 + (swz % 64) / 2; }
template <int MODE>
__device__ __forceinline__ void moe_unit(PG8_LAS unsigned char* lds, int e, int cb, int slot0  , int nv  , const bf16_t* A, const int* slot_tok,
                                         const float* W0, const float* W1, bf16_t* OUT, const float* slot_rs  , const int* slot_dst) {
    constexpr int K = MODE == 0 ? 4096 : 512, nt = K / 64, LDB = MODE == 0 ? 512 : 4096, RB = LDB * 4  ;
    const int tid = threadIdx.x, wid = __builtin_amdgcn_readfirstlane(tid >> 6), lane = tid & 63, wr = wid >> 1, wc = wid & 1, fr = lane & 15, fq = lane >> 4;
    unsigned aoff[NMU];
#pragma unroll
    for (int i = 0; i < NMU; ++i) { const int R = 8 * (wid + 8 * i) + (lane >> 3), C = 8 * ((lane & 7) ^ ((R >> 1) & 7)); const int w4 = R / RWU, r = 4 * (R - RWU * w4) + w4;
        const unsigned row = r < nv ? (MODE == 0 ? (unsigned)slot_tok[slot0 + r] : (unsigned)(slot0 + r)) : (MODE == 0 ? 0u : (unsigned)slot0); aoff[i] = (row * (unsigned)K + (unsigned)C) * 2u; }
    const int jj0 = 2 * (lane & 31), typ = lane >> 5;
    const int R0 = MODE == 0 ? 64 * (jj0 >> 5) + 32 * typ + 16 * ((jj0 >> 2) & 1) + 4 * ((jj0 >> 3) & 3) + (jj0 & 3) : 2 * lane;
    const char* Bb = MODE == 0 ? (const char*)((typ ? W1 : W0) + (size_t)e * K * LDB + 64 * cb + jj0) + (size_t)(8 * wid) * RB
                               : (const char*)(W0 + (size_t)e * K * LDB + 128 * cb + 2 * lane) + (size_t)(8 * wid) * RB;
    const unsigned bw0 = (unsigned)(R0 * 128 + ((wid ^ ((R0 >> 1) & 7)) * 16)), bw1 = bw0 + 128u;
    const int nvw = (nv - wr + 3) >> 2, mcnt = nvw <= 0 ? 0 : (((nvw + 15) >> 4) > NMU ? NMU : ((nvw + 15) >> 4));
#define MU_SA(b) (lds + (b) * ABYTES)
#define MU_SB(b) (lds + 2 * ABYTES + (b) * BBYTES)
#define MU_GLDS_A(buf, kt) do { _Pragma("unroll") for (int i = 0; i < NMU; ++i) \
        __builtin_amdgcn_global_load_lds((const unsigned*)((const char*)A + aoff[i] + (size_t)(kt) * 128), (PG8_LAS unsigned*)(MU_SA(buf) + wid * 1024 + i * 8192), 16, 0, 0); } while (0)
#define MU_B_ISSUE(sb, kt) do { const char* kb_ = Bb + (size_t)(kt) * (64 * (size_t)RB); _Pragma("unroll") for (int j = 0; j < 8; ++j) { const char* p_ = kb_ + (size_t)j * RB; \
        asm volatile("global_load_dwordx2 %0, %1, off" : "=&v"(sb[j]) : "v"(p_) : "memory"); } } while (0)
#define MU_B_WAIT(sb, N) asm volatile("s_waitcnt vmcnt(%8)" : "+v"(sb[0]), "+v"(sb[1]), "+v"(sb[2]), "+v"(sb[3]), "+v"(sb[4]), "+v"(sb[5]), "+v"(sb[6]), "+v"(sb[7]) : "n"(N) : "memory")
#define MU_G_LOAD(ga, kt) do { const PG8_LAS f32x4* gk_ = (const PG8_LAS f32x4*)(lds + GAIN_OFF) + 16 * (kt) + 2 * wid; const f32x4 ga_ = gk_[0], gb_ = gk_[1]; \
        ga[0] = ga_[0]; ga[1] = ga_[1]; ga[2] = ga_[2]; ga[3] = ga_[3]; ga[4] = gb_[0]; ga[5] = gb_[1]; ga[6] = gb_[2]; ga[7] = gb_[3]; } while (0)
#define MU_B_WRITE(sb, buf, ga) do { u32x4 w0_, w1_; w0_.x = cvtpk(sb[0].x * ga[0], sb[1].x * ga[1]); w0_.y = cvtpk(sb[2].x * ga[2], sb[3].x * ga[3]); w0_.z = cvtpk(sb[4].x * ga[4], sb[5].x * ga[5]); w0_.w = cvtpk(sb[6].x * ga[6], sb[7].x * ga[7]); \
        w1_.x = cvtpk(sb[0].y * ga[0], sb[1].y * ga[1]); w1_.y = cvtpk(sb[2].y * ga[2], sb[3].y * ga[3]); w1_.z = cvtpk(sb[4].y * ga[4], sb[5].y * ga[5]); w1_.w = cvtpk(sb[6].y * ga[6], sb[7].y * ga[7]); \
        *(PG8_LAS u32x4*)(MU_SB(buf) + bw0) = w0_; *(PG8_LAS u32x4*)(MU_SB(buf) + bw1) = w1_; } while (0)
#define MU_RDA(buf, ks, m) (*(const PG8_LAS bf16x8*)(MU_SA(buf) + (RWU * wr + 16 * (m) + fr) * 128 + (((4 * (ks) + fq) ^ (((RWU * wr + 16 * (m) + fr) >> 1) & 7)) * 16)))
#define MU_RDB(buf, ks, n) (*(const PG8_LAS bf16x8*)(MU_SB(buf) + (64 * wc + 16 * (n) + fr) * 128 + (((4 * (ks) + fq) ^ (((64 * wc + 16 * (n) + fr) >> 1) & 7)) * 16)))
#define MU_COMPUTE_N(buf, MC) do { bf16x8 At[MC], Bf0[4], Bf1[4]; \
        _Pragma("unroll") for (int n = 0; n < 4; ++n) Bf0[n] = MU_RDB(buf, 0, n); \
        _Pragma("unroll") for (int m = 0; m < (MC); ++m) At[m] = MU_RDA(buf, 0, m); \
        _Pragma("unroll") for (int m = 0; m < (MC); ++m) { _Pragma("unroll") for (int n = 0; n < 4; ++n) acc[m][n] = __builtin_amdgcn_mfma_f32_16x16x32_bf16(Bf0[n], At[m], acc[m][n], 0, 0, 0); \
            At[m] = MU_RDA(buf, 1, m); if (m < 4) Bf1[m] = MU_RDB(buf, 1, m); } \
        _Pragma("unroll") for (int m = 0; m < (MC); ++m) { _Pragma("unroll") for (int n = 0; n < 4; ++n) acc[m][n] = __builtin_amdgcn_mfma_f32_16x16x32_bf16(Bf1[n], At[m], acc[m][n], 0, 0, 0); } \
        __builtin_amdgcn_sched_group_barrier(0x100, 4 + (MC), 0); \
        _Pragma("unroll") for (int m = 0; m < (MC); ++m) { __builtin_amdgcn_sched_group_barrier(0x008, 4, 0); __builtin_amdgcn_sched_group_barrier(0x100, 1, 0); if (m < 4) __builtin_amdgcn_sched_group_barrier(0x100, 1, 0); } \
        __builtin_amdgcn_sched_group_barrier(0x008, 4 * (MC), 0); \
        __builtin_amdgcn_sched_barrier(0); } while (0)
#define MU_COMPUTE(buf) MU_COMPUTE_N(buf, NMU)
#define MU_END(last) do { if (last) asm volatile("s_waitcnt vmcnt(0)" ::: "memory"); else asm volatile("s_waitcnt vmcnt(8)" ::: "memory"); \
        asm volatile("s_waitcnt lgkmcnt(0)" ::: "memory"); __builtin_amdgcn_s_barrier(); asm volatile("" ::: "memory"); } while (0)
    f32x4 acc[NMU][4];
#pragma unroll
    for (int m = 0; m < NMU; ++m)
#pragma unroll
        for (int n = 0; n < 4; ++n) acc[m][n] = (f32x4){0.f, 0.f, 0.f, 0.f};
    f32x2 s0[8], s1[8];
    float g0[8];
    MU_GLDS_A(0, 0); MU_B_ISSUE(s0, 0); MU_G_LOAD(g0, 0); MU_B_ISSUE(s1, 1);
    MU_B_WAIT(s0, 8); MU_B_WRITE(s0, 0, g0); __builtin_amdgcn_sched_barrier(0); MU_B_ISSUE(s0, 2);
    asm volatile("s_waitcnt vmcnt(16)" ::: "memory");
    asm volatile("s_waitcnt lgkmcnt(0)" ::: "memory"); __builtin_amdgcn_s_barrier(); asm volatile("" ::: "memory");
#pragma unroll 1
    for (int t = 0; t < nt; t += 2) {
        if (t + 2 < nt) MU_B_WAIT(s1, 8); else MU_B_WAIT(s1, 0);
        MU_G_LOAD(g0, t + 1); MU_B_WRITE(s1, 1, g0); __builtin_amdgcn_sched_barrier(0); MU_GLDS_A(1, t + 1); __builtin_amdgcn_sched_barrier(0);
        if (t + 3 < nt) { MU_B_ISSUE(s1, t + 3); }
        MU_COMPUTE(0);
        MU_END(t + 3 >= nt);
        if (t + 2 < nt) { MU_B_WAIT(s0, 8); MU_G_LOAD(g0, t + 2); MU_B_WRITE(s0, 0, g0); __builtin_amdgcn_sched_barrier(0); MU_GLDS_A(0, t + 2); __builtin_amdgcn_sched_barrier(0); }
        if (t + 4 < nt) { MU_B_ISSUE(s0, t + 4); }
        MU_COMPUTE(1);
        MU_END(t + 4 >= nt);
    }
#pragma unroll
    for (int m = 0; m < NMU; ++m) if (m < mcnt) { const int r = 4 * (16 * m + fr) + wr;
        if (r < nv) { const int slot = slot0 + r; const float rs = slot_rs[slot];
            if (MODE == 0) {
                float h[8];
#pragma unroll
                for (int n = 0; n < 2; ++n)
#pragma unroll
                    for (int i = 0; i < 4; ++i) { const float g = acc[m][n][i] * rs, up = acc[m][n + 2][i] * rs; h[4 * n + i] = g * __builtin_amdgcn_rcpf(1.0f + __expf(-g)) * up; }
                { u32x4 w; w.x = cvtpk(h[0], h[1]); w.y = cvtpk(h[2], h[3]); w.z = cvtpk(h[4], h[5]); w.w = cvtpk(h[6], h[7]); *(u32x4*)(OUT + (size_t)slot * DFF + 64 * cb + 32 * wc + 8 * fq) = w; }
            } else { const int dst = slot_dst[slot];
#pragma unroll
                for (int n = 0; n < 4; ++n) { const f32x4 v = acc[m][n] * rs; u32x2 w; w.x = cvtpk(v[0], v[1]); w.y = cvtpk(v[2], v[3]); *(u32x2*)(OUT + (size_t)dst * D + 128 * cb + 64 * wc + 16 * n + 4 * fq) = w; } } } }
#undef MU_SA
#undef MU_SB
#undef MU_GLDS_A
#undef MU_B_ISSUE
#undef MU_B_WAIT
#undef MU_B_WRITE
#undef MU_G_LOAD
#undef MU_COMPUTE
#undef MU_COMPUTE_N
#undef MU_RDA
#undef MU_RDB
#undef MU_END
}

constexpr int MD_STG_OFF = 114688, MD_TAB_OFF = 133120;
constexpr int DCB = 4;
constexpr int DR = 320, DRW = 80, DNM = 5, DABYTES = DR * 64 * 2;
__device__ __forceinline__ void moe_down_stream(PG8_LAS unsigned char* lds, int e, int cb0, int slot0, int nv, const bf16_t* HIDp, const float* Wd, bf16_t* Y, const float* slot_w, const int* slot_dst) {
    constexpr int K = 512, NT = 8 * DCB, RB = 4096 * 4;
    const int tid = threadIdx.x, wid = __builtin_amdgcn_readfirstlane(tid >> 6), lane = tid & 63, wr = wid >> 1, wc = wid & 1, fr = lane & 15, fq = lane >> 4;
    unsigned aoff[5];
#pragma unroll
    for (int i = 0; i < 5; ++i) { const int R = 8 * (wid + 8 * i) + (lane >> 3), C = 8 * ((lane & 7) ^ ((R >> 1) & 7)); const int w4 = R / DRW; int r = 4 * (R - DRW * w4) + w4; r = r < nv ? r : r % nv;
        aoff[i] = ((unsigned)(slot0 + r) * (unsigned)K + (unsigned)C) * 2u; }
    const int c0_ = 2 * lane, R0 = 64 * (c0_ >> 6) + 16 * (2 * ((c0_ >> 5) & 1) + ((c0_ >> 2) & 1)) + 4 * ((c0_ >> 3) & 3) + (c0_ & 3);
    const char* Bb = (const char*)(Wd + (size_t)e * K * 4096 + 128 * cb0 + 2 * lane) + (size_t)(8 * wid) * RB;
    const unsigned bw0 = (unsigned)(R0 * 128 + ((wid ^ ((R0 >> 1) & 7)) * 16)), bw1 = bw0 + 128u;
    const int nvw = (nv - wr + 3) >> 2, mcnt = nvw <= 0 ? 0 : (((nvw + 15) >> 4) > DNM ? DNM : ((nvw + 15) >> 4));
    unsigned amask = 0u;
#pragma unroll
    for (int i = 0; i < 5; ++i) { const int grp = 4 * i + (wid >> 1), w4 = grp / DNM, mf = grp % DNM, nv4 = (nv - w4 + 3) >> 2, mc4 = nv4 <= 0 ? 0 : ((nv4 + 15) >> 4); if (mf < mc4) amask |= 1u << i; }
    LAS int* ldst = (LAS int*)(lds + MD_TAB_OFF); LAS float* lw = (LAS float*)(ldst + DR);
    PG8_LAS unsigned char* stg = lds + MD_STG_OFF + wid * 2048;
    __syncthreads();
    for (int r = tid; r < DR; r += 512) { const bool ok = r < nv; ldst[r] = ok ? slot_dst[slot0 + r] : -1; lw[r] = ok ? slot_w[slot0 + r] : 0.f; }
    asm volatile("s_waitcnt vmcnt(0)" ::: "memory");
#define MD_SA(b) (lds + (b) * DABYTES)
#define MD_SB(b) (lds + 2 * DABYTES + (b) * BBYTES)
#define MD_GLDS_A(buf, tau) do { _Pragma("unroll") for (int i = 0; i < 5; ++i) if (amask & (1u << i)) \
        __builtin_amdgcn_global_load_lds((const unsigned*)((const char*)HIDp + aoff[i] + (size_t)((tau) & 7) * 128), (PG8_LAS unsigned*)(MD_SA(buf) + wid * 1024 + i * 8192), 16, 0, 0); } while (0)
#define MD_B_ISSUE(sb, tau) do { const char* kb_ = Bb + (size_t)((tau) >> 3) * 512 + (size_t)((tau) & 7) * (64 * (size_t)RB); _Pragma("unroll") for (int j = 0; j < 8; ++j) { const char* p_ = kb_ + (size_t)j * RB; \
        asm volatile("global_load_dwordx2 %0, %1, off" : "=&v"(sb[j]) : "v"(p_) : "memory"); } } while (0)
#define MD_B_WAIT(sb, N) asm volatile("s_waitcnt vmcnt(%8)" : "+v"(sb[0]), "+v"(sb[1]), "+v"(sb[2]), "+v"(sb[3]), "+v"(sb[4]), "+v"(sb[5]), "+v"(sb[6]), "+v"(sb[7]) : "n"(N) : "memory")
#define MD_B_WRITE(sb, buf) do { u32x4 w0_, w1_; w0_.x = cvtpk(sb[0].x, sb[1].x); w0_.y = cvtpk(sb[2].x, sb[3].x); w0_.z = cvtpk(sb[4].x, sb[5].x); w0_.w = cvtpk(sb[6].x, sb[7].x); \
        w1_.x = cvtpk(sb[0].y, sb[1].y); w1_.y = cvtpk(sb[2].y, sb[3].y); w1_.z = cvtpk(sb[4].y, sb[5].y); w1_.w = cvtpk(sb[6].y, sb[7].y); \
        *(PG8_LAS u32x4*)(MD_SB(buf) + bw0) = w0_; *(PG8_LAS u32x4*)(MD_SB(buf) + bw1) = w1_; } while (0)
#define MD_RDA(buf, ks, m) (*(const PG8_LAS bf16x8*)(MD_SA(buf) + (DRW * wr + 16 * (m) + fr) * 128 + (((4 * (ks) + fq) ^ (((DRW * wr + 16 * (m) + fr) >> 1) & 7)) * 16)))
#define MD_RDB(buf, ks, n) (*(const PG8_LAS bf16x8*)(MD_SB(buf) + (64 * wc + 16 * (n) + fr) * 128 + (((4 * (ks) + fq) ^ (((64 * wc + 16 * (n) + fr) >> 1) & 7)) * 16)))
#define MD_COMPUTE(buf) do { bf16x8 At[DNM], Bf[4]; \
        _Pragma("unroll") for (int n = 0; n < 4; ++n) Bf[n] = MD_RDB(buf, 0, n); \
        _Pragma("unroll") for (int m = 0; m < DNM; ++m) At[m] = MD_RDA(buf, 0, m); \
        _Pragma("unroll") for (int m = 0; m < DNM; ++m) { _Pragma("unroll") for (int n = 0; n < 4; ++n) acc[m][n] = __builtin_amdgcn_mfma_f32_16x16x32_bf16(Bf[n], At[m], acc[m][n], 0, 0, 0); \
            At[m] = MD_RDA(buf, 1, m); } \
        __builtin_amdgcn_sched_barrier(0); \
        _Pragma("unroll") for (int n = 0; n < 4; ++n) Bf[n] = MD_RDB(buf, 1, n); \
        _Pragma("unroll") for (int m = 0; m < DNM; ++m) { _Pragma("unroll") for (int n = 0; n < 4; ++n) acc[m][n] = __builtin_amdgcn_mfma_f32_16x16x32_bf16(Bf[n], At[m], acc[m][n], 0, 0, 0); } \
        __builtin_amdgcn_sched_barrier(0); } while (0)
#define MD_END(last) do { if (last) asm volatile("s_waitcnt vmcnt(0)" ::: "memory"); else asm volatile("s_waitcnt vmcnt(8)" ::: "memory"); \
        asm volatile("s_waitcnt lgkmcnt(0)" ::: "memory"); __builtin_amdgcn_s_barrier(); asm volatile("" ::: "memory"); } while (0)
    f32x4 acc[DNM][4];
#pragma unroll
    for (int m = 0; m < DNM; ++m)
#pragma unroll
        for (int n = 0; n < 4; ++n) acc[m][n] = (f32x4){0.f, 0.f, 0.f, 0.f};
    f32x2 s0[8], s1[8];
    MD_GLDS_A(0, 0); MD_B_ISSUE(s0, 0); MD_B_ISSUE(s1, 1);
    MD_B_WAIT(s0, 8); MD_B_WRITE(s0, 0); __builtin_amdgcn_sched_barrier(0); MD_B_ISSUE(s0, 2);
    asm volatile("s_waitcnt vmcnt(16)" ::: "memory");
    asm volatile("s_waitcnt lgkmcnt(0)" ::: "memory"); __builtin_amdgcn_s_barrier(); asm volatile("" ::: "memory");
#pragma unroll 1
    for (int t = 0; t < NT; t += 2) {
        if (t + 2 < NT) MD_B_WAIT(s1, 8); else MD_B_WAIT(s1, 0);
        MD_B_WRITE(s1, 1); __builtin_amdgcn_sched_barrier(0); MD_GLDS_A(1, t + 1); __builtin_amdgcn_sched_barrier(0);
        if (t + 3 < NT) MD_B_ISSUE(s1, t + 3);
        MD_COMPUTE(0);
        MD_END(t + 3 >= NT);
        if (t + 2 < NT) { MD_B_WAIT(s0, 8); MD_B_WRITE(s0, 0); __builtin_amdgcn_sched_barrier(0); MD_GLDS_A(0, t + 2); __builtin_amdgcn_sched_barrier(0); }
        if (t + 4 < NT) MD_B_ISSUE(s0, t + 4);
        MD_COMPUTE(1);
        MD_END(t + 4 >= NT);
        if (((t + 1) & 7) == 7) {
            const int cb = cb0 + ((t + 1) >> 3);
#pragma unroll
            for (int m = 0; m < DNM; ++m) {
                const float w_ = lw[4 * (16 * m + fr) + wr];
#pragma unroll
                for (int p = 0; p < 2; ++p) { const f32x4 v0 = acc[m][2 * p] * w_, v1 = acc[m][2 * p + 1] * w_; u32x4 w; w.x = cvtpk(v0[0], v0[1]); w.y = cvtpk(v0[2], v0[3]); w.z = cvtpk(v1[0], v1[1]); w.w = cvtpk(v1[2], v1[3]);
                    *(PG8_LAS u32x4*)(stg + fr * 128 + (((4 * p + fq) ^ (fr & 7)) * 16)) = w; }
#pragma unroll
                for (int hh = 0; hh < 2; ++hh) { const int r = (lane >> 3) + 8 * hh, cc = lane & 7; const u32x4 d = *(const PG8_LAS u32x4*)(stg + r * 128 + ((cc ^ (r & 7)) * 16)); const int dst_ = ldst[4 * (16 * m + r) + wr];
                    if (dst_ >= 0) *(u32x4*)(Y + (size_t)dst_ * D + 128 * cb + 64 * wc + 8 * cc) = d; }
#pragma unroll
                for (int n = 0; n < 4; ++n) acc[m][n] = (f32x4){0.f, 0.f, 0.f, 0.f}; } }
    }
#undef MD_SA
#undef MD_SB
#undef MD_GLDS_A
#undef MD_B_ISSUE
#undef MD_B_WAIT
#undef MD_B_WRITE
#undef MD_COMPUTE
#undef MD_RDA
#undef MD_RDB
#undef MD_END
}
}

constexpr int NWAVES = 8, NTHREADS = 512;
constexpr int N_PHASES = 11;
constexpr int MOE_TAB_OFF = 132096;
struct Args { const void* in[18]; float* out; unsigned char* ws; int ph_lo, ph_hi; };

struct Frame {
    LAS unsigned char* lds;
    int tid, lane, wave, G, bid;
    unsigned char* ws;
    const float *x, *g_mix, *w_in, *w2, *gb, *g_gla, *sinks, *w_out, *g_ffn, *rg_w, *rg_b, *re_w, *re_b, *wg, *wu, *wd, *g_fin;
    const int* pos;
    float* out;
};

template <int MODE>
__device__ __forceinline__ int dest_row(int n, int row_off) {
    if (MODE == 0) return row_off + n;
    if (MODE == 1) return n < 6144 ? n : (n < 6160 ? C_GA + (n - 6144) : n - 16);
    if (MODE == 2) return row_off + 256 * (n >> 7) + (n & 127);
    return row_off + 256 * (n >> 7) + 128 + (n & 127);
}
template <int MODE>
__device__ __forceinline__ void transpose_item(const float* W, int K, int N, bf16_t* WT, int row_off, LAS float* scr, int item, int lane) {
    const int nblk = (N + 31) / 32, nb = (item >> 3) % nblk, kb = (item & 7) + 8 * (item / (8 * nblk)), k0 = 64 * kb, n0 = 32 * nb;
    const bool nok = (n0 + (lane & 31)) < N;
    float tv[32];
#pragma unroll
    for (int i = 0; i < 32; ++i) { const int kk = 2 * i + (lane >> 5); tv[i] = nok ? W[(size_t)(k0 + kk) * N + n0 + (lane & 31)] : 0.f; }
#pragma unroll
    for (int i = 0; i < 32; ++i) { const int kk = 2 * i + (lane >> 5); scr[kk * 33 + (lane & 31)] = tv[i]; }
    LDS_WAIT(); asm volatile("" ::: "memory");
    const int c = lane & 7;
#pragma unroll
    for (int j = 0; j < 4; ++j) { const int n = (lane >> 3) + 8 * j; const LAS float* s = scr + (8 * c) * 33 + n;
        u32x4 o; o.x = pk2(s[0 * 33], s[1 * 33]); o.y = pk2(s[2 * 33], s[3 * 33]); o.z = pk2(s[4 * 33], s[5 * 33]); o.w = pk2(s[6 * 33], s[7 * 33]);
        if (n0 + n < N) *(u32x4*)(WT + (size_t)dest_row<MODE>(n0 + n, row_off) * K + k0 + 8 * c) = o; }
    LDS_WAIT(); asm volatile("" ::: "memory");
}
__device__ __forceinline__ void rms_row_to_bf16(int lane, const float* xrow, const float* g, bf16_t* orow) {
    const f32x4* xr = (const f32x4*)xrow + lane; const f32x4* gr = (const f32x4*)g + lane;
    f32x4 v[16]; float s = 0.f;
#pragma unroll
    for (int j = 0; j < 16; ++j) { v[j] = xr[64 * j]; s += (v[j].x * v[j].x + v[j].y * v[j].y) + (v[j].z * v[j].z + v[j].w * v[j].w); }
    const float rstd = 1.0f / sqrtf(wave_sum(s) * (1.f / D) + RMS_EPS);
    u32x2* o8 = (u32x2*)orow + lane;
#pragma unroll
    for (int j = 0; j < 16; ++j) { const f32x4 gg = gr[64 * j]; u32x2 w; w.x = pk2(v[j].x * rstd * gg.x, v[j].y * rstd * gg.y); w.y = pk2(v[j].z * rstd * gg.z, v[j].w * rstd * gg.w); o8[64 * j] = w; }
}

__device__ __forceinline__ void p0_prologue(Frame& F) {
    LAS float* scr = (LAS float*)(F.lds + F.wave * 16384);
    const int gw = F.bid * NWAVES + F.wave, NGW = F.G * NWAVES;
    bf16_t* WIN = (bf16_t*)(F.ws + WS_WIN); bf16_t* WOUT = (bf16_t*)(F.ws + WS_WOUT); bf16_t* WGU = (bf16_t*)(F.ws + WS_WGU); bf16_t* WD = (bf16_t*)(F.ws + WS_WD);
    constexpr int I_IN = 64 * 273, I_OUT = 64 * 128, I_G = 64 * 16, I_DN = 8 * 128;
    for (int it = gw; it < I_IN; it += NGW) transpose_item<1>(F.w_in, D, IN_COLS, WIN, 0, scr, it, F.lane);
    for (int it = gw; it < I_OUT; it += NGW) transpose_item<0>(F.w_out, D, D, WOUT, 0, scr, it, F.lane);

    { u32x4* z = (u32x4*)(WIN + (size_t)IN_COLS * D); const size_t n16 = (size_t)(LDP - IN_COLS) * D * 2 / 16;
      for (size_t i = (size_t)F.bid * NTHREADS + F.tid; i < n16; i += (size_t)F.G * NTHREADS) z[i] = (u32x4){0u, 0u, 0u, 0u}; }
    { bf16_t* RBH = (bf16_t*)(F.ws + WS_RB); bf16_t* RBL = RBH + 80 * D;
      for (int i = F.bid * NTHREADS + F.tid; i < 80 * D; i += F.G * NTHREADS) { const int c = i / D, k = i % D;
          float v = 0.f; if (c < 8) v = F.rg_w[k * 8 + c]; else if (c < 72) { const int g = (c - 8) >> 3, j = (c - 8) & 7; v = F.re_w[((size_t)g * D + k) * 8 + j]; }
          const unsigned h = f2bf(v); const float hf = __builtin_bit_cast(float, h << 16); RBH[i] = (bf16_t)h; RBL[i] = (bf16_t)f2bf(v - hf); } }
    { float* RC = (float*)(F.ws + WS_ROPE); float* RS = RC + M * 32;
      for (int i = F.bid * NTHREADS + F.tid; i < M * 32; i += F.G * NTHREADS) { const int m = i >> 5, j = i & 31;
          const float inv = exp2f(-(float)j * (13.287712379549449f / 32.0f));
          const float angf = (float)F.pos[m] * inv;
          const double a = (double)angf; const double tr = a * 0.15915494309189535; const double fr = tr - __builtin_rint(tr);
          const float r = (float)(fr * 6.283185307179586);
          RC[i] = cosf(r); RS[i] = sinf(r); } }
    { bf16_t* U = (bf16_t*)(F.ws + WS_U);
      for (int m = gw; m < M; m += NGW) rms_row_to_bf16(F.lane, F.x + (size_t)m * D, F.g_mix, U + (size_t)m * D); }
}

__device__ __forceinline__ int crow(int r, int hi) { return (r & 3) + 8 * (r >> 2) + 4 * hi; }
constexpr int SWA_KROW = 144;
__device__ __forceinline__ void rot8(const u32x4 x1, const u32x4 x2, const f32x4 c0, const f32x4 c1, const f32x4 s0, const f32x4 s1, float sc, u32x4& o1, u32x4& o2) {
    const unsigned a[4] = {x1.x, x1.y, x1.z, x1.w}, b[4] = {x2.x, x2.y, x2.z, x2.w};
    const float c[8] = {c0.x, c0.y, c0.z, c0.w, c1.x, c1.y, c1.z, c1.w}, s[8] = {s0.x, s0.y, s0.z, s0.w, s1.x, s1.y, s1.z, s1.w};
    unsigned r1[4], r2[4];
#pragma unroll
    for (int j = 0; j < 4; ++j) { const float a0 = bflo(a[j]), a1 = bfhi(a[j]), b0 = bflo(b[j]), b1 = bfhi(b[j]);
        r1[j] = cvtpk((a0 * c[2 * j] - b0 * s[2 * j]) * sc, (a1 * c[2 * j + 1] - b1 * s[2 * j + 1]) * sc);
        r2[j] = cvtpk((b0 * c[2 * j] + a0 * s[2 * j]) * sc, (b1 * c[2 * j + 1] + a1 * s[2 * j + 1]) * sc); }
    o1 = (u32x4){r1[0], r1[1], r1[2], r1[3]}; o2 = (u32x4){r2[0], r2[1], r2[2], r2[3]};
}
__device__ __forceinline__ void swa_unit(Frame& F, int b, int kvh, int qb) {
    const bf16_t* PROJ = (const bf16_t*)(F.ws + WS_PROJ); bf16_t* MIX = (bf16_t*)(F.ws + WS_MIX);
    const float* RC = (const float*)(F.ws + WS_ROPE); const float* RS = RC + M * 32;
    LAS unsigned char* Kl = F.lds; LAS unsigned char* Vl = F.lds + 192 * SWA_KROW;
    LAS float* wsf = (LAS float*)(F.lds + 2 * 192 * SWA_KROW) + F.wave * 64;
    LAS bf16_t* stg = (LAS bf16_t*)(F.lds + 2 * 192 * SWA_KROW + 2048) + F.wave * 2048;
    const int tid = F.tid, lane = F.lane, r32 = lane & 31, hi = lane >> 5;
    const int K0 = 64 * (qb - 2);
    const size_t rowb = (size_t)b * SEQ;
    for (int task = tid; task < 768; task += NTHREADS) { const int key = task >> 2, c = task & 3, kg = K0 + key;
        u32x4 o1 = (u32x4){0u, 0u, 0u, 0u}, o2 = o1;
        if (kg >= 0) { const bf16_t* src = PROJ + (rowb + kg) * LDP + C_SK + kvh * 64; const u32x4 x1 = *(const u32x4*)(src + 8 * c), x2 = *(const u32x4*)(src + 32 + 8 * c);
            const float* cs = RC + (rowb + kg) * 32 + 8 * c; const float* sn = RS + (rowb + kg) * 32 + 8 * c;
            rot8(x1, x2, *(const f32x4*)cs, *(const f32x4*)(cs + 4), *(const f32x4*)sn, *(const f32x4*)(sn + 4), 1.0f, o1, o2); }
        *(LAS u32x4*)(Kl + key * SWA_KROW + 16 * c) = o1; *(LAS u32x4*)(Kl + key * SWA_KROW + 64 + 16 * c) = o2; }
    for (int task = tid; task < 1536; task += NTHREADS) { const int key = task >> 3, c = task & 7, kg = K0 + key;
        u32x4 v = (u32x4){0u, 0u, 0u, 0u};
        if (kg >= 0) v = *(const u32x4*)(PROJ + (rowb + kg) * LDP + C_SV + kvh * 64 + 8 * c);
        *(LAS u32x4*)(Vl + key * SWA_KROW + 16 * c) = v; }
    __syncthreads();
    const int qh = kvh * 8 + F.wave;
    const float sink2 = F.sinks[qh] * 1.4426950408889634f;
#pragma unroll 1
    for (int sub = 0; sub < 2; ++sub) {
        const int qg = 64 * qb + 32 * sub + r32;
        bf16x8 qr[4];
        { const bf16_t* qsrc = PROJ + (rowb + qg) * LDP + C_SQ + qh * 64 + 8 * hi;
          const u32x4 x0 = *(const u32x4*)(qsrc), x1 = *(const u32x4*)(qsrc + 16), x2 = *(const u32x4*)(qsrc + 32), x3 = *(const u32x4*)(qsrc + 48);
          const float* cs = RC + (rowb + qg) * 32 + 8 * hi; const float* sn = RS + (rowb + qg) * 32 + 8 * hi;
          u32x4 o0, o1, o2, o3; const float sc = 0.125f * 1.4426950408889634f;
          rot8(x0, x2, *(const f32x4*)cs, *(const f32x4*)(cs + 4), *(const f32x4*)sn, *(const f32x4*)(sn + 4), sc, o0, o2);
          rot8(x1, x3, *(const f32x4*)(cs + 16), *(const f32x4*)(cs + 20), *(const f32x4*)(sn + 16), *(const f32x4*)(sn + 20), sc, o1, o3);
          qr[0] = __builtin_bit_cast(bf16x8, o0); qr[1] = __builtin_bit_cast(bf16x8, o1); qr[2] = __builtin_bit_cast(bf16x8, o2); qr[3] = __builtin_bit_cast(bf16x8, o3); }
        f32x16 p[5];
#pragma unroll
        for (int j = 0; j < 5; ++j) {
#pragma unroll
            for (int r = 0; r < 16; ++r) p[j][r] = 0.f;
#pragma unroll
            for (int d0 = 0; d0 < 4; ++d0) { const bf16x8 kf = *(const LAS bf16x8*)(Kl + (32 * sub + 32 * j + r32) * SWA_KROW + (16 * d0 + 8 * hi) * 2);
                p[j] = __builtin_amdgcn_mfma_f32_32x32x16_bf16(kf, qr[d0], p[j], 0, 0, 0); } }
        const int kneg = -(K0 + 32 * sub);
        const float NEG = -INFINITY;
#pragma unroll
        for (int j = 0; j < 5; ++j)
#pragma unroll
            for (int r = 0; r < 16; ++r) { const int c = crow(r, hi); bool ok = (32 * j >= kneg);
                if (j == 0) ok = ok && (c > r32); if (j == 4) ok = ok && (c <= r32);
                p[j][r] = ok ? p[j][r] : NEG; }
        float mx = sink2;
#pragma unroll
        for (int j = 0; j < 5; ++j)
#pragma unroll
            for (int r = 0; r < 16; ++r) mx = fmaxf(mx, p[j][r]);
        mx = fmaxf(mx, __shfl_xor(mx, 32));
        float sum = 0.f;
#pragma unroll
        for (int j = 0; j < 5; ++j)
#pragma unroll
            for (int r = 0; r < 16; ++r) { p[j][r] = __builtin_amdgcn_exp2f(p[j][r] - mx); sum += p[j][r]; }
        sum += __shfl_xor(sum, 32);
        sum += __builtin_amdgcn_exp2f(sink2 - mx);
        f32x16 o[2];
#pragma unroll
        for (int r = 0; r < 16; ++r) { o[0][r] = 0.f; o[1][r] = 0.f; }
        const int vrow0 = 32 * sub + 4 * hi + ((lane & 15) >> 2), vcol = ((lane >> 4) & 1) * 32 + (lane & 3) * 8;
#pragma unroll
        for (int j = 0; j < 5; ++j)
#pragma unroll
            for (int s = 0; s < 2; ++s) {
                u32x4 pw; pw.x = cvtpk(p[j][8 * s], p[j][8 * s + 1]); pw.y = cvtpk(p[j][8 * s + 2], p[j][8 * s + 3]); pw.z = cvtpk(p[j][8 * s + 4], p[j][8 * s + 5]); pw.w = cvtpk(p[j][8 * s + 6], p[j][8 * s + 7]);
                const bf16x8 pa = __builtin_bit_cast(bf16x8, pw);
#pragma unroll
                for (int d0 = 0; d0 < 2; ++d0) { const LAS unsigned char* vp = Vl + (vrow0 + 32 * j + 16 * s) * SWA_KROW + d0 * 64 + vcol;
                    const s16x4 lo = __builtin_bit_cast(s16x4, __builtin_amdgcn_ds_read_tr16_b64_v4i16((LAS s16x4*)vp));
                    const s16x4 hh = __builtin_bit_cast(s16x4, __builtin_amdgcn_ds_read_tr16_b64_v4i16((LAS s16x4*)(vp + 8 * SWA_KROW)));
                    const bf16x8 vf = (bf16x8){lo[0], lo[1], lo[2], lo[3], hh[0], hh[1], hh[2], hh[3]};
                    o[d0] = __builtin_amdgcn_mfma_f32_32x32x16_bf16(pa, vf, o[d0], 0, 0, 0); } }
        if (hi == 0) wsf[r32] = 1.0f / sum;
        LDS_WAIT();
#pragma unroll
        for (int r = 0; r < 16; ++r) { const int orow = crow(r, hi); const float rl = wsf[orow];
#pragma unroll
            for (int d0 = 0; d0 < 2; ++d0) stg[orow * 64 + d0 * 32 + r32] = (bf16_t)f2bf(o[d0][r] * rl); }
        LDS_WAIT();
#pragma unroll
        for (int i = 0; i < 4; ++i) { const int row = i * 8 + (lane >> 3), ch = lane & 7; const u32x4 v = *(const LAS u32x4*)(stg + row * 64 + ch * 8);
            *(u32x4*)(MIX + (rowb + 64 * qb + 32 * sub + row) * D + 2048 + qh * 64 + ch * 8) = v; }
        LDS_WAIT();
    }
    __syncthreads();
}

constexpr int GP_ROW = 136;
__device__ __forceinline__ void gla_prep_unit(Frame& F, int unit) {
    const int bh = unit >> 7, n = unit & 127, b = bh >> 3, h = bh & 7, tid = F.tid, lane = F.lane;
    const bf16_t* PROJ = (const bf16_t*)(F.ws + WS_PROJ);
    bf16_t* QIN = (bf16_t*)(F.ws + WS_QIN) + (size_t)unit * 64 * 128; bf16_t* KDT = (bf16_t*)(F.ws + WS_KDT) + (size_t)unit * 128 * 64;
    bf16_t* AM = (bf16_t*)(F.ws + WS_AM) + (size_t)unit * 64 * 64; float* DEC = (float*)(F.ws + WS_DEC) + (size_t)unit * 128;
    LAS float* gaS = (LAS float*)F.lds; LAS float* tot = gaS + 1024; LAS bf16_t* qinS = (LAS bf16_t*)(F.lds + 8192); LAS bf16_t* kinS = qinS + 64 * GP_ROW;
    const size_t m0 = (size_t)b * SEQ + 64 * n;
    const int d = tid & 127, cg = tid >> 7;
    bf16_t qv[16], kv[16];
#pragma unroll
    for (int i = 0; i < 16; ++i) { const bf16_t* pr = PROJ + (m0 + cg * 16 + i) * LDP + h * 128 + d; qv[i] = pr[C_GQ]; kv[i] = pr[C_GK]; }
    { const int c = tid >> 3, r2 = (tid & 7) * 2; const unsigned w = *(const unsigned*)(PROJ + (m0 + c) * LDP + C_GA + r2); gaS[c * 16 + r2] = bflo(w); gaS[c * 16 + r2 + 1] = bfhi(w); }
    float w2r[16];
#pragma unroll
    for (int r = 0; r < 16; ++r) w2r[r] = F.w2[r * 1024 + h * 128 + d];
    const float bias = F.gb[h * 128 + d];
    __syncthreads();
    float bl[16]; float run = 0.f;
#pragma unroll
    for (int i = 0; i < 16; ++i) { const int c = cg * 16 + i; float z = bias;
#pragma unroll
        for (int r4 = 0; r4 < 4; ++r4) { const f32x4 g4 = *(const LAS f32x4*)(gaS + c * 16 + 4 * r4); z += g4.x * w2r[4 * r4] + g4.y * w2r[4 * r4 + 1] + g4.z * w2r[4 * r4 + 2] + g4.w * w2r[4 * r4 + 3]; }
        const float ls = fminf(z, 0.f) - __logf(1.0f + __expf(-fabsf(z)));
        run += ls * (1.f / 16.f); bl[i] = run; }
    tot[cg * 128 + d] = run;
    __syncthreads();
    float offs = 0.f, blast = 0.f;
#pragma unroll
    for (int g = 0; g < 4; ++g) { const float t = tot[g * 128 + d]; blast += t; if (g < cg) offs += t; }
    const float eblast = __expf(blast);
    unsigned kd[8];
#pragma unroll
    for (int i = 0; i < 16; i += 2) { float kdv[2];
#pragma unroll
        for (int u = 0; u < 2; ++u) { const int c = cg * 16 + i + u; const float bb = bl[i + u] + offs;
            const float q = bf2f(qv[i + u]) * 0.08838834764831845f, k = bf2f(kv[i + u]);
            const float eb = __expf(bb), einv = __builtin_amdgcn_rcpf(eb);
            const float qin = q * eb, kin = k * einv; kdv[u] = kin * eblast;
            const bf16_t qb16 = (bf16_t)f2bf(qin); qinS[c * GP_ROW + d] = qb16; kinS[c * GP_ROW + d] = (bf16_t)f2bf(kin); QIN[c * 128 + d] = qb16; }
        kd[i >> 1] = pk2(kdv[0], kdv[1]); }
    *(u32x4*)(KDT + d * 64 + cg * 16) = (u32x4){kd[0], kd[1], kd[2], kd[3]}; *(u32x4*)(KDT + d * 64 + cg * 16 + 8) = (u32x4){kd[4], kd[5], kd[6], kd[7]};
    if (cg == 0) DEC[d] = eblast;
    __syncthreads();
    { const int mi = F.wave >> 1, fr = lane & 15, fq = lane >> 4;
#pragma unroll
      for (int t = 0; t < 2; ++t) { const int ni = 2 * (F.wave & 1) + t; f32x4 acc = (f32x4){0.f, 0.f, 0.f, 0.f};
          if (ni <= mi) {
#pragma unroll
              for (int ks = 0; ks < 4; ++ks) { const bf16x8 kf = *(const LAS bf16x8*)(kinS + (16 * ni + fr) * GP_ROW + 32 * ks + 8 * fq), qf = *(const LAS bf16x8*)(qinS + (16 * mi + fr) * GP_ROW + 32 * ks + 8 * fq);
                  acc = __builtin_amdgcn_mfma_f32_16x16x32_bf16(kf, qf, acc, 0, 0, 0); } }
          const int c = 16 * mi + fr, j0 = 16 * ni + 4 * fq; float v[4];
#pragma unroll
          for (int i = 0; i < 4; ++i) v[i] = (j0 + i <= c) ? acc[i] : 0.f;
          u32x2 w; w.x = pk2(v[0], v[1]); w.y = pk2(v[2], v[3]); *(u32x2*)(AM + c * 64 + j0) = w; } }
    __syncthreads();
}

constexpr int GS_AM = 0, GS_QIN = 8192, GS_KDT = 24576, GS_V = 40960, GS_DEC = 43008, GS_SLOT = 44032;
constexpr int GS_SB = 3 * GS_SLOT, GS_SBROW = 272, GS_SBBUF = 16 * GS_SBROW;
__device__ __forceinline__ void gs_load(Frame& F, int bh, int et, int n, int slot) {
    const int lane = F.lane, unit = bh * 128 + n, b = bh >> 3, h = bh & 7, wave = F.wave;
    LAS unsigned char* base = F.lds + slot * GS_SLOT;
    if (wave >= 1 && wave <= 4) { const int m = wave - 1;
        const char* am = (const char*)(F.ws + WS_AM) + (size_t)unit * 8192; const char* qin = (const char*)(F.ws + WS_QIN) + (size_t)unit * 16384;
#pragma unroll
        for (int i = 0; i < 2; ++i) { const int r = 16 * m + i * 8 + (lane >> 3), ch = (lane & 7) ^ (r & 7);
            __builtin_amdgcn_global_load_lds((const unsigned*)(am + r * 128 + ch * 16), (LAS unsigned*)(base + GS_AM + (2 * m + i) * 1024), 16, 0, 0); }
#pragma unroll
        for (int i = 0; i < 4; ++i) { const int r = 16 * m + i * 4 + (lane >> 4), ch = (lane & 15) ^ (r & 15);
            __builtin_amdgcn_global_load_lds((const unsigned*)(qin + r * 256 + ch * 16), (LAS unsigned*)(base + GS_QIN + (4 * m + i) * 1024), 16, 0, 0); }
    } else if (wave == 5 || wave == 6) { const char* kdt = (const char*)(F.ws + WS_KDT) + (size_t)unit * 16384; const int i0 = (wave - 5) * 8;
#pragma unroll
        for (int i = 0; i < 8; ++i) { const int r = (i0 + i) * 8 + (lane >> 3), ch = (lane & 7) ^ (r & 7);
            __builtin_amdgcn_global_load_lds((const unsigned*)(kdt + r * 128 + ch * 16), (LAS unsigned*)(base + GS_KDT + (i0 + i) * 1024), 16, 0, 0); }
    } else if (wave == 7) { const char* dec = (const char*)(F.ws + WS_DEC) + (size_t)unit * 512;
        const char* v = (const char*)((const bf16_t*)(F.ws + WS_PROJ) + ((size_t)b * SEQ + 64 * n) * LDP + C_GV + h * 256 + et * 16);
#pragma unroll
        for (int i = 0; i < 2; ++i) { const int r = i * 32 + (lane >> 1);
            __builtin_amdgcn_global_load_lds((const unsigned*)(v + (size_t)r * LDP * 2 + (lane & 1) * 16), (LAS unsigned*)(base + GS_V + i * 1024), 16, 0, 0); }
        __builtin_amdgcn_global_load_lds((const unsigned*)(dec + (lane & 31) * 16), (LAS unsigned*)(base + GS_DEC), 16, 0, 0);
    }
}
__device__ __forceinline__ void gs_vfrag(const LAS unsigned char* vbase, int lane, bf16x8 (&vf)[2]) {
    const unsigned a = (unsigned)(uintptr_t)(vbase + (8 * (lane >> 4) + ((lane & 15) >> 2)) * 32 + (lane & 3) * 8);
    s16x4 r0, r1, r2, r3;
    asm volatile("ds_read_b64_tr_b16 %0, %4\n\tds_read_b64_tr_b16 %1, %4 offset:128\n\tds_read_b64_tr_b16 %2, %4 offset:1024\n\tds_read_b64_tr_b16 %3, %4 offset:1152\n\ts_waitcnt lgkmcnt(0)"
                 : "=&v"(r0), "=&v"(r1), "=&v"(r2), "=&v"(r3) : "v"(a) : "memory");
    vf[0] = (bf16x8){r0[0], r0[1], r0[2], r0[3], r1[0], r1[1], r1[2], r1[3]}; vf[1] = (bf16x8){r2[0], r2[1], r2[2], r2[3], r3[0], r3[1], r3[2], r3[3]};
}
__device__ __forceinline__ void gs_wait_older(int wave, bool first) {
    if (wave >= 1 && wave <= 4) { if (first) asm volatile("s_waitcnt vmcnt(6)" ::: "memory"); else asm volatile("s_waitcnt vmcnt(14)" ::: "memory"); }
    else if (wave == 5 || wave == 6) asm volatile("s_waitcnt vmcnt(8)" ::: "memory");
    else if (wave == 7) asm volatile("s_waitcnt vmcnt(3)" ::: "memory");
}
__device__ __forceinline__ void gla_scan_chain(Frame& F, int chain) {
    const int bh = chain >> 4, et = chain & 15, b = bh >> 3, h = bh & 7, lane = F.lane, fr = lane & 15, fq = lane >> 4, wave = F.wave;
    bf16_t* ORAW = (bf16_t*)(F.ws + WS_ORAW);
    f32x4 S[8];
#pragma unroll
    for (int i = 0; i < 8; ++i) S[i] = (f32x4){0.f, 0.f, 0.f, 0.f};
    if (wave >= 1) { gs_load(F, bh, et, 0, 0); gs_load(F, bh, et, 1, 1); gs_wait_older(wave, true); }
    if (wave == 0) { for (int i = lane; i < GS_SBBUF / 16; i += 64) *(LAS u32x4*)(F.lds + GS_SB + i * 16) = (u32x4){0u, 0u, 0u, 0u}; }
    asm volatile("s_waitcnt lgkmcnt(0)" ::: "memory"); __builtin_amdgcn_s_barrier(); asm volatile("" ::: "memory");
#pragma unroll 1
    for (int n = 0; n < 128; ++n) {
        const LAS unsigned char* base = F.lds + (n % 3) * GS_SLOT;
        if (wave >= 1 && n + 2 < 128) gs_load(F, bh, et, n + 2, (n + 2) % 3);
        if (wave == 0) {
            bf16x8 vf[2]; gs_vfrag(base + GS_V, lane, vf);
            bf16x8 kf[8][2]; f32x4 dc[8];
#pragma unroll
            for (int mt = 0; mt < 8; ++mt) { const int r = 16 * mt + fr; dc[mt] = *(const LAS f32x4*)(base + GS_DEC + (16 * mt + 4 * fq) * 4);
#pragma unroll
                for (int ks = 0; ks < 2; ++ks) kf[mt][ks] = *(const LAS bf16x8*)(base + GS_KDT + r * 128 + (((4 * ks + fq) ^ (r & 7)) * 16)); }
            __builtin_amdgcn_sched_barrier(0);
            LAS unsigned char* sb = F.lds + GS_SB + ((n + 1) & 1) * GS_SBBUF + fr * GS_SBROW + 8 * fq;
#pragma unroll
            for (int mt = 0; mt < 8; ++mt) { f32x4 s = S[mt] * dc[mt];
                s = __builtin_amdgcn_mfma_f32_16x16x32_bf16(kf[mt][0], vf[0], s, 0, 0, 0); s = __builtin_amdgcn_mfma_f32_16x16x32_bf16(kf[mt][1], vf[1], s, 0, 0, 0); S[mt] = s; }
#pragma unroll
            for (int mt = 0; mt < 8; ++mt) { u32x2 w; w.x = cvtpk(S[mt][0], S[mt][1]); w.y = cvtpk(S[mt][2], S[mt][3]); *(LAS u32x2*)(sb + 32 * mt) = w; }
        } else if (wave <= 4) {
            const int m = wave - 1, r = 16 * m + fr;
            bf16x8 vf[2]; gs_vfrag(base + GS_V, lane, vf);
            const LAS unsigned char* sb = F.lds + GS_SB + (n & 1) * GS_SBBUF + fr * GS_SBROW + 16 * fq;
            bf16x8 af[2], qf[4], sf[4];
#pragma unroll
            for (int ks = 0; ks < 2; ++ks) af[ks] = *(const LAS bf16x8*)(base + GS_AM + r * 128 + (((4 * ks + fq) ^ (r & 7)) * 16));
#pragma unroll
            for (int ks = 0; ks < 4; ++ks) { qf[ks] = *(const LAS bf16x8*)(base + GS_QIN + r * 256 + (((4 * ks + fq) ^ (r & 15)) * 16)); sf[ks] = *(const LAS bf16x8*)(sb + 64 * ks); }
            __builtin_amdgcn_sched_barrier(0);
            f32x4 acc = (f32x4){0.f, 0.f, 0.f, 0.f};
#pragma unroll
            for (int ks = 0; ks < 2; ++ks) acc = __builtin_amdgcn_mfma_f32_16x16x32_bf16(af[ks], vf[ks], acc, 0, 0, 0);
#pragma unroll
            for (int ks = 0; ks < 4; ++ks) acc = __builtin_amdgcn_mfma_f32_16x16x32_bf16(qf[ks], sf[ks], acc, 0, 0, 0);
            bf16_t* op = ORAW + ((size_t)b * SEQ + 64 * n + 16 * m + 4 * fq) * 2048 + h * 256 + et * 16 + fr;
#pragma unroll
            for (int i = 0; i < 4; ++i) op[(size_t)i * 2048] = (bf16_t)f2bf(acc[i]);
        }
        if (wave >= 1) { if (n + 2 < 128) gs_wait_older(wave, false); else asm volatile("s_waitcnt vmcnt(0)" ::: "memory"); }
        asm volatile("s_waitcnt lgkmcnt(0)" ::: "memory"); __builtin_amdgcn_s_barrier(); asm volatile("" ::: "memory");
    }
    asm volatile("s_waitcnt vmcnt(0) lgkmcnt(0)" ::: "memory");
}
__device__ __forceinline__ void gla_norm(Frame& F) {
    const bf16_t* PROJ = (const bf16_t*)(F.ws + WS_PROJ); const bf16_t* ORAW = (const bf16_t*)(F.ws + WS_ORAW); bf16_t* MIX = (bf16_t*)(F.ws + WS_MIX);
    const int gw = F.bid * NWAVES + F.wave, NGW = F.G * NWAVES, lane = F.lane;
    const int col = 8 * (lane & 31);
    const f32x4 gn0 = *(const f32x4*)(F.g_gla + col), gn1 = *(const f32x4*)(F.g_gla + col + 4);
    const float gn[8] = {gn0.x, gn0.y, gn0.z, gn0.w, gn1.x, gn1.y, gn1.z, gn1.w};
    for (int m = gw; m < M; m += NGW) {
        u32x4 ow[4], gw4[4];
#pragma unroll
        for (int j = 0; j < 4; ++j) { const int hc = (2 * j + (lane >> 5)) * 256 + col; ow[j] = *(const u32x4*)(ORAW + (size_t)m * 2048 + hc); gw4[j] = *(const u32x4*)(PROJ + (size_t)m * LDP + C_GR + hc); }
#pragma unroll
        for (int j = 0; j < 4; ++j) { const unsigned a[4] = {ow[j].x, ow[j].y, ow[j].z, ow[j].w}, g[4] = {gw4[j].x, gw4[j].y, gw4[j].z, gw4[j].w};
            float o[8], ss = 0.f;
#pragma unroll
            for (int i = 0; i < 4; ++i) { o[2 * i] = bflo(a[i]); o[2 * i + 1] = bfhi(a[i]); ss += o[2 * i] * o[2 * i] + o[2 * i + 1] * o[2 * i + 1]; }
#pragma unroll
            for (int s = 1; s < 32; s <<= 1) ss += __shfl_xor(ss, s);
            const float rstd = 1.0f / sqrtf(ss * (1.f / 256.f) + RMS_EPS);
            unsigned w[4];
#pragma unroll
            for (int i = 0; i < 4; ++i) { const float g0 = bflo(g[i]), g1 = bfhi(g[i]);
                w[i] = pk2(o[2 * i] * rstd * gn[2 * i] * (g0 / (1.f + __expf(-g0))), o[2 * i + 1] * rstd * gn[2 * i + 1] * (g1 / (1.f + __expf(-g1)))); }
            *(u32x4*)(MIX + (size_t)m * D + (2 * j + (lane >> 5)) * 256 + col) = (u32x4){w[0], w[1], w[2], w[3]}; }
    }
}

struct RtLoad { u32x4 x[2]; f32x4 g[2]; };
struct RtW { bf16x8 wh[5], wl[5]; };
__device__ __forceinline__ void rt_load(RtLoad& L, const bf16_t* h0, const bf16_t* h1, const float* gp, int ko) {
    L.x[0] = *(const u32x4*)(h0 + ko); L.x[1] = *(const u32x4*)(h1 + ko);
    L.g[0] = *(const f32x4*)(gp + ko); L.g[1] = *(const f32x4*)(gp + ko + 4);
}
__device__ __forceinline__ void rt_step(const RtLoad& L, const bf16_t* bh, const bf16_t* bl, f32x4 (&acc)[2][5], float (&ss)[2], int ko) {
    RtW W;
#pragma unroll
    for (int n = 0; n < 5; ++n) { W.wh[n] = *(const bf16x8*)(bh + (size_t)n * 16 * D + ko); W.wl[n] = *(const bf16x8*)(bl + (size_t)n * 16 * D + ko); }
    bf16x8 ahi[2], alo[2];
#pragma unroll
    for (int mi = 0; mi < 2; ++mi) { const u32x4 xw = L.x[mi]; const f32x4 xa = (f32x4){bflo(xw.x), bfhi(xw.x), bflo(xw.y), bfhi(xw.y)}, xb = (f32x4){bflo(xw.z), bfhi(xw.z), bflo(xw.w), bfhi(xw.w)};
        ss[mi] += (xa.x * xa.x + xa.y * xa.y) + (xa.z * xa.z + xa.w * xa.w) + (xb.x * xb.x + xb.y * xb.y) + (xb.z * xb.z + xb.w * xb.w);
        const float u[8] = {xa.x * L.g[0].x, xa.y * L.g[0].y, xa.z * L.g[0].z, xa.w * L.g[0].w, xb.x * L.g[1].x, xb.y * L.g[1].y, xb.z * L.g[1].z, xb.w * L.g[1].w};
        unsigned hb[8]; float lo[8];
#pragma unroll
        for (int j = 0; j < 8; ++j) { hb[j] = f2bf(u[j]); lo[j] = u[j] - __builtin_bit_cast(float, hb[j] << 16); }
        const u32x4 hw = (u32x4){hb[0] | (hb[1] << 16), hb[2] | (hb[3] << 16), hb[4] | (hb[5] << 16), hb[6] | (hb[7] << 16)};
        const u32x4 lw = (u32x4){pk2(lo[0], lo[1]), pk2(lo[2], lo[3]), pk2(lo[4], lo[5]), pk2(lo[6], lo[7])};
        ahi[mi] = __builtin_bit_cast(bf16x8, hw); alo[mi] = __builtin_bit_cast(bf16x8, lw); }
#pragma unroll
    for (int n = 0; n < 5; ++n)
#pragma unroll
        for (int mi = 0; mi < 2; ++mi) { acc[mi][n] = __builtin_amdgcn_mfma_f32_16x16x32_bf16(ahi[mi], W.wh[n], acc[mi][n], 0, 0, 0);
            acc[mi][n] = __builtin_amdgcn_mfma_f32_16x16x32_bf16(alo[mi], W.wh[n], acc[mi][n], 0, 0, 0);
            acc[mi][n] = __builtin_amdgcn_mfma_f32_16x16x32_bf16(ahi[mi], W.wl[n], acc[mi][n], 0, 0, 0); }
}
__device__ __forceinline__ void p5_router(Frame& F) {
    const bf16_t* H = (const bf16_t*)(F.ws + WS_HB);
    const bf16_t* RBH = (const bf16_t*)(F.ws + WS_RB); const bf16_t* RBL = RBH + 80 * D;
    unsigned* ctl = (unsigned*)(F.ws + WS_CTL);
    LAS float* part = (LAS float*)F.lds;
    LAS float* lg = part + 4 * 64 * 80;
    LAS float* ssp = lg + 64 * 80;
    LAS float* rs = ssp + 256;
    const int lane = F.lane, wave = F.wave;
    for (int tile = F.bid; tile < M / 64; tile += F.G) {
        const int m0 = tile * 64;
        { const int tg = wave & 1, kq = wave >> 1, fr = lane & 15, fq = lane >> 4;
          f32x4 acc[2][5];
#pragma unroll
          for (int a = 0; a < 2; ++a)
#pragma unroll
              for (int n = 0; n < 5; ++n) acc[a][n] = (f32x4){0.f, 0.f, 0.f, 0.f};
          float ss[2] = {0.f, 0.f};
          const size_t roff = (size_t)(m0 + 32 * tg + fr) * D + kq * 1024 + 8 * fq;
          const bf16_t* h0 = H + roff; const bf16_t* h1 = h0 + (size_t)16 * D;
          const float* gp = F.g_ffn + kq * 1024 + 8 * fq;
          const bf16_t* bh = RBH + (size_t)fr * D + kq * 1024 + 8 * fq; const bf16_t* bl = RBL + (size_t)fr * D + kq * 1024 + 8 * fq;
          RtLoad La, Lb; rt_load(La, h0, h1, gp, 0);
#pragma unroll 1
          for (int ks = 0; ks < 32; ks += 2) {
              rt_load(Lb, h0, h1, gp, (ks + 1) * 32); rt_step(La, bh, bl, acc, ss, ks * 32);
              if (ks + 2 < 32) rt_load(La, h0, h1, gp, (ks + 2) * 32);
              rt_step(Lb, bh, bl, acc, ss, (ks + 1) * 32); }
#pragma unroll
          for (int mi = 0; mi < 2; ++mi) { float s = ss[mi]; s += __shfl_xor(s, 16); s += __shfl_xor(s, 32); if (fq == 0) ssp[kq * 64 + 32 * tg + 16 * mi + fr] = s;
#pragma unroll
              for (int n = 0; n < 5; ++n)
#pragma unroll
                  for (int i = 0; i < 4; ++i) part[(kq * 64 + 32 * tg + 16 * mi + 4 * fq + i) * 80 + 16 * n + fr] = acc[mi][n][i]; } }
        __syncthreads();
        if (F.tid < 64) { const float s = (ssp[F.tid] + ssp[64 + F.tid]) + (ssp[128 + F.tid] + ssp[192 + F.tid]); const float r = 1.0f / sqrtf(s * (1.f / D) + RMS_EPS); rs[F.tid] = r; }
        __syncthreads();
        for (int i = F.tid; i < 64 * 80; i += NTHREADS) lg[i] = ((part[i] + part[5120 + i]) + (part[10240 + i] + part[15360 + i])) * rs[i / 80];
        __syncthreads();
        if (F.tid < 64) { const int tk = F.tid, m = m0 + tk; const LAS float* L = lg + tk * 80;
            float gl[8]; int g = 0; float gm;
#pragma unroll
            for (int c = 0; c < 8; ++c) gl[c] = L[c] + F.rg_b[c];
            gm = gl[0];
#pragma unroll
            for (int c = 1; c < 8; ++c) if (gl[c] > gm) { gm = gl[c]; g = c; }
            float gs = 0.f;
#pragma unroll
            for (int c = 0; c < 8; ++c) gs += expf(gl[c] - gm);
            const float gw = 1.0f / gs;
            float el[8];
#pragma unroll
            for (int j = 0; j < 8; ++j) el[j] = L[8 + g * 8 + j] + F.re_b[g * 8 + j];
            int i0 = 0; float e0 = el[0];
#pragma unroll
            for (int j = 1; j < 8; ++j) if (el[j] > e0) { e0 = el[j]; i0 = j; }
            int i1 = -1; float e1 = -3.0e38f;
#pragma unroll
            for (int j = 0; j < 8; ++j) if (j != i0 && el[j] > e1) { e1 = el[j]; i1 = j; }
            const float tt = expf(e1 - e0); const float w0 = 1.0f / (1.0f + tt), w1 = tt / (1.0f + tt);
            const int x0 = g * 8 + i0, x1 = g * 8 + i1;
            const size_t s0 = (size_t)x0 * CAPS + atomicAdd(ctl + CW_CNT + x0, 1u), s1 = (size_t)x1 * CAPS + atomicAdd(ctl + CW_CNT + x1, 1u); const float rr = rs[tk];
            int* t2tok = (int*)(F.ws + WS_T2 + T2_TOK); float* t2w = (float*)(F.ws + WS_T2 + T2_W); int* t2dst = (int*)(F.ws + WS_T2 + T2_DST); float* t2rs = (float*)(F.ws + WS_T2 + T2_RS);
            t2tok[s0] = m; t2w[s0] = gw * w0; t2dst[s0] = 2 * m; t2rs[s0] = rr; t2tok[s1] = m; t2w[s1] = gw * w1; t2dst[s1] = 2 * m + 1; t2rs[s1] = rr; }
        __syncthreads();
    }
}
__device__ __forceinline__ void p6_tables(Frame& F) {
    unsigned* ctl = (unsigned*)(F.ws + WS_CTL);
    const int* tok_e = (const int*)(F.ws + WS_TAB + T_TOKE); const float* tok_w = (const float*)(F.ws + WS_TAB + T_TOKW); const int* tok_r = (const int*)(F.ws + WS_TAB + T_TOKR);
    int* slot_tok = (int*)(F.ws + WS_TAB + T_SLOTTOK); float* slot_w = (float*)(F.ws + WS_TAB + T_SLOTW); int* slot_dst = (int*)(F.ws + WS_TAB + T_SLOTDST); int* tile_e = (int*)(F.ws + WS_TAB + T_TILEE);
    float* slot_rs = (float*)(F.ws + WS_TAB + T_SLOTRS); const float* RSTD = (const float*)(F.ws + WS_TAB + T_RSTD);
    LAS int* off = (LAS int*)F.lds; LAS int* cnt = off + 80;
    if (F.tid < 64) cnt[F.tid] = (int)ctl[CW_CNT + F.tid];
    __syncthreads();
    if (F.tid == 0) { int a = 0; for (int e = 0; e < 64; ++e) { off[e] = a; a += (cnt[e] + 255) & ~255; } off[64] = a; }
    __syncthreads();
    for (int i = F.bid * NTHREADS + F.tid; i < 2 * M; i += F.G * NTHREADS) { const int e = tok_e[i], s = off[e] + tok_r[i]; slot_tok[s] = i >> 1; slot_w[s] = tok_w[i]; slot_dst[s] = i; slot_rs[s] = RSTD[i >> 1]; }
    for (int e = F.bid; e < 64; e += F.G) for (int s = off[e] + cnt[e] + F.tid; s < off[e + 1]; s += NTHREADS) { slot_tok[s] = 0; slot_w[s] = 0.f; slot_dst[s] = -1; slot_rs[s] = 0.f; }
    if (F.bid == 1 % F.G) { int* eoff = (int*)(F.ws + WS_TAB + T_EOFF); if (F.tid < 65) eoff[F.tid] = off[F.tid];
        if (F.tid < 8) { int* ul = (int*)(F.ws + WS_TAB + T_ULUP) + F.tid * UL_UP; int n = 0;
            for (int e = F.tid; e < 64; e += 8) { const int nrb = (cnt[e] + mu::MR - 1) / mu::MR; for (int rb = 0; rb < nrb; ++rb) for (int cb = 0; cb < 8; ++cb) ul[n++] = (e << 16) | (rb << 8) | cb; }
            ctl[CW_NUP + F.tid] = (unsigned)n; }
        else if (F.tid >= 64 && F.tid < 72) { const int x = F.tid - 64; int* ul = (int*)(F.ws + WS_TAB + T_ULDN) + x * UL_DN; int n = 0;
            for (int e = x; e < 64; e += 8) { const int nrb = (cnt[e] + mu::DR - 1) / mu::DR; for (int rb = 0; rb < nrb; ++rb) for (int cq = 0; cq < 4; ++cq) ul[n++] = (e << 16) | (rb << 8) | cq; }
            ctl[CW_NDN + x] = (unsigned)n; } }
    if (F.bid == 0) { if (F.tid < 64) for (int t = off[F.tid] >> 8; t < (off[F.tid + 1] >> 8); ++t) tile_e[t] = F.tid;
        if (F.tid == 0) ctl[CW_NT] = (unsigned)(off[64] >> 8); }
}
__device__ __forceinline__ void p9_row(float* O, const bf16_t* Hb, const bf16_t* Y, const float* g, int m, int mnext, int lane, u32x2 (&v)[16], u32x2 (&vn)[16]) {
    const u32x2* y0 = (const u32x2*)(Y + (size_t)(2 * m) * D) + lane; const u32x2* y1 = (const u32x2*)(Y + (size_t)(2 * m + 1) * D) + lane;
    u32x2 a[16], b[16];
#pragma unroll
    for (int j = 0; j < 16; ++j) { a[j] = y0[64 * j]; b[j] = y1[64 * j]; }
    if (mnext < M) { const u32x2* xn = (const u32x2*)(Hb + (size_t)mnext * D) + lane;
#pragma unroll
        for (int j = 0; j < 16; ++j) vn[j] = xn[64 * j]; }
    f32x4* xr = (f32x4*)(O + (size_t)m * D) + lane; const f32x4* gr = (const f32x4*)g + lane; float s = 0.f;
    f32x4 t[16];
#pragma unroll
    for (int j = 0; j < 16; ++j) { t[j].x = bflo(v[j].x) + (bflo(a[j].x) + bflo(b[j].x)); t[j].y = bfhi(v[j].x) + (bfhi(a[j].x) + bfhi(b[j].x)); t[j].z = bflo(v[j].y) + (bflo(a[j].y) + bflo(b[j].y)); t[j].w = bfhi(v[j].y) + (bfhi(a[j].y) + bfhi(b[j].y));
        s += (t[j].x * t[j].x + t[j].y * t[j].y) + (t[j].z * t[j].z + t[j].w * t[j].w); }
    const float rstd = 1.0f / sqrtf(wave_sum(s) * (1.f / D) + RMS_EPS);
#pragma unroll
    for (int j = 0; j < 16; ++j) { const f32x4 gg = gr[64 * j]; xr[64 * j] = (f32x4){t[j].x * rstd * gg.x, t[j].y * rstd * gg.y, t[j].z * rstd * gg.z, t[j].w * rstd * gg.w}; }
}
__device__ __forceinline__ void p9_final(Frame& F) {
    const bf16_t* Y = (const bf16_t*)(F.ws + WS_Y); const bf16_t* Hb = (const bf16_t*)(F.ws + WS_HB); float* O = F.out;
    const int gw = F.bid * NWAVES + F.wave, NGW = F.G * NWAVES, lane = F.lane;
    u32x2 va[16], vb[16];
    int m = gw;
    if (m < M) { const u32x2* xr = (const u32x2*)(Hb + (size_t)m * D) + lane;
#pragma unroll
        for (int j = 0; j < 16; ++j) va[j] = xr[64 * j]; }
    while (m < M) {
        p9_row(O, Hb, Y, F.g_fin, m, m + NGW, lane, va, vb); m += NGW; if (m >= M) break;
        p9_row(O, Hb, Y, F.g_fin, m, m + NGW, lane, vb, va); m += NGW;
    }
}

__global__ void __launch_bounds__(NTHREADS, 2) hymba_fwd(Args args) {
    extern __shared__ __attribute__((aligned(16))) unsigned char lds[];
    Frame F;
    F.lds = (LAS unsigned char*)lds;
    F.tid = threadIdx.x; F.lane = F.tid & 63; F.wave = __builtin_amdgcn_readfirstlane(F.tid >> 6);
    F.G = gridDim.x; F.bid = blockIdx.x; F.ws = args.ws; F.out = args.out;
    F.x = (const float*)args.in[0]; F.pos = (const int*)args.in[1]; F.g_mix = (const float*)args.in[2]; F.w_in = (const float*)args.in[3]; F.w2 = (const float*)args.in[4];
    F.gb = (const float*)args.in[5]; F.g_gla = (const float*)args.in[6]; F.sinks = (const float*)args.in[7]; F.w_out = (const float*)args.in[8]; F.g_ffn = (const float*)args.in[9];
    F.rg_w = (const float*)args.in[10]; F.rg_b = (const float*)args.in[11]; F.re_w = (const float*)args.in[12]; F.re_b = (const float*)args.in[13];
    F.wg = (const float*)args.in[14]; F.wu = (const float*)args.in[15]; F.wd = (const float*)args.in[16]; F.g_fin = (const float*)args.in[17];
    volatile LAS unsigned* MISC = (volatile LAS unsigned*)(F.lds + MISC_OFF);
    for (int u = F.tid; u < (LDS_BYTES - LDSCTL_OFF) / 4; u += NTHREADS) ((LAS unsigned*)(F.lds + LDSCTL_OFF))[u] = 0u;
    __syncthreads();
    unsigned* ctl = (unsigned*)(F.ws + WS_CTL);
    XcdBarrier bar; bar.bar = ctl + CW_BAR; bar.x = 0; bar.st = nullptr;
    if (MK_N_LAUNCHES == 1) bar = xcd_barrier_post(ctl + CW_BAR, MISC + 8);
    const int lo = args.ph_lo, hi = args.ph_hi;
#define IN(k) (lo <= (k) && (k) < hi)
#define SEAM(k) do { if (IN(k) && IN((k) + 1)) xcd_barrier(bar); } while (0)
    bf16_t* U = (bf16_t*)(F.ws + WS_U); bf16_t* PROJ = (bf16_t*)(F.ws + WS_PROJ); bf16_t* MIX = (bf16_t*)(F.ws + WS_MIX);

    if (IN(0)) REP(0) { p0_prologue(F); } SEAM(0);
    if (IN(1)) REP(1) {
        pg8::DenseSched S; S.init(U, (const bf16_t*)(F.ws + WS_WIN), M, LDP, D, F.G, F.bid);
        pg8::EpiBf16 E{PROJ, LDP};
        pg8::gemm_phase<pg8::EpiBf16, pg8::DenseSched, true>(F.lds, D, S, E);
    } SEAM(1);
    if (IN(2)) {
        REP(20) for (int u = F.bid; u < 2048; u += F.G) gla_prep_unit(F, u);
        REP(21) for (int u = F.bid; u < 1024; u += F.G) swa_unit(F, u >> 9, (u >> 7) & 3, u & 127);
    } SEAM(2);
    if (IN(3)) REP(3) { for (int c = F.bid; c < 256; c += F.G) { const int cc = (F.G == 256) ? (((c & 7) * 2 + (c >> 7)) << 4) | ((c >> 3) & 15) : c; gla_scan_chain(F, cc); } } SEAM(3);
    if (IN(4)) REP(4) { gla_norm(F); } SEAM(4);
    if (IN(5)) REP(5) {
        pg8::DenseSched S; S.init(MIX, (const bf16_t*)(F.ws + WS_WOUT), M, D, D, F.G, F.bid);
        pg8::EpiResBf16 E{F.x, (bf16_t*)(F.ws + WS_HB), D};
        pg8::gemm_phase<pg8::EpiResBf16, pg8::DenseSched, true>(F.lds, D, S, E);
    } SEAM(5);
    if (IN(6)) { p5_router(F); } SEAM(6);
    LAS int* eo = (LAS int*)(F.lds + MOE_TAB_OFF); LAS int* ecnt = eo + 80;
#define MOE_OFFSETS() do { __syncthreads(); if (F.tid < 64) { const int c_ = (int)ctl[CW_CNT + F.tid]; int s_ = c_; _Pragma("unroll") for (int d_ = 1; d_ < 64; d_ <<= 1) { const int t_ = __shfl_up(s_, d_); if (F.lane >= d_) s_ += t_; } \
        eo[F.tid + 1] = s_; ecnt[F.tid] = c_; if (F.tid == 0) eo[0] = 0; } __syncthreads(); } while (0)
#define MOE_UNIT(idx_, x_, RMAX, CBN, e_, rb_, cb_, ok_) do { int b_ = 0; ok_ = false; for (int k_ = 0; k_ < 8; ++k_) { const int ee_ = (x_) + 8 * k_, n_ = ((ecnt[ee_] + (RMAX) - 1) / (RMAX)) * (CBN); \
        if ((idx_) < b_ + n_) { e_ = ee_; rb_ = ((idx_) - b_) / (CBN); cb_ = ((idx_) - b_) % (CBN); ok_ = true; break; } b_ += n_; } } while (0)
    if (IN(8)) REP(8) {
        __syncthreads(); for (int i = F.tid; i < D / 4; i += NTHREADS) ((LAS f32x4*)(F.lds + mu::GAIN_OFF))[i] = ((const f32x4*)F.g_ffn)[i];
        MOE_OFFSETS();
        const int x = F.bid & 7;
        for (int j = F.bid >> 3; ; j += F.G >> 3) { int e = 0, rb = 0, cb = 0; bool ok; MOE_UNIT(j, x, mu::MR, 8, e, rb, cb, ok); if (!ok) break;
            const int n = ecnt[e], nrb = (n + mu::MR - 1) / mu::MR, base = n / nrb, rem = n % nrb, r0 = rb * base + (rb < rem ? rb : rem), nv = base + (rb < rem ? 1 : 0);
            const long adj = (long)e * CAPS - eo[e];
            mu::moe_unit<0>(F.lds, e, cb, eo[e] + r0, nv, (const bf16_t*)(F.ws + WS_HB), (const int*)(F.ws + WS_T2 + T2_TOK) + adj, F.wg, F.wu, (bf16_t*)(F.ws + WS_HID), (const float*)(F.ws + WS_T2 + T2_RS) + adj, nullptr); }
    } SEAM(8);
    if (IN(9)) REP(9) {
        MOE_OFFSETS();
        const int x = F.bid & 7;
        for (int j = F.bid >> 3; ; j += F.G >> 3) { int e = 0, rb = 0, cq = 0; bool ok; MOE_UNIT(j, x, mu::DR, (32 / mu::DCB), e, rb, cq, ok); if (!ok) break;
            const int n = ecnt[e], nrb = (n + mu::DR - 1) / mu::DR, base = n / nrb, rem = n % nrb, r0 = rb * base + (rb < rem ? rb : rem), nv = base + (rb < rem ? 1 : 0);
            const long adj = (long)e * CAPS - eo[e];
            mu::moe_down_stream(F.lds, e, mu::DCB * cq, eo[e] + r0, nv, (const bf16_t*)(F.ws + WS_HID), F.wd, (bf16_t*)(F.ws + WS_Y), (const float*)(F.ws + WS_T2 + T2_W) + adj, (const int*)(F.ws + WS_T2 + T2_DST) + adj); }
    } SEAM(9);
#undef MOE_OFFSETS
#undef MOE_UNIT
    if (IN(10)) { p9_final(F); }
#undef IN
#undef SEAM
}

extern "C" void kernel_launch(void* const* d_in, const int* in_sizes, int n_in, void* d_out, int out_size, void* d_ws, size_t ws_size, hipStream_t stream) {
    static int grid = 0;
    if (grid == 0) {
        if (n_in != 18 || out_size != M * D || ws_size < WS_END) { fprintf(stderr, "kernel_launch: unexpected shapes (n_in %d, out %d, ws %zu < %zu)\n", n_in, out_size, ws_size, (size_t)WS_END); grid = -1; return; }
        int dev = 0, cus = 0, per_cu = 0;
        if (hipGetDevice(&dev) != hipSuccess || hipDeviceGetAttribute(&cus, hipDeviceAttributeMultiprocessorCount, dev) != hipSuccess) { grid = -1; return; }
        if (hipFuncSetAttribute((const void*)hymba_fwd, hipFuncAttributeMaxDynamicSharedMemorySize, LDS_BYTES) != hipSuccess) { fprintf(stderr, "kernel_launch: hipFuncSetAttribute failed\n"); grid = -1; return; }
        if (hipOccupancyMaxActiveBlocksPerMultiprocessor(&per_cu, (const void*)hymba_fwd, NTHREADS, LDS_BYTES) != hipSuccess || per_cu < 1) { fprintf(stderr, "kernel_launch: occupancy query says %d\n", per_cu); }
        (void)hipGetLastError();
        grid = cus;
    }
    if (grid < 0) return;
    (void)in_sizes;
    if (hipMemsetAsync((char*)d_ws + WS_CTL, 0, CTL_ZERO_BYTES, stream) != hipSuccess) return;
    Args a{};
    for (int i = 0; i < 18; ++i) a.in[i] = d_in[i];
    a.out = (float*)d_out; a.ws = (unsigned char*)d_ws;
    if (MK_N_LAUNCHES == 1) { a.ph_lo = 0; a.ph_hi = N_PHASES; hipLaunchKernelGGL(hymba_fwd, dim3(grid), dim3(NTHREADS), LDS_BYTES, stream, a); }
    else for (int p = 0; p < N_PHASES; ++p) { a.ph_lo = p; a.ph_hi = p + 1; hipLaunchKernelGGL(hymba_fwd, dim3(grid), dim3(NTHREADS), LDS_BYTES, stream, a); }
}
```
